# Optimizing an MI355X kernel written in HIP

```python
import jax, jax.numpy as jnp
from jax import lax
import numpy as np

D_MODEL = 1024
BATCH = 8
SEQ = 4096
DEPTH = 1

MEM_LEN = 256
GRID_W = 64
ROPE_THETA = 10000.0
Q_BLOCK = 128
RMS_EPS = 1e-6
LN_EPS = 1e-5

GQA_HEADS = 8
GQA_KV_HEADS = 2
GQA_HEAD_DIM = D_MODEL // 16
MLA_HEADS = 8
MLA_NOPE_DIM = D_MODEL // 16
MLA_ROPE_DIM = D_MODEL // 32
MLA_V_DIM = D_MODEL // 16
MLA_Q_LORA = 3 * D_MODEL // 8
MLA_KV_LORA = D_MODEL // 4
MEM_HEADS = 4
MEM_HEAD_DIM = D_MODEL // 8
N_BRANCH = 3

GQA_Q_W = GQA_HEADS * GQA_HEAD_DIM
GQA_KV_W = GQA_KV_HEADS * GQA_HEAD_DIM
MLA_OUT_W = MLA_HEADS * MLA_V_DIM
MEM_Q_W = MEM_HEADS * MEM_HEAD_DIM
GATE_W = N_BRANCH * D_MODEL
SPLIT_SIZES = (GQA_Q_W, GQA_KV_W, GQA_KV_W, MLA_Q_LORA, MLA_KV_LORA, MLA_ROPE_DIM, MEM_Q_W, GATE_W)
SPLIT_OFFSETS = tuple(int(v) for v in np.cumsum(SPLIT_SIZES)[:-1])
IN_PROJ_W = sum(SPLIT_SIZES)

N_EXPERTS = 32
TOP_K = 4
D_EXPERT = D_MODEL
SWIGLU_LIMIT = 7.0
SWIGLU_ALPHA = 1.702
EXPERT_BLOCK = 128

DEEPNORM_ALPHA = (2 * DEPTH) ** 0.25
DEEPNORM_BETA = (8 * DEPTH) ** -0.25

kernel_name = "hybrid_gqa_mla_mem_moe_deepnorm_encoder"


def layer_norm(x, g, b):
    xf = x.astype(jnp.float32)
    mu = jnp.mean(xf, axis=-1, keepdims=True)
    xc = xf - mu
    var = jnp.mean(xc * xc, axis=-1, keepdims=True)
    return (xc * lax.rsqrt(var + LN_EPS) * g + b).astype(x.dtype)


def rms_norm(x, g):
    xf = x.astype(jnp.float32)
    return (xf * lax.rsqrt(jnp.mean(xf * xf, axis=-1, keepdims=True) + RMS_EPS) * g).astype(x.dtype)


def rope_1d(x, pos):
    half = x.shape[-1] // 2
    inv = ROPE_THETA ** (-jnp.arange(half, dtype=jnp.float32) / half)
    ang = pos.astype(jnp.float32)[:, None] * inv[None, :]
    c = jnp.cos(ang)[None, :, None, :]
    s = jnp.sin(ang)[None, :, None, :]
    x1 = x[..., :half].astype(jnp.float32)
    x2 = x[..., half:].astype(jnp.float32)
    return jnp.concatenate([x1 * c - x2 * s, x2 * c + x1 * s], axis=-1).astype(x.dtype)


def axial_rope(x, row, col):
    d = x.shape[-1] // 2
    return jnp.concatenate([rope_1d(x[..., :d], row), rope_1d(x[..., d:], col)], axis=-1)


def blocked_attention(q, k, v):
    B, S, Hk, G, Dq = q.shape
    nqb = S // Q_BLOCK
    qb = (q * (Dq ** -0.5)).reshape(B, nqb, Q_BLOCK, Hk, G, Dq).transpose(1, 0, 2, 3, 4, 5)

    def attend(qblk):
        s = jnp.einsum('bqhgd,bthd->bhgqt', qblk, k, preferred_element_type=jnp.float32)
        p = jax.nn.softmax(s, axis=-1).astype(v.dtype)
        return jnp.einsum('bhgqt,bthe->bqhge', p, v)

    o = lax.map(attend, qb)
    return o.transpose(1, 0, 2, 3, 4, 5).reshape(B, S, Hk, G, v.shape[-1])


def hybrid_mixer(h, mem, row, col, w_in_proj, b_gate, gqa_q_norm, gqa_k_norm, mla_q_norm,
                 mla_kv_norm, w_mla_qb, w_mla_kvb, w_mem_kv, w_br_gqa, w_br_mla, w_br_mem, w_out):
    B, S, D = h.shape
    proj = h @ w_in_proj
    q_a, k_a, v_a, q_lat, kv_lat, k_rope, q_m, gate_pre = jnp.split(proj, SPLIT_OFFSETS, axis=-1)

    qa = axial_rope(rms_norm(q_a.reshape(B, S, GQA_HEADS, GQA_HEAD_DIM), gqa_q_norm), row, col)
    ka = axial_rope(rms_norm(k_a.reshape(B, S, GQA_KV_HEADS, GQA_HEAD_DIM), gqa_k_norm), row, col)
    va = v_a.reshape(B, S, GQA_KV_HEADS, GQA_HEAD_DIM)
    group = GQA_HEADS // GQA_KV_HEADS
    oa = blocked_attention(qa.reshape(B, S, GQA_KV_HEADS, group, GQA_HEAD_DIM), ka, va).reshape(B, S, GQA_Q_W)

    qm = (rms_norm(q_lat, mla_q_norm) @ w_mla_qb).reshape(B, S, MLA_HEADS, MLA_NOPE_DIM + MLA_ROPE_DIM)
    q_nope, q_pe = qm[..., :MLA_NOPE_DIM], axial_rope(qm[..., MLA_NOPE_DIM:], row, col)
    kv = (rms_norm(kv_lat, mla_kv_norm) @ w_mla_kvb).reshape(B, S, MLA_HEADS, MLA_NOPE_DIM + MLA_V_DIM)
    k_nope, v_b = kv[..., :MLA_NOPE_DIM], kv[..., MLA_NOPE_DIM:]
    k_pe = axial_rope(k_rope[:, :, None, :], row, col)
    k_b = jnp.concatenate([k_nope, jnp.broadcast_to(k_pe, (B, S, MLA_HEADS, MLA_ROPE_DIM))], axis=-1)
    q_b = jnp.concatenate([q_nope, q_pe], axis=-1)[:, :, :, None, :]
    ob = blocked_attention(q_b, k_b, v_b).reshape(B, S, MLA_OUT_W)

    mkv = mem @ w_mem_kv
    M = mem.shape[1]
    mk = mkv[..., :MEM_Q_W].reshape(B, M, MEM_HEADS, MEM_HEAD_DIM)
    mv = mkv[..., MEM_Q_W:].reshape(B, M, MEM_HEADS, MEM_HEAD_DIM)
    oc = blocked_attention(q_m.reshape(B, S, MEM_HEADS, 1, MEM_HEAD_DIM), mk, mv).reshape(B, S, MEM_Q_W)

    gates = jax.nn.sigmoid((gate_pre + b_gate).astype(jnp.float32)).astype(h.dtype).reshape(B, S, N_BRANCH, D)
    merged = (gates[:, :, 0] * (oa @ w_br_gqa)
              + gates[:, :, 1] * (ob @ w_br_mla)
              + gates[:, :, 2] * (oc @ w_br_mem))
    return merged @ w_out


def moe_ffn(h, w_router, b_router, w_exp_in, b_exp_in, w_exp_out, b_exp_out):
    B, S, D = h.shape
    N = B * S
    A = N * TOP_K
    xt = h.reshape(N, D)
    logits = jnp.dot(xt, w_router, preferred_element_type=jnp.float32) + b_router.astype(jnp.float32)
    top_val, top_idx = lax.top_k(logits, TOP_K)
    gate = jax.nn.softmax(top_val, axis=-1)

    flat_e = top_idx.reshape(A).astype(jnp.int32)
    flat_tok = jnp.repeat(jnp.arange(N, dtype=jnp.int32), TOP_K)
    flat_w = gate.reshape(A)
    order = jnp.argsort(flat_e)
    e_s, tok_s, w_s = flat_e[order], flat_tok[order], flat_w[order]
    counts = jnp.bincount(flat_e, length=N_EXPERTS).astype(jnp.int32)
    padded = (counts + EXPERT_BLOCK - 1) // EXPERT_BLOCK * EXPERT_BLOCK
    pad_end = jnp.cumsum(padded)
    pad_start = pad_end - padded
    grp_start = jnp.cumsum(counts) - counts
    dest = pad_start[e_s] + jnp.arange(A, dtype=jnp.int32) - grp_start[e_s]
    n_blocks = -(-A // EXPERT_BLOCK) + N_EXPERTS
    n_slots = n_blocks * EXPERT_BLOCK
    slot_tok = jnp.full((n_slots,), N, jnp.int32).at[dest].set(tok_s)
    slot_w = jnp.zeros((n_slots,), jnp.float32).at[dest].set(w_s)
    blk_start = jnp.arange(n_blocks, dtype=jnp.int32) * EXPERT_BLOCK
    blk_e = jnp.minimum(jnp.searchsorted(pad_end, blk_start, side='right'), N_EXPERTS - 1).astype(jnp.int32)
    x_pad = jnp.concatenate([xt, jnp.zeros((1, D), xt.dtype)], axis=0)
    xs = x_pad[slot_tok].reshape(n_blocks, EXPERT_BLOCK, D)

    def expert_block(args):
        xb, e = args
        hb = xb @ w_exp_in[e] + b_exp_in[e]
        x_glu = jnp.minimum(hb[:, :D_EXPERT], SWIGLU_LIMIT)
        x_lin = jnp.clip(hb[:, D_EXPERT:], -SWIGLU_LIMIT, SWIGLU_LIMIT)
        act = x_glu * jax.nn.sigmoid(SWIGLU_ALPHA * x_glu) * (x_lin + 1.0)
        return act @ w_exp_out[e] + b_exp_out[e]

    ys = lax.map(expert_block, (xs, blk_e)).reshape(n_slots, D)
    ys = ys * slot_w[:, None].astype(ys.dtype)
    out = jnp.zeros((N + 1, D), ys.dtype).at[slot_tok].add(ys)[:N]
    return out.reshape(B, S, D)


def setup_inputs(seed: int = 0) -> dict:
    key = jax.random.key(seed)
    ks = iter(jax.random.split(key, 32))

    def w(shape, fan_in, scale=1.0):
        return jax.random.normal(next(ks), shape, jnp.float32) * (fan_in ** -0.5) * scale

    def gain(shape):
        return 1.0 + 0.05 * jax.random.normal(next(ks), shape, jnp.float32)

    def bias(shape, scale=0.02):
        return scale * jax.random.normal(next(ks), shape, jnp.float32)

    L, D = DEPTH, D_MODEL
    return {
        "x": jax.random.normal(next(ks), (BATCH, SEQ, D), jnp.float32),
        "mem": jax.random.normal(next(ks), (BATCH, MEM_LEN, D), jnp.float32),
        "ln_in_g": gain((D,)),
        "ln_in_b": bias((D,)),
        "w_in_proj": w((L, D, IN_PROJ_W), D),
        "b_gate": bias((L, GATE_W)),
        "gqa_q_norm": gain((L, GQA_HEAD_DIM)),
        "gqa_k_norm": gain((L, GQA_HEAD_DIM)),
        "mla_q_norm": gain((L, MLA_Q_LORA)),
        "mla_kv_norm": gain((L, MLA_KV_LORA)),
        "w_mla_qb": w((L, MLA_Q_LORA, MLA_HEADS * (MLA_NOPE_DIM + MLA_ROPE_DIM)), MLA_Q_LORA),
        "w_mla_kvb": w((L, MLA_KV_LORA, MLA_HEADS * (MLA_NOPE_DIM + MLA_V_DIM)), MLA_KV_LORA),
        "w_mem_kv": w((L, D, 2 * MEM_Q_W), D),
        "w_br_gqa": w((L, GQA_Q_W, D), GQA_Q_W),
        "w_br_mla": w((L, MLA_OUT_W, D), MLA_OUT_W),
        "w_br_mem": w((L, MEM_Q_W, D), MEM_Q_W),
        "w_out": w((L, D, D), D, DEEPNORM_BETA),
        "ln1_g": gain((L, D)),
        "ln1_b": bias((L, D)),
        "w_router": w((L, D, N_EXPERTS), D),
        "b_router": bias((L, N_EXPERTS), 0.01),
        "w_exp_in": w((L, N_EXPERTS, D, 2 * D_EXPERT), D),
        "b_exp_in": bias((L, N_EXPERTS, 2 * D_EXPERT)),
        "w_exp_out": w((L, N_EXPERTS, D_EXPERT, D), D_EXPERT, DEEPNORM_BETA),
        "b_exp_out": bias((L, N_EXPERTS, D)),
        "ln2_g": gain((L, D)),
        "ln2_b": bias((L, D)),
    }


def reference(x, mem, ln_in_g, ln_in_b, w_in_proj, b_gate, gqa_q_norm, gqa_k_norm, mla_q_norm,
              mla_kv_norm, w_mla_qb, w_mla_kvb, w_mem_kv, w_br_gqa, w_br_mla, w_br_mem, w_out,
              ln1_g, ln1_b, w_router, b_router, w_exp_in, b_exp_in, w_exp_out, b_exp_out,
              ln2_g, ln2_b):
    S = x.shape[1]
    rows = S // GRID_W
    row = jnp.repeat(jnp.arange(rows, dtype=jnp.int32), GRID_W)
    col = jnp.tile(jnp.arange(GRID_W, dtype=jnp.int32), rows)
    h = layer_norm(x, ln_in_g, ln_in_b)
    for l in range(DEPTH):
        mix = hybrid_mixer(h, mem, row, col, w_in_proj[l], b_gate[l], gqa_q_norm[l], gqa_k_norm[l],
                           mla_q_norm[l], mla_kv_norm[l], w_mla_qb[l], w_mla_kvb[l], w_mem_kv[l],
                           w_br_gqa[l], w_br_mla[l], w_br_mem[l], w_out[l])
        h = layer_norm(DEEPNORM_ALPHA * h + mix, ln1_g[l], ln1_b[l])
        ffn = moe_ffn(h, w_router[l], b_router[l], w_exp_in[l], b_exp_in[l], w_exp_out[l], b_exp_out[l])
        h = layer_norm(DEEPNORM_ALPHA * h + ffn, ln2_g[l], ln2_b[l])
    return h
```

```cpp
#include <hip/hip_runtime.h>
#include <cstdio>
#include <cstdint>

namespace pg8 {
#define PG8_LAS __attribute__((address_space(3)))
typedef unsigned short bf16_t;
typedef short bf16x8 __attribute__((ext_vector_type(8)));
typedef float f32x4 __attribute__((ext_vector_type(4)));
typedef float f32x2 __attribute__((ext_vector_type(2)));
typedef unsigned u32x4 __attribute__((ext_vector_type(4)));
typedef unsigned u32x2 __attribute__((ext_vector_type(2)));
constexpr int BM = 256, BK = 64, HALF = 128, HTB = HALF * BK * 2  , STAGE_BYTES = 8 * HTB, NXCD = 8, WGM = 8;

__host__ __device__ __forceinline__ int lds_byte(int r, int c) { const int st = (r >> 4) * 2 + (c >> 5), rr = r & 15, cc = c & 31, ob = rr * 64 + cc * 2; return st * 1024 + (ob ^ (((ob >> 9) & 1) << 5)); }
__host__ __device__ __forceinline__ void stage_rc(int b, int& R, int& C) { const int st = b / 1024, sb = b % 1024, swz = sb ^ (((sb >> 9) & 1) << 5); R = (st >> 1) * 16 + swz / 64; C = (st & 1) * 32 + (swz % 64) / 2; }
__host__ __device__ __forceinline__ int perm32(int rho) { const int n = rho >> 4, i = rho & 15; return 8 * (i >> 2) + 4 * n + (i & 3); }

struct Unit { int pm, pn, aux; };

__device__ __forceinline__ unsigned cvt_pk_bf16(float lo, float hi) { unsigned r; asm volatile("v_cvt_pk_bf16_f32 %0, %1, %2" : "=v"(r) : "v"(lo), "v"(hi)); return r; }
__device__ __forceinline__ u32x2 pack4(f32x4 v) { u32x2 w; w.x = cvt_pk_bf16(v[0], v[1]); w.y = cvt_pk_bf16(v[2], v[3]); return w; }

template <class Epi, class Sched, bool ALIGN_EPI = false, bool SP2 = false>
__device__ __forceinline__ void gemm_phase(PG8_LAS unsigned char* lds, const int Kdim, const Sched& S, const Epi& E) {
    int tid_ = threadIdx.x; asm volatile("" : "+v"(tid_));
    const int tid = tid_, wid = __builtin_amdgcn_readfirstlane(tid >> 6), lane = tid & 63, wr = wid >> 2, wc = wid & 3, fr = lane & 15, fq = lane >> 4;
    const int K = Kdim, nt = K / BK;
    unsigned voffA[2], voffB[2];
#pragma unroll
    for (int i = 0; i < 2; ++i) { int R, C; stage_rc(tid * 16 + i * 8192, R, C); const int Rb = Epi::PERM ? ((R & ~31) + perm32(R & 31)) : R;
        voffA[i] = (unsigned)(R * K + C) * 2u; voffB[i] = (unsigned)(Rb * K + C) * 2u; }
    const size_t kstep = (size_t)(BK * 2);
    const size_t hstep = (size_t)HALF * K * 2;
    const size_t tstep = 2 * hstep;
    const unsigned ldsw = (unsigned)wid * 1024u;
    const int aoff = lds_byte(wr * 64 + fr, fq * 8), boff = lds_byte(wc * 32 + fr, fq * 8);
#define PG8_SA(b, h) (((b) * 2 + (h)) * HTB)
#define PG8_SB(b, h) ((4 + (b) * 2 + (h)) * HTB)
#define PG8_STAGE(bufoff, gbase, voff) do { _Pragma("unroll") for (int _i = 0; _i < 2; ++_i) \
        __builtin_amdgcn_global_load_lds((const unsigned*)((const char*)(gbase) + (voff)[_i]), (PG8_LAS unsigned*)(lds + (bufoff) + ldsw + _i * 8192), 16, 0, 0); } while (0)
#define PG8_LDA(dst, b, h) do { _Pragma("unroll") for (int m = 0; m < 4; ++m) _Pragma("unroll") for (int k = 0; k < 2; ++k) dst[m][k] = *(const PG8_LAS bf16x8*)(lds + PG8_SA(b, h) + aoff + m * 2048 + k * 1024); } while (0)
#define PG8_LDB(dst, b, h) do { _Pragma("unroll") for (int n = 0; n < 2; ++n) _Pragma("unroll") for (int k = 0; k < 2; ++k) dst[n][k] = *(const PG8_LAS bf16x8*)(lds + PG8_SB(b, h) + boff + n * 2048 + k * 1024); } while (0)
#define PG8_MMA(ai, bj, At, Bt) do { __builtin_amdgcn_s_setprio(1); _Pragma("unroll") for (int m = 0; m < 4; ++m) _Pragma("unroll") for (int n = 0; n < 2; ++n) _Pragma("unroll") for (int k = 0; k < 2; ++k) \
        acc[ai][bj][m][n] = __builtin_amdgcn_mfma_f32_16x16x32_bf16(Bt[n][k], At[m][k], acc[ai][bj][m][n], 0, 0, 0); __builtin_amdgcn_s_setprio(0); } while (0)
#define PG8_WAIT_V(n) asm volatile("s_waitcnt vmcnt(" #n ")" ::: "memory")
#define PG8_WAIT_L(n) asm volatile("s_waitcnt lgkmcnt(" #n ")" ::: "memory")
#define PG8_BAR __builtin_amdgcn_s_barrier()
#define PG8_SCHED __builtin_amdgcn_sched_barrier(0)
    Unit cur, nxt; int ui = 0;
    if (!S.next(0, cur)) return;
    f32x4 acc[2][2][4][2];
#pragma unroll
    for (int a = 0; a < 2; ++a)
#pragma unroll
        for (int b = 0; b < 2; ++b)
#pragma unroll
            for (int m = 0; m < 4; ++m)
#pragma unroll
                for (int n = 0; n < 2; ++n) acc[a][b][m][n] = (f32x4){0.f, 0.f, 0.f, 0.f};
    bf16x8 At[4][2], B0[2][2], B1[2][2];
    const char* cA = S.a_ptr(cur); const char* cB = S.b_ptr(cur);
    S.a_ready(cur);
    if constexpr (SP2) {
        PG8_STAGE(PG8_SB(0, 0), cB, voffB); PG8_STAGE(PG8_SB(0, 1), cB + hstep, voffB); PG8_STAGE(PG8_SA(0, 0), cA, voffA); PG8_STAGE(PG8_SA(0, 1), cA + hstep, voffA);
        if (wr == 1) PG8_BAR;
        PG8_WAIT_V(2); PG8_BAR;
        PG8_STAGE(PG8_SB(1, 0), cB + kstep, voffB); PG8_STAGE(PG8_SA(1, 0), cA + kstep, voffA); PG8_STAGE(PG8_SB(1, 1), cB + hstep + kstep, voffB);
        PG8_WAIT_V(6); PG8_BAR;
    } else {
        PG8_STAGE(PG8_SB(0, 0), cB, voffB); PG8_STAGE(PG8_SA(0, 0), cA, voffA); PG8_STAGE(PG8_SB(0, 1), cB + hstep, voffB); PG8_STAGE(PG8_SA(0, 1), cA + hstep, voffA);
        if (wr == 1) PG8_BAR;
        PG8_WAIT_V(4); PG8_BAR;
        PG8_STAGE(PG8_SB(1, 0), cB + kstep, voffB); PG8_STAGE(PG8_SA(1, 0), cA + kstep, voffA); PG8_STAGE(PG8_SB(1, 1), cB + hstep + kstep, voffB);
        PG8_WAIT_V(6); PG8_BAR;
    }
    for (;;) {
        const bool has_next = S.next(ui + 1, nxt);
        const char* nA = has_next ? S.a_ptr(nxt) : cA; const char* nB = has_next ? S.b_ptr(nxt) : cB;
        for (int t = 0; t < nt; t += 2) {
            const bool last = (t == nt - 2);
            const char* a1 = cA + (size_t)(t + 1) * kstep;
            const char* a2 = last ? nA : cA + (size_t)(t + 2) * kstep; const char* b2 = last ? nB : cB + (size_t)(t + 2) * kstep;
            const char* a3 = a2 + kstep; const char* b3 = b2 + kstep;
            if (last && has_next) S.a_ready(nxt);
            if constexpr (SP2) {
            PG8_LDB(B0, 0, 0); PG8_LDB(B1, 0, 1); PG8_SCHED; PG8_LDA(At, 0, 0); PG8_STAGE(PG8_SA(1, 1), a1 + hstep, voffA);
            PG8_WAIT_V(8); PG8_WAIT_L(0); PG8_BAR; PG8_MMA(0, 0, At, B0); PG8_MMA(0, 1, At, B1); PG8_BAR; PG8_SCHED;
            PG8_LDA(At, 0, 1); PG8_STAGE(PG8_SB(0, 0), b2, voffB); PG8_STAGE(PG8_SB(0, 1), b2 + hstep, voffB); PG8_STAGE(PG8_SA(0, 0), a2, voffA);
            PG8_WAIT_V(8); PG8_WAIT_L(0); PG8_BAR; PG8_MMA(1, 0, At, B0); PG8_MMA(1, 1, At, B1); PG8_BAR; PG8_SCHED;
            PG8_LDB(B0, 1, 0); PG8_LDB(B1, 1, 1); PG8_SCHED; PG8_LDA(At, 1, 0); PG8_STAGE(PG8_SA(0, 1), a2 + hstep, voffA);
            PG8_WAIT_V(8); PG8_WAIT_L(0); PG8_BAR; PG8_MMA(0, 0, At, B0); PG8_MMA(0, 1, At, B1); PG8_BAR; PG8_SCHED;
            PG8_LDA(At, 1, 1); PG8_STAGE(PG8_SB(1, 0), b3, voffB); PG8_STAGE(PG8_SB(1, 1), b3 + hstep, voffB); PG8_STAGE(PG8_SA(1, 0), a3, voffA);
            PG8_WAIT_V(8); PG8_WAIT_L(0); PG8_BAR; PG8_MMA(1, 0, At, B0); PG8_MMA(1, 1, At, B1); PG8_BAR; PG8_SCHED;
            } else {
            PG8_LDB(B0, 0, 0); PG8_SCHED; PG8_LDA(At, 0, 0); PG8_STAGE(PG8_SA(1, 1), a1 + hstep, voffA);
            PG8_WAIT_L(8); PG8_BAR; PG8_WAIT_L(0); PG8_MMA(0, 0, At, B0); PG8_BAR; PG8_SCHED;
            PG8_LDB(B1, 0, 1); PG8_STAGE(PG8_SB(0, 0), b2, voffB);
            PG8_BAR; PG8_WAIT_L(0); PG8_MMA(0, 1, At, B1); PG8_BAR;
            PG8_LDA(At, 0, 1); PG8_STAGE(PG8_SA(0, 0), a2, voffA);
            PG8_BAR; PG8_WAIT_L(0); PG8_MMA(1, 0, At, B0); PG8_BAR; PG8_SCHED;
            PG8_STAGE(PG8_SB(0, 1), b2 + hstep, voffB);
            PG8_WAIT_V(6); PG8_BAR; PG8_MMA(1, 1, At, B1); PG8_BAR;
            PG8_LDB(B0, 1, 0); PG8_SCHED; PG8_LDA(At, 1, 0); PG8_STAGE(PG8_SA(0, 1), a2 + hstep, voffA);
            PG8_WAIT_L(8); PG8_BAR; PG8_WAIT_L(0); PG8_MMA(0, 0, At, B0); PG8_BAR; PG8_SCHED;
            PG8_LDB(B1, 1, 1); PG8_STAGE(PG8_SB(1, 0), b3, voffB);
            PG8_BAR; PG8_WAIT_L(0); PG8_MMA(0, 1, At, B1); PG8_BAR;
            PG8_LDA(At, 1, 1); PG8_STAGE(PG8_SA(1, 0), a3, voffA);
            PG8_BAR; PG8_WAIT_L(0); PG8_MMA(1, 0, At, B0); PG8_BAR; PG8_SCHED;
            PG8_STAGE(PG8_SB(1, 1), b3 + hstep, voffB);
            PG8_WAIT_V(6); PG8_BAR; PG8_MMA(1, 1, At, B1); PG8_BAR;
            }
        }
        if constexpr (ALIGN_EPI) { if (wr == 0) PG8_BAR; }
        if constexpr (!Epi::AFTER_DRAIN) { int t2_ = threadIdx.x; asm volatile("" : "+v"(t2_)); const int fr_ = t2_ & 15, fq_ = (t2_ >> 4) & 3; E(acc, cur, wr, wc, fr_, fq_); S.done(cur); }
        if (!has_next) break;
#pragma unroll
        for (int a = 0; a < 2; ++a)
#pragma unroll
            for (int b = 0; b < 2; ++b)
#pragma unroll
                for (int m = 0; m < 4; ++m)
#pragma unroll
                    for (int n = 0; n < 2; ++n) acc[a][b][m][n] = (f32x4){0.f, 0.f, 0.f, 0.f};
        cur = nxt; cA = nA; cB = nB; ++ui;
        if constexpr (ALIGN_EPI) { if (wr == 1) PG8_BAR; }
    }
    PG8_WAIT_V(0);
    if constexpr (!ALIGN_EPI) { if (wr == 0) PG8_BAR; }
    PG8_BAR;
    if constexpr (Epi::AFTER_DRAIN) { E.fused(acc, cur, wr, wc, fr, fq, lds, wid, lane); S.done(cur); }
#undef PG8_SA
#undef PG8_SB
#undef PG8_STAGE
#undef PG8_LDA
#undef PG8_LDB
#undef PG8_MMA
#undef PG8_WAIT_V
#undef PG8_WAIT_L
#undef PG8_BAR
#undef PG8_SCHED
}
}

constexpr int NB = 8, SEQ = 4096, DM = 1024, NTOK = NB * SEQ;
constexpr int MEMLEN = 256, NMEM = NB * MEMLEN;
constexpr int IN_PROJ_W = 5024, NPROJ = 5120;
constexpr int QLAT = 384, KVLAT = 256;
constexpr int NEXP = 32, TOPK = 4, DEXP = 1024;
constexpr int MAXTILES = 544;
constexpr float LN_EPS = 1e-5f, RMS_EPS = 1e-6f;
constexpr float DN_ALPHA = 1.189207115002721f;
constexpr float LOG2E = 1.4426950408889634f;

typedef pg8::bf16_t bf16_t;
typedef pg8::f32x4 f32x4;
typedef pg8::f32x2 f32x2;
typedef pg8::u32x2 u32x2;
typedef pg8::u32x4 u32x4;
using pg8::pack4;
using pg8::Unit;
#define LAS __attribute__((address_space(3)))
#define GAS __attribute__((address_space(1)))

__device__ __forceinline__ void tile_of(int L, int nM, int nN, int& pm, int& pn) {
    const int nwg = nM * nN; int wgid = L;
    { const int q = nwg / pg8::NXCD, r = nwg % pg8::NXCD, xcd = wgid % pg8::NXCD, off = wgid / pg8::NXCD; wgid = (xcd < r ? xcd * (q + 1) : r * (q + 1) + (xcd - r) * q) + off; }
    const int nig = pg8::WGM * nN, gid = wgid / nig, fm = gid * pg8::WGM, gsz = (nM - fm) < pg8::WGM ? (nM - fm) : pg8::WGM;
    pm = fm + ((wgid % nig) % gsz); pn = (wgid % nig) / gsz;
}
struct DenseOrder {
    int nM, nN, nwg, G, c; const char* A; const char* B; size_t tstep;
    __device__ __forceinline__ void init(int M, int N, int K, int G_, int c_, const void* A_, const void* B_) { nM = M / 256; nN = N / 256; nwg = nM * nN; G = G_; c = c_; A = (const char*)A_; B = (const char*)B_; tstep = (size_t)256 * K * 2; }
    __device__ __forceinline__ bool next(int i, Unit& u) const { const long L = (long)i * G + c; if (L >= nwg) return false; tile_of((int)L, nM, nN, u.pm, u.pn); u.aux = 0; return true; }
    __device__ __forceinline__ const char* a_ptr(const Unit& u) const { return A + (size_t)u.pm * tstep; }
    __device__ __forceinline__ const char* b_ptr(const Unit& u) const { return B + (size_t)u.pn * tstep; }
    __device__ __forceinline__ void a_ready(const Unit&) const {}
    __device__ __forceinline__ void done(const Unit&) const {}
};
struct BranchOrder {
    int G, c; const char *A, *B; size_t tstep, astride, bstride;
    __device__ __forceinline__ bool next(int i, Unit& u) const { const int ti = i / 3, br = i - 3 * ti; const long L = (long)ti * G + c; if (L >= 128 * 4) return false; tile_of((int)L, 128, 4, u.pm, u.pn); u.aux = br; return true; }
    __device__ __forceinline__ const char* a_ptr(const Unit& u) const { return A + (size_t)u.aux * astride + (size_t)u.pm * tstep; }
    __device__ __forceinline__ const char* b_ptr(const Unit& u) const { return B + (size_t)u.aux * bstride + (size_t)u.pn * tstep; }
    __device__ __forceinline__ void a_ready(const Unit&) const {}
    __device__ __forceinline__ void done(const Unit&) const {}
};
struct MoeOrder {
    int G, c, T, NPN; const char* A; const char* B; size_t tstep; const LAS int* tile_e;
    __device__ __forceinline__ bool next(int i, Unit& u) const {
        const int L = i * G + c, x = L & 7, y = L >> 3, tp = y / NPN, pn = y - tp * NPN, t = 8 * tp + x;
        if (t >= T) return false;
        u.pm = t; u.pn = pn; u.aux = __builtin_amdgcn_readfirstlane(tile_e[t]); return true;
    }
    __device__ __forceinline__ const char* a_ptr(const Unit& u) const { return A + (size_t)u.pm * tstep; }
    __device__ __forceinline__ const char* b_ptr(const Unit& u) const { return B + (size_t)(u.aux * NPN + u.pn) * tstep; }
    __device__ __forceinline__ void a_ready(const Unit&) const {}
    __device__ __forceinline__ void done(const Unit&) const {}
};

typedef const pg8::f32x4 (&AccRef)[2][2][4][2];
__device__ __forceinline__ float fast_sigmoid(float x) { return __builtin_amdgcn_rcpf(1.f + __builtin_amdgcn_exp2f(-x * LOG2E)); }
__device__ __forceinline__ f32x4 sigmoid4(f32x4 v) { f32x4 r; r[0] = fast_sigmoid(v[0]); r[1] = fast_sigmoid(v[1]); r[2] = fast_sigmoid(v[2]); r[3] = fast_sigmoid(v[3]); return r; }
__device__ __forceinline__ float ssq4(f32x4 v) { return (v[0] * v[0] + v[1] * v[1]) + (v[2] * v[2] + v[3] * v[3]); }
__device__ __forceinline__ float quad_sum(float s) { s += __shfl_xor(s, 16); s += __shfl_xor(s, 32); return s; }

struct EpiInProj {
    static constexpr bool PERM = false, AFTER_DRAIN = false;
    bf16_t *Qa, *Ka, *Va, *Qlat, *KVlat, *Kb, *Qm, *Gates; float* ssq;
    const float *qn, *kn, *bgate, *ropeA, *ropeB;
    __device__ __forceinline__ void operator()(AccRef acc, const Unit& u, int wr, int wc, int fr, int fq) const {
        const int pn = u.pn, rowb = u.pm * 256 + wr * 64 + fr;
        if (pn <= 2) {
            if (pn == 2 && wc >= 2) {
#pragma unroll
                for (int ai = 0; ai < 2; ++ai)
#pragma unroll
                    for (int m = 0; m < 4; ++m) { const int row = rowb + ai * 128 + m * 16; bf16_t* d = Va + (unsigned)row * 128 + (wc - 2) * 64 + 4 * fq;
#pragma unroll
                        for (int bj = 0; bj < 2; ++bj)
#pragma unroll
                            for (int n = 0; n < 2; ++n) *(u32x2*)(d + 32 * bj + 16 * n) = pack4(acc[ai][bj][m][n]); }
            } else {
                const float* gain = pn < 2 ? qn : kn; const int pitch = pn < 2 ? 512 : 128;
                bf16_t* dst = pn < 2 ? Qa + (4 * pn + wc) * 64 : Ka + wc * 64;
                f32x4 g[2][2];
#pragma unroll
                for (int bj = 0; bj < 2; ++bj)
#pragma unroll
                    for (int n = 0; n < 2; ++n) g[bj][n] = *(const f32x4*)(gain + 32 * bj + 16 * n + 4 * fq);
#pragma unroll
                for (int ai = 0; ai < 2; ++ai)
#pragma unroll
                    for (int m = 0; m < 4; ++m) {
                        const int row = rowb + ai * 128 + m * 16, t = row & (SEQ - 1), rp = t >> 6, cp = t & 63;
                        float ss = (ssq4(acc[ai][0][m][0]) + ssq4(acc[ai][0][m][1])) + (ssq4(acc[ai][1][m][0]) + ssq4(acc[ai][1][m][1]));
                        ss = quad_sum(ss);
                        const float rinv = 1.0f / sqrtf(ss * (1.0f / 64.0f) + RMS_EPS);
                        bf16_t* d = dst + (unsigned)row * pitch + 4 * fq;
#pragma unroll
                        for (int bj = 0; bj < 2; ++bj) { const int pos = bj ? cp : rp;
                            const f32x4 c4 = *(const f32x4*)(ropeA + pos * 16 + 4 * fq), s4 = *(const f32x4*)(ropeA + 1024 + pos * 16 + 4 * fq);
                            const f32x4 x1 = acc[ai][bj][m][0] * rinv * g[bj][0], x2 = acc[ai][bj][m][1] * rinv * g[bj][1];
                            *(u32x2*)(d + 32 * bj) = pack4(x1 * c4 - x2 * s4); *(u32x2*)(d + 32 * bj + 16) = pack4(x2 * c4 + x1 * s4); }
                    }
            }
        } else if (pn == 3 || pn == 5) {
            bf16_t* dst = pn == 3 ? Qlat : KVlat; const int pitch = pn == 3 ? QLAT : KVLAT, slot = (pn == 3 ? 0 : 8) + wc;
#pragma unroll
            for (int ai = 0; ai < 2; ++ai)
#pragma unroll
                for (int m = 0; m < 4; ++m) { const int row = rowb + ai * 128 + m * 16; bf16_t* d = dst + (unsigned)row * pitch + 32 * wc + 4 * fq;
                    float ss = (ssq4(acc[ai][0][m][0]) + ssq4(acc[ai][0][m][1])) + (ssq4(acc[ai][1][m][0]) + ssq4(acc[ai][1][m][1]));
                    ss = quad_sum(ss); if (fq == 0) ssq[(unsigned)row * 12 + slot] = ss;
#pragma unroll
                    for (int bj = 0; bj < 2; ++bj)
#pragma unroll
                        for (int n = 0; n < 2; ++n) *(u32x2*)(d + 128 * bj + 16 * n) = pack4(acc[ai][bj][m][n]); }
        } else if (pn == 4) {
#pragma unroll
            for (int ai = 0; ai < 2; ++ai)
#pragma unroll
                for (int m = 0; m < 4; ++m) { const int row = rowb + ai * 128 + m * 16; bf16_t* d = Qlat + (unsigned)row * QLAT + 256 + 32 * wc + 4 * fq;
                    float ss = ssq4(acc[ai][0][m][0]) + ssq4(acc[ai][0][m][1]);
                    ss = quad_sum(ss); if (fq == 0) ssq[(unsigned)row * 12 + 4 + wc] = ss;
#pragma unroll
                    for (int n = 0; n < 2; ++n) *(u32x2*)(d + 16 * n) = pack4(acc[ai][0][m][n]);
                    if (wc == 0) { const int t = row & (SEQ - 1), a = fq >> 1, pos = a ? (t & 63) : (t >> 6), i0 = 4 * (fq & 1);
                        const f32x4 c4 = *(const f32x4*)(ropeB + pos * 8 + i0), s4 = *(const f32x4*)(ropeB + 512 + pos * 8 + i0);
                        const f32x4 x1 = acc[ai][1][m][0], x2 = acc[ai][1][m][1];
                        const u32x2 o1 = pack4(x1 * c4 - x2 * s4), o2 = pack4(x2 * c4 + x1 * s4);
                        bf16_t* kd = Kb + (unsigned)row * 768 + 64 + 16 * a + i0;
#pragma unroll
                        for (int h = 0; h < 8; ++h) { *(u32x2*)(kd + h * 96) = o1; *(u32x2*)(kd + h * 96 + 8) = o2; } }
                }
        } else if (pn <= 7) {
#pragma unroll
            for (int ai = 0; ai < 2; ++ai)
#pragma unroll
                for (int m = 0; m < 4; ++m) { const int row = rowb + ai * 128 + m * 16; bf16_t* d = Qm + (unsigned)row * 512 + (pn - 6) * 256 + 32 * wc + 4 * fq;
#pragma unroll
                    for (int bj = 0; bj < 2; ++bj)
#pragma unroll
                        for (int n = 0; n < 2; ++n) *(u32x2*)(d + 128 * bj + 16 * n) = pack4(acc[ai][bj][m][n]); }
        } else {
            const int col0 = (pn - 8) * 256 + 32 * wc + 4 * fq; f32x4 bv[2][2];
#pragma unroll
            for (int bj = 0; bj < 2; ++bj)
#pragma unroll
                for (int n = 0; n < 2; ++n) bv[bj][n] = *(const f32x4*)(bgate + col0 + 128 * bj + 16 * n);
#pragma unroll
            for (int ai = 0; ai < 2; ++ai)
#pragma unroll
                for (int m = 0; m < 4; ++m) { const int row = rowb + ai * 128 + m * 16; bf16_t* d = Gates + (unsigned)row * 3072 + col0;
#pragma unroll
                    for (int bj = 0; bj < 2; ++bj)
#pragma unroll
                        for (int n = 0; n < 2; ++n) *(u32x2*)(d + 128 * bj + 16 * n) = pack4(sigmoid4(acc[ai][bj][m][n] + bv[bj][n])); }
        }
    }
};
struct EpiQb {
    static constexpr bool PERM = false, AFTER_DRAIN = false;
    bf16_t* Qb; const float* ssq; const float* ropeB;
    __device__ __forceinline__ void operator()(AccRef acc, const Unit& u, int wr, int wc, int fr, int fq) const {
        const int pn = u.pn, rowb = u.pm * 256 + wr * 64 + fr;
#pragma unroll
        for (int ai = 0; ai < 2; ++ai)
#pragma unroll
            for (int m = 0; m < 4; ++m) { const int row = rowb + ai * 128 + m * 16;
                const f32x4 s0 = *(const f32x4*)(ssq + (unsigned)row * 12), s1 = *(const f32x4*)(ssq + (unsigned)row * 12 + 4);
                const float tot = ((s0[0] + s0[1]) + (s0[2] + s0[3])) + ((s1[0] + s1[1]) + (s1[2] + s1[3]));
                const float rinv = 1.0f / sqrtf(tot * (1.0f / (float)QLAT) + RMS_EPS);
                if (pn < 2) {
#pragma unroll
                    for (int bj = 0; bj < 2; ++bj)
#pragma unroll
                        for (int n = 0; n < 2; ++n) { const int c = 128 * bj + 32 * wc + 16 * n + 4 * fq, head = 4 * pn + (c >> 6), d = c & 63;
                            *(u32x2*)(Qb + (unsigned)row * 768 + head * 96 + d) = pack4(acc[ai][bj][m][n] * rinv); }
                } else { const int t = row & (SEQ - 1), a = fq >> 1, pos = a ? (t & 63) : (t >> 6), i0 = 4 * (fq & 1);
                    const f32x4 c4 = *(const f32x4*)(ropeB + pos * 8 + i0), s4 = *(const f32x4*)(ropeB + 512 + pos * 8 + i0);
#pragma unroll
                    for (int bj = 0; bj < 2; ++bj) { const f32x4 x1 = acc[ai][bj][m][0] * rinv, x2 = acc[ai][bj][m][1] * rinv;
                        bf16_t* qd = Qb + (unsigned)row * 768 + (4 * bj + wc) * 96 + 64 + 16 * a + i0;
                        *(u32x2*)qd = pack4(x1 * c4 - x2 * s4); *(u32x2*)(qd + 8) = pack4(x2 * c4 + x1 * s4); }
                }
            }
    }
};
struct EpiKVb {
    static constexpr bool PERM = false, AFTER_DRAIN = false;
    bf16_t *Kb, *Vb; const float* ssq;
    __device__ __forceinline__ void operator()(AccRef acc, const Unit& u, int wr, int wc, int fr, int fq) const {
        const int pn = u.pn, rowb = u.pm * 256 + wr * 64 + fr;
#pragma unroll
        for (int ai = 0; ai < 2; ++ai)
#pragma unroll
            for (int m = 0; m < 4; ++m) { const int row = rowb + ai * 128 + m * 16;
                const f32x4 s0 = *(const f32x4*)(ssq + (unsigned)row * 12 + 8);
                const float rinv = 1.0f / sqrtf(((s0[0] + s0[1]) + (s0[2] + s0[3])) * (1.0f / (float)KVLAT) + RMS_EPS);
#pragma unroll
                for (int bj = 0; bj < 2; ++bj) { const int h = 2 * pn + bj;
#pragma unroll
                    for (int n = 0; n < 2; ++n) { const int dd = 32 * wc + 16 * n + 4 * fq;
                        bf16_t* d = (wc < 2) ? Kb + (unsigned)row * 768 + h * 96 + dd : Vb + (unsigned)row * 512 + h * 64 + (dd - 64);
                        *(u32x2*)d = pack4(acc[ai][bj][m][n] * rinv); } }
            }
    }
};
struct EpiPlain {
    static constexpr bool PERM = false, AFTER_DRAIN = false;
    bf16_t* O; int ldc;
    __device__ __forceinline__ void operator()(AccRef acc, const Unit& u, int wr, int wc, int fr, int fq) const {
        const int rowb = u.pm * 256 + wr * 64 + fr, col0 = u.pn * 256 + 32 * wc + 4 * fq;
#pragma unroll
        for (int ai = 0; ai < 2; ++ai)
#pragma unroll
            for (int m = 0; m < 4; ++m) { bf16_t* d = O + (unsigned)(rowb + ai * 128 + m * 16) * (unsigned)ldc + col0;
#pragma unroll
                for (int bj = 0; bj < 2; ++bj)
#pragma unroll
                    for (int n = 0; n < 2; ++n) *(u32x2*)(d + 128 * bj + 16 * n) = pack4(acc[ai][bj][m][n]); }
    }
};
struct EpiBranch {
    static constexpr bool PERM = false, AFTER_DRAIN = false;
    const bf16_t* Gates; float* Macc; bf16_t* Merged;
    __device__ __forceinline__ void operator()(AccRef acc, const Unit& u, int wr, int wc, int fr, int fq) const {
        const int br = u.aux, rowb = u.pm * 256 + wr * 64 + fr, col0 = u.pn * 256 + 32 * wc + 4 * fq;
#pragma unroll
        for (int ai = 0; ai < 2; ++ai)
#pragma unroll
            for (int m = 0; m < 4; ++m) { const int row = rowb + ai * 128 + m * 16;
#pragma unroll
                for (int bj = 0; bj < 2; ++bj)
#pragma unroll
                    for (int n = 0; n < 2; ++n) { const int col = col0 + 128 * bj + 16 * n;
                        const u32x2 gw = *(const u32x2*)(Gates + (unsigned)row * 3072 + br * 1024 + col);
                        f32x4 g; g[0] = __uint_as_float(gw.x << 16); g[1] = __uint_as_float(gw.x & 0xffff0000u); g[2] = __uint_as_float(gw.y << 16); g[3] = __uint_as_float(gw.y & 0xffff0000u);
                        f32x4 v = acc[ai][bj][m][n] * g; float* mp = Macc + (unsigned)row * 1024 + col;
                        if (br > 0) v = v + *(const f32x4*)mp;
                        if (br < 2) *(f32x4*)mp = v; else *(u32x2*)(Merged + (unsigned)row * 1024 + col) = pack4(v); }
            }
    }
};
struct EpiOutProj {
    static constexpr bool PERM = false, AFTER_DRAIN = false;
    const float* x; const float* stats0; const float* g; const float* b; float* pre;
    __device__ __forceinline__ void operator()(AccRef acc, const Unit& u, int wr, int wc, int fr, int fq) const {
        const int rowb = u.pm * 256 + wr * 64 + fr, col0 = u.pn * 256 + 32 * wc + 4 * fq; f32x4 gv[2][2], bv[2][2];
#pragma unroll
        for (int bj = 0; bj < 2; ++bj)
#pragma unroll
            for (int n = 0; n < 2; ++n) { gv[bj][n] = *(const f32x4*)(g + col0 + 128 * bj + 16 * n); bv[bj][n] = *(const f32x4*)(b + col0 + 128 * bj + 16 * n); }
#pragma unroll
        for (int ai = 0; ai < 2; ++ai)
#pragma unroll
            for (int m = 0; m < 4; ++m) { const int row = rowb + ai * 128 + m * 16; const f32x2 st = *(const f32x2*)(stats0 + (unsigned)row * 2);
#pragma unroll
                for (int bj = 0; bj < 2; ++bj)
#pragma unroll
                    for (int n = 0; n < 2; ++n) { const size_t off = (unsigned)row * 1024 + col0 + 128 * bj + 16 * n;
                        const f32x4 xv = *(const f32x4*)(x + off); const f32x4 h0 = (xv - st.x) * st.y * gv[bj][n] + bv[bj][n];
                        *(f32x4*)(pre + off) = h0 * DN_ALPHA + acc[ai][bj][m][n]; }
            }
    }
};
struct EpiSwiglu {
    static constexpr bool PERM = false, AFTER_DRAIN = false;
    const float* bin; bf16_t* Act;
    __device__ __forceinline__ void operator()(AccRef acc, const Unit& u, int wr, int wc, int fr, int fq) const {
        const int e = u.aux, rowb = u.pm * 256 + wr * 64 + fr, col0 = u.pn * 128 + 32 * wc + 4 * fq; f32x4 bg[2], bl[2];
#pragma unroll
        for (int n = 0; n < 2; ++n) { bg[n] = *(const f32x4*)(bin + (size_t)e * 2048 + col0 + 16 * n); bl[n] = *(const f32x4*)(bin + (size_t)e * 2048 + 1024 + col0 + 16 * n); }
#pragma unroll
        for (int ai = 0; ai < 2; ++ai)
#pragma unroll
            for (int m = 0; m < 4; ++m) { const int row = rowb + ai * 128 + m * 16;
#pragma unroll
                for (int n = 0; n < 2; ++n) { const f32x4 hg = acc[ai][0][m][n] + bg[n], hl = acc[ai][1][m][n] + bl[n]; f32x4 o;
#pragma unroll
                    for (int j = 0; j < 4; ++j) { const float xg = fminf(hg[j], 7.0f), xl = fminf(fmaxf(hl[j], -7.0f), 7.0f); o[j] = xg * fast_sigmoid(1.702f * xg) * (xl + 1.0f); }
                    *(u32x2*)(Act + (unsigned)row * 1024 + col0 + 16 * n) = pack4(o); }
            }
    }
};
struct EpiExpOut {
    static constexpr bool PERM = false, AFTER_DRAIN = false;
    const float* bout; const float* rank_w; const LAS int* tstart; bf16_t* Ys;
    __device__ __forceinline__ void operator()(AccRef acc, const Unit& u, int wr, int wc, int fr, int fq) const {
        const int e = u.aux, rl = wr * 64 + fr, rowb = u.pm * 256 + rl, col0 = u.pn * 256 + 32 * wc + 4 * fq; f32x4 bv[2][2];
        const int rank0 = (u.pm - __builtin_amdgcn_readfirstlane(tstart[e])) * 256 + rl;
#pragma unroll
        for (int bj = 0; bj < 2; ++bj)
#pragma unroll
            for (int n = 0; n < 2; ++n) bv[bj][n] = *(const f32x4*)(bout + (size_t)e * 1024 + col0 + 128 * bj + 16 * n);
#pragma unroll
        for (int ai = 0; ai < 2; ++ai)
#pragma unroll
            for (int m = 0; m < 4; ++m) { const int row = rowb + ai * 128 + m * 16; const float w = rank_w[(size_t)e * NTOK + rank0 + ai * 128 + m * 16];
#pragma unroll
                for (int bj = 0; bj < 2; ++bj)
#pragma unroll
                    for (int n = 0; n < 2; ++n) *(u32x2*)(Ys + (unsigned)row * 1024 + col0 + 128 * bj + 16 * n) = pack4((acc[ai][bj][m][n] + bv[bj][n]) * w); }
    }
};

namespace att {
using bf16x8 = __attribute__((ext_vector_type(8))) short;
using s16x4  = __attribute__((ext_vector_type(4))) short;
using f32x16 = __attribute__((ext_vector_type(16))) float;
#define ASBAR() __builtin_amdgcn_sched_barrier(0)
__device__ __forceinline__ int crow(int r, int hi) { return (r & 3) + 8 * (r >> 2) + 4 * hi; }
__device__ __forceinline__ unsigned cvtpk(float lo, float hi) { unsigned r; asm volatile("v_cvt_pk_bf16_f32 %0, %1, %2" : "=v"(r) : "v"(lo), "v"(hi)); return r; }
constexpr float THR = 8.f;
__device__ __forceinline__ void partialSM(f32x16& p0, f32x16& p1, float& m_reg, float& mn, float& alpha, float C, float thr_raw) {
  float pmax = p0[0];
#pragma unroll
  for (int r = 1; r < 16; ++r) pmax = fmaxf(pmax, p0[r]);
#pragma unroll
  for (int r = 0; r < 16; ++r) pmax = fmaxf(pmax, p1[r]);
  { auto rr = __builtin_amdgcn_permlane32_swap(__float_as_uint(pmax), __float_as_uint(pmax), false, false);
    pmax = fmaxf(__uint_as_float(rr[0]), __uint_as_float(rr[1])); }
  if (__builtin_expect(__all(pmax - m_reg <= thr_raw), 1)) { mn = m_reg; alpha = 1.f; }
  else { mn = fmaxf(m_reg, pmax); alpha = __builtin_amdgcn_exp2f((m_reg - mn) * C); m_reg = mn; }
  const float mnC = -mn * C;
#pragma unroll
  for (int r = 0; r < 16; ++r) p0[r] = fmaf(p0[r], C, mnC);
#pragma unroll
  for (int r = 0; r < 16; ++r) p1[r] = fmaf(p1[r], C, mnC);
#pragma unroll
  for (int r = 0; r < 16; ++r) p0[r] = __builtin_amdgcn_exp2f(p0[r]);
}
__device__ __forceinline__ void finishSM(f32x16& p0, f32x16& p1, float alpha, float& l_reg, bf16x8& pa0, bf16x8& pa1, bf16x8& pa2, bf16x8& pa3) {
#pragma unroll
  for (int r = 0; r < 16; ++r) p1[r] = __builtin_amdgcn_exp2f(p1[r]);
  float ps = 0;
#pragma unroll
  for (int r = 0; r < 16; ++r) ps += p0[r];
#pragma unroll
  for (int r = 0; r < 16; ++r) ps += p1[r];
  { auto rr = __builtin_amdgcn_permlane32_swap(__float_as_uint(ps), __float_as_uint(ps), false, false);
    ps = __uint_as_float(rr[0]) + __uint_as_float(rr[1]); }
  l_reg = l_reg * alpha + ps;
#define ATT_PK4(P, BASE, OUT) do { unsigned a0 = cvtpk(P[BASE + 0], P[BASE + 1]), a1 = cvtpk(P[BASE + 2], P[BASE + 3]);   \
    unsigned b0 = cvtpk(P[BASE + 4], P[BASE + 5]), b1 = cvtpk(P[BASE + 6], P[BASE + 7]);                              \
    auto r0 = __builtin_amdgcn_permlane32_swap(a0, b0, false, false); auto r1 = __builtin_amdgcn_permlane32_swap(a1, b1, false, false); \
    u32x4 w = {r0[0], r1[0], r0[1], r1[1]}; OUT = *reinterpret_cast<bf16x8*>(&w); } while (0)
  ATT_PK4(p0, 0, pa0); ATT_PK4(p0, 8, pa1); ATT_PK4(p1, 0, pa2); ATT_PK4(p1, 8, pa3);
#undef ATT_PK4
}
template <int DQK> __device__ __forceinline__ void qkt(f32x16& p0, f32x16& p1, const char* Ks, const bf16x8* qr, int r32, int hi) {
  constexpr int KROW = DQK * 2 + 16;
  p0 = f32x16{}; p1 = f32x16{};
#pragma unroll
  for (int d0 = 0; d0 < DQK / 16; ++d0) { const int cb = (d0 * 16 + hi * 8) * 2;
    const bf16x8 b0 = *reinterpret_cast<const bf16x8*>(Ks + r32 * KROW + cb);
    const bf16x8 b1 = *reinterpret_cast<const bf16x8*>(Ks + (32 + r32) * KROW + cb);
    p0 = __builtin_amdgcn_mfma_f32_32x32x16_bf16(b0, qr[d0], p0, 0, 0, 0);
    p1 = __builtin_amdgcn_mfma_f32_32x32x16_bf16(b1, qr[d0], p1, 0, 0, 0); }
}
template <int NCG> __device__ __forceinline__ int v_st(int k, int c) { const int kk = (k & ~0xC) | ((k & 4) << 1) | ((k & 8) >> 1); return ((kk >> 3) * NCG + (c >> 5)) * 512 + ((kk & 7) * 32 + (c & 31)) * 2; }
__device__ __forceinline__ int v_rd_base(int lane) { return ((lane & 3) << 3) | (((lane >> 2) & 3) << 6) | (((lane >> 4) & 1) << 5) | (((lane >> 5) & 1) << 8); }
template <int OFF> __device__ __forceinline__ s16x4 tr_read(int vb) { s16x4 r; asm volatile("ds_read_b64_tr_b16 %0, %1 offset:%2" : "=&v"(r) : "v"(vb), "i"(OFF) : "memory"); return r; }
template <int D0, int NCG> __device__ __forceinline__ void pv_one(f32x16& od, int vb, bf16x8 pa0, bf16x8 pa1, bf16x8 pa2, bf16x8 pa3) {
  constexpr int KS = 2 * NCG * 512, HF = NCG * 512, B = D0 * 512;
  const s16x4 l0 = tr_read<B + 0 * KS>(vb), h0 = tr_read<B + 0 * KS + HF>(vb), l1 = tr_read<B + 1 * KS>(vb), h1 = tr_read<B + 1 * KS + HF>(vb);
  const s16x4 l2 = tr_read<B + 2 * KS>(vb), h2 = tr_read<B + 2 * KS + HF>(vb), l3 = tr_read<B + 3 * KS>(vb), h3 = tr_read<B + 3 * KS + HF>(vb);
  asm volatile("s_waitcnt lgkmcnt(0)" ::: "memory"); ASBAR();
#define ATT_PK(L, H) (bf16x8){L[0], L[1], L[2], L[3], H[0], H[1], H[2], H[3]}
  od = __builtin_amdgcn_mfma_f32_32x32x16_bf16(pa0, ATT_PK(l0, h0), od, 0, 0, 0);
  od = __builtin_amdgcn_mfma_f32_32x32x16_bf16(pa1, ATT_PK(l1, h1), od, 0, 0, 0);
  od = __builtin_amdgcn_mfma_f32_32x32x16_bf16(pa2, ATT_PK(l2, h2), od, 0, 0, 0);
  od = __builtin_amdgcn_mfma_f32_32x32x16_bf16(pa3, ATT_PK(l3, h3), od, 0, 0, 0);
#undef ATT_PK
}
template <int NCG> __device__ __forceinline__ void pv_all(f32x16* o, int vb, bf16x8 pa0, bf16x8 pa1, bf16x8 pa2, bf16x8 pa3) {
  pv_one<0, NCG>(o[0], vb, pa0, pa1, pa2, pa3); pv_one<1, NCG>(o[1], vb, pa0, pa1, pa2, pa3);
  if constexpr (NCG == 4) { pv_one<2, NCG>(o[2], vb, pa0, pa1, pa2, pa3); pv_one<3, NCG>(o[3], vb, pa0, pa1, pa2, pa3); }
}
template <int DQK, int DV> struct Cfg {
  static constexpr int KROW = DQK * 2 + 16, SHM_K = 64 * KROW, SHM_V = 64 * DV * 2, NCG = DV / 32, KCH = DQK / 8, VCH = DV / 8;
  static constexpr int KPT = (64 * KCH + 511) / 512, VPT = (64 * VCH + 511) / 512, LDS = 2 * SHM_V + 2 * SHM_K + 8 * 64 * 4;
};
template <int DQK, int DV, int LDQ, int LDK, int LDV, int LDO>
__device__ __forceinline__ void attn_body(const bf16_t* Qb, const bf16_t* __restrict__ Kh, const bf16_t* __restrict__ Vh, bf16_t* Ob, int seq, float C, float thr_raw, char* lds) {
  using CF = Cfg<DQK, DV>;
  constexpr int KROW = CF::KROW, SHM_K = CF::SHM_K, SHM_V = CF::SHM_V, NCG = CF::NCG, KCH = CF::KCH, VCH = CF::VCH, KPT = CF::KPT, VPT = CF::VPT, ND0 = DQK / 16, NDB = DV / 32, SDEPTH = 2;
  int tid_ = threadIdx.x; asm volatile("" : "+v"(tid_));
  const int tid = tid_, wid = tid >> 6, lane = tid & 63, r32 = lane & 31, hi = lane >> 5;
  char* V_lds = lds; char* K_lds = lds + 2 * SHM_V;
  float* ws = (float*)(lds + 2 * SHM_V + 2 * SHM_K) + wid * 64; float* li_l = ws; float* al_l = ws + 32;
  float m_reg = -1e30f, l_reg = 0; f32x16 o[NDB]; bf16x8 qr[ND0];
#pragma unroll
  for (int d = 0; d < NDB; ++d) o[d] = f32x16{};
  const bf16_t* Qw = Qb + (long)(wid * 32 + r32) * LDQ + hi * 8;
#pragma unroll
  for (int d0 = 0; d0 < ND0; ++d0) qr[d0] = *reinterpret_cast<const bf16x8*>(Qw + d0 * 16);
  int kgo[KPT], klo[KPT], vgo[VPT], vlo[VPT]; bool kval[KPT];
#pragma unroll
  for (int j = 0; j < KPT; ++j) { const int p = tid + 512 * j, row = p / KCH, ch = p - row * KCH; kval[j] = p < 64 * KCH; kgo[j] = row * LDK + ch * 8; klo[j] = row * KROW + ch * 16; }
#pragma unroll
  for (int j = 0; j < VPT; ++j) { const int p = tid + 512 * j, key = p / VCH, c = (p - key * VCH) * 8; vgo[j] = key * LDV + c; vlo[j] = v_st<NCG>(key, c); }
  const int vb0 = (int)(uintptr_t)V_lds + v_rd_base(lane);
  bf16x8 sk[SDEPTH][KPT], sv[SDEPTH][VPT];
#define ATT_SLOAD(i, k0) do { _Pragma("unroll") for (int j_ = 0; j_ < VPT; ++j_) sv[i][j_] = *reinterpret_cast<const bf16x8*>(Vh + (long)(k0) * LDV + vgo[j_]); \
    _Pragma("unroll") for (int j_ = 0; j_ < KPT; ++j_) if (kval[j_]) sk[i][j_] = *reinterpret_cast<const bf16x8*>(Kh + (long)(k0) * LDK + kgo[j_]); } while (0)
#define ATT_SWRITE(b, i) do { _Pragma("unroll") for (int j_ = 0; j_ < VPT; ++j_) *reinterpret_cast<bf16x8*>(V_lds + (b) * SHM_V + vlo[j_]) = sv[i][j_]; \
    _Pragma("unroll") for (int j_ = 0; j_ < KPT; ++j_) if (kval[j_]) *reinterpret_cast<bf16x8*>(K_lds + (b) * SHM_K + klo[j_]) = sk[i][j_]; } while (0)
#define ATT_SWAIT() asm volatile("s_waitcnt vmcnt(%0)" :: "n"(KPT + VPT) : "memory")
#define ATT_RESC(a) do { if (__any((a) < 1.f)) { if (hi == 0) al_l[r32] = (a); asm volatile("s_waitcnt lgkmcnt(0)" ::: "memory"); \
    _Pragma("unroll") for (int d_ = 0; d_ < NDB; ++d_) _Pragma("unroll") for (int r_ = 0; r_ < 16; ++r_) o[d_][r_] *= al_l[crow(r_, hi)]; } } while (0)
  f32x16 pA0, pA1, pB0, pB1; float mnA, mnB, alA, alB; bf16x8 pa0, pa1, pa2, pa3; const int NT = seq / 64;
  constexpr int SE = 0, SO = SDEPTH - 1;
  ATT_SLOAD(SE, 0); asm volatile("s_waitcnt vmcnt(0)" ::: "memory"); ATT_SWRITE(0, SE); __syncthreads();
  qkt<DQK>(pA0, pA1, K_lds, qr, r32, hi); partialSM(pA0, pA1, m_reg, mnA, alA, C, thr_raw);
  ATT_SLOAD(SO, 64); if (2 < NT) ATT_SLOAD(SE, 2 * 64);
  ATT_SWAIT(); ATT_SWRITE(1, SO); __syncthreads();
  for (int j = 1; j + 1 < NT; j += 2) {
    ASBAR(); qkt<DQK>(pB0, pB1, K_lds + SHM_K, qr, r32, hi);
    finishSM(pA0, pA1, alA, l_reg, pa0, pa1, pa2, pa3); ASBAR();
    ATT_SLOAD(SO, (j + SDEPTH) * 64); ASBAR();
    pv_all<NCG>(o, vb0, pa0, pa1, pa2, pa3); partialSM(pB0, pB1, m_reg, mnB, alB, C, thr_raw);
    __syncthreads(); ATT_SWAIT(); ATT_SWRITE(0, SE);
    ATT_RESC(alB); __syncthreads();
    ASBAR(); qkt<DQK>(pA0, pA1, K_lds, qr, r32, hi);
    finishSM(pB0, pB1, alB, l_reg, pa0, pa1, pa2, pa3); ASBAR();
    if (j + 3 < NT) ATT_SLOAD(SE, (j + 1 + SDEPTH) * 64); ASBAR();
    pv_all<NCG>(o, vb0 + SHM_V, pa0, pa1, pa2, pa3); partialSM(pA0, pA1, m_reg, mnA, alA, C, thr_raw);
    __syncthreads(); ATT_SWAIT(); ATT_SWRITE(1, SO);
    ATT_RESC(alA); __syncthreads();
  }
  ASBAR(); qkt<DQK>(pB0, pB1, K_lds + SHM_K, qr, r32, hi);
  finishSM(pA0, pA1, alA, l_reg, pa0, pa1, pa2, pa3); ASBAR();
  pv_all<NCG>(o, vb0, pa0, pa1, pa2, pa3); partialSM(pB0, pB1, m_reg, mnB, alB, C, thr_raw);
  __syncthreads(); ATT_RESC(alB);
  finishSM(pB0, pB1, alB, l_reg, pa0, pa1, pa2, pa3); ASBAR();
  pv_all<NCG>(o, vb0 + SHM_V, pa0, pa1, pa2, pa3);
  if (hi == 0) li_l[r32] = l_reg; asm volatile("s_waitcnt lgkmcnt(0)" ::: "memory");
  float rli[16];
#pragma unroll
  for (int r = 0; r < 16; ++r) rli[r] = __builtin_amdgcn_rcpf(li_l[crow(r, hi)]);
  bf16_t* Ow = Ob + (long)(wid * 32) * LDO;
#pragma unroll
  for (int r = 0; r < 16; ++r) { const int orow = crow(r, hi);
#pragma unroll
    for (int d0 = 0; d0 < NDB; ++d0) { const unsigned w = cvtpk(o[d0][r] * rli[r], 0.f); Ow[(long)orow * LDO + d0 * 32 + r32] = (bf16_t)(w & 0xffffu); } }
  __syncthreads();
#undef ATT_SLOAD
#undef ATT_SWRITE
#undef ATT_SWAIT
#undef ATT_RESC
}
#undef ASBAR
}

constexpr int NWAVES = 8;
constexpr int NPHASE = 11;
#ifndef MK_N_LAUNCHES
#define MK_N_LAUNCHES 11
#endif
constexpr int N_LAUNCHES = MK_N_LAUNCHES;
static_assert(N_LAUNCHES == 1 || N_LAUNCHES == NPHASE, "1 or 11 launches");

constexpr size_t MiB = 1u << 20;
constexpr size_t WS_CTL = 0, CTL_ZERO_BYTES = 1 * MiB;
constexpr size_t WS_STATS0 = 1 * MiB, WS_STATS1 = WS_STATS0 + 256 * 1024, WS_ROPEA = WS_STATS1 + 256 * 1024, WS_ROPEB = WS_ROPEA + 8192;
constexpr size_t WS_SSQ = 2 * MiB, WS_TOKER = 4 * MiB, WS_RTOK = 5 * MiB, WS_RW = 10 * MiB;
constexpr size_t WS_WIN = 16 * MiB, WS_WQB = 26 * MiB, WS_WKVB = 27 * MiB, WS_WMEM = 28 * MiB, WS_WBR = 30 * MiB, WS_WOUT = 33 * MiB;
constexpr size_t WS_MEMB = 36 * MiB, WS_MKV = 40 * MiB, WS_W1 = 44 * MiB, WS_W2 = 172 * MiB;
constexpr size_t WS_H0 = 236 * MiB, WS_H1 = WS_H0;
constexpr size_t WS_QA = 300 * MiB, WS_OB = 332 * MiB, WS_QM = 364 * MiB, WS_KA = 396 * MiB, WS_VA = 404 * MiB, WS_QLAT = 412 * MiB, WS_KVLAT = 436 * MiB, WS_GATES = 452 * MiB;
constexpr size_t WS_QB = 644 * MiB, WS_KB = 692 * MiB, WS_VB = 740 * MiB, WS_MERGED = 772 * MiB;
constexpr size_t WS_XS = 300 * MiB, WS_ACT = 572 * MiB, WS_YS = WS_XS, WS_END = 844 * MiB;
static_assert(WS_RTOK + (size_t)(NEXP * NTOK + 256) * 4 <= WS_RW && WS_RW + (size_t)(NEXP * NTOK + 256) * 4 <= WS_WIN, "routing arrays");
static_assert(WS_XS + (size_t)MAXTILES * 256 * 2048 <= WS_ACT && WS_ACT + (size_t)MAXTILES * 256 * 2048 <= WS_END, "moe slabs");
constexpr int CW_TMO = 0, CW_BAR = 4096, CW_CNT = 16384;
constexpr int RING_OFF = 0, RING_BYTES = 131072;
constexpr int LDSCTL_OFF = RING_BYTES, MISC_OFF = LDSCTL_OFF + 320;
constexpr int L_TS = LDSCTL_OFF + 512, L_CNT = LDSCTL_OFF + 704, L_TE = LDSCTL_OFF + 1024, L_HIST = LDSCTL_OFF + 4096, L_BASE = LDSCTL_OFF + 4224, L_ASGE = LDSCTL_OFF + 4608, L_ASGW = LDSCTL_OFF + 6656;
constexpr int LDS_BYTES = 147456;
static_assert(att::Cfg<128, 128>::LDS <= RING_BYTES && att::Cfg<96, 64>::LDS <= RING_BYTES, "attention LDS");

typedef GAS unsigned gu32;
#define RLX_AGENT __ATOMIC_RELAXED, __HIP_MEMORY_SCOPE_AGENT
#define LDS_WAIT() asm volatile("s_waitcnt lgkmcnt(0)" ::: "memory")
#define VM_WAIT() asm volatile("s_waitcnt vmcnt(0)" ::: "memory")

#define XB_TMO      128
#define XB_XCNT(j)  (256  + 64 * (j))
#define XB_XSUB(j)  (1280 + 64 * (j))
#define XB_XGEN(j)  (2304 + 64 * (j))
#define XB_TOP      3328
#define XB_TOPGEN   3392
#define XCD_BAR_WORDS 3456
#define XB_SPIN_CAP (1u << 18)
__device__ __forceinline__ unsigned xb_ld(unsigned* p)              { return __hip_atomic_load(p, __ATOMIC_RELAXED, __HIP_MEMORY_SCOPE_AGENT); }
__device__ __forceinline__ unsigned xb_add(unsigned* p, unsigned v) { return __hip_atomic_fetch_add(p, v, __ATOMIC_RELAXED, __HIP_MEMORY_SCOPE_AGENT); }
__device__ __forceinline__ unsigned xb_xcc_id() { return (unsigned)__builtin_amdgcn_s_getreg((3 << 11) | 20) & 0xFu; }
#define XB_SPIN(cond, bar) do { unsigned _sp = 0; while (cond) { __builtin_amdgcn_s_sleep(1); \
    if ((++_sp & 255u) == 0u) { if (xb_ld(&(bar)[XB_TMO])) break; if (_sp > XB_SPIN_CAP) { atomicAdd(&(bar)[XB_TMO], 1u); break; } } } } while (0)
struct XcdBarrier { unsigned* bar; unsigned x; volatile LAS unsigned* st; };
__device__ __forceinline__ XcdBarrier xcd_barrier_post(unsigned* bar, volatile LAS unsigned* st) {
    XcdBarrier b; b.bar = bar; b.x = xb_xcc_id(); b.st = st;
    if (threadIdx.x == 0) (void)xb_add(&bar[XB_XCNT(b.x)], 1u);
    return b;
}
__device__ __forceinline__ void xcd_barrier_complete(unsigned* bar, unsigned x, unsigned& nloc, unsigned& nx) {
    const unsigned G = gridDim.x * gridDim.y * gridDim.z;
    unsigned sum, cnt, mine, sp = 0u;
    for (;;) {
        sum = 0u; cnt = 0u; mine = 0u;
#pragma unroll
        for (unsigned j = 0; j < 16; ++j) { const unsigned c = xb_ld(&bar[XB_XCNT(j)]); sum += c; cnt += (c > 0u) ? 1u : 0u; mine = (j == x) ? c : mine; }
        if (sum == G) break;
        __builtin_amdgcn_s_sleep(1);
        if ((++sp & 255u) == 0u) { if (xb_ld(&bar[XB_TMO])) break; if (sp > XB_SPIN_CAP) { atomicAdd(&bar[XB_TMO], 1u); break; } }
    }
    nloc = mine > 0u ? mine : 1u; nx = cnt > 0u ? cnt : 1u;
}
__device__ __forceinline__ void xcd_barrier(const XcdBarrier& b) {
    asm volatile("s_waitcnt vmcnt(0)" ::: "memory");
    __syncthreads();
    if (threadIdx.x == 0) {
        unsigned* bar = b.bar;
        __builtin_amdgcn_s_waitcnt(0);
        unsigned nloc = b.st[0], nx = b.st[1];
        if (nloc == 0u) { xcd_barrier_complete(bar, b.x, nloc, nx); b.st[0] = nloc; b.st[1] = nx; }
        const unsigned old = xb_add(&bar[XB_XSUB(b.x)], 1u);
        const unsigned gen = old / nloc;
        if (old + 1u == (gen + 1u) * nloc) {
            __builtin_amdgcn_fence(__ATOMIC_RELEASE, "agent");
            asm volatile("s_waitcnt vmcnt(0)" ::: "memory");
            const unsigned og = xb_add(&bar[XB_TOP], 1u);
            const unsigned tg = og / nx;
            if (og + 1u == (tg + 1u) * nx) xb_add(&bar[XB_TOPGEN], 1u);
            else XB_SPIN(xb_ld(&bar[XB_TOPGEN]) == tg, bar);
            __builtin_amdgcn_fence(__ATOMIC_ACQUIRE, "agent");
            xb_add(&bar[XB_XGEN(b.x)], 1u);
            asm volatile("s_waitcnt vmcnt(0)" ::: "memory");
        } else {
            XB_SPIN(xb_ld(&bar[XB_XGEN(b.x)]) == gen, bar);
            __builtin_amdgcn_fence(__ATOMIC_ACQUIRE, "agent");
            asm volatile("s_waitcnt vmcnt(0)" ::: "memory");
        }
    }
    __syncthreads();
}

struct Frame {
    LAS unsigned char* lds;
    volatile LAS unsigned* MISC;
    int tid, lane, wave, G;
};
struct Args { const float* in[27]; float* out; unsigned char* ws; int ph_lo, ph_hi; };
#define CAS __attribute__((address_space(4)))
struct KA { const CAS char* p;
    __device__ __forceinline__ const float* in(int i) const { return *(const float* const CAS*)(p + 8 * i); }
    __device__ __forceinline__ float* out() const { return *(float* const CAS*)(p + 216); }
    __device__ __forceinline__ unsigned char* ws() const { return *(unsigned char* const CAS*)(p + 224); }
    __device__ __forceinline__ gu32* ctl() const { return (gu32*)(ws() + WS_CTL); }
};
static_assert(offsetof(Args, out) == 216 && offsetof(Args, ws) == 224 && offsetof(Args, ph_lo) == 232, "Args layout");
__device__ __forceinline__ KA kargs() { KA k; k.p = (const CAS char*)__builtin_amdgcn_kernarg_segment_ptr(); asm volatile("" : "+s"(k.p)); return k; }
template <class T> __device__ __forceinline__ T* wsp(const KA& ka, size_t off) { return (T*)(ka.ws() + off); }
__device__ __forceinline__ float wave_sum(float v) {
#pragma unroll
    for (int o = 1; o < 64; o <<= 1) v += __shfl_xor(v, o);
    return v;
}
__device__ __forceinline__ float wave_max(float v) {
#pragma unroll
    for (int o = 1; o < 64; o <<= 1) v = fmaxf(v, __shfl_xor(v, o));
    return v;
}
__device__ __forceinline__ f32x4 bf4_to_f32(u32x2 w) { f32x4 g; g[0] = __uint_as_float(w.x << 16); g[1] = __uint_as_float(w.x & 0xffff0000u); g[2] = __uint_as_float(w.y << 16); g[3] = __uint_as_float(w.y & 0xffff0000u); return g; }

struct MapId { __device__ __forceinline__ int operator()(int n) const { return n; } };
struct MapInProj { __device__ __forceinline__ int operator()(int n) const {
    if (n < 512) { const int h = n >> 6, d = n & 63; return 256 * (h >> 2) + 128 * (d >> 5) + 32 * (h & 3) + (d & 31); }
    if (n < 768) { const int g = (n - 512) >> 6, d = n & 63; return 512 + 128 * (d >> 5) + 32 * g + (d & 31); }
    if (n < 1152) { const int i = n - 768; return i < 256 ? 768 + i : 1024 + (i - 256); }
    if (n < 1408) return 1280 + (n - 1152);
    if (n < 1440) { const int d = n - 1408, a = d >> 4, np = (d >> 3) & 1, i = d & 7; return 1024 + 128 + 16 * np + 8 * a + i; }
    if (n < 1952) return 1536 + (n - 1440);
    return 2048 + (n - 1952); } };
struct MapQb { __device__ __forceinline__ int operator()(int c) const { const int h = c / 96, r = c - 96 * h;
    if (r < 64) return 256 * (h >> 2) + 64 * (h & 3) + r;
    const int d = r - 64, a = d >> 4, np = (d >> 3) & 1, i = d & 7; return 512 + 128 * (h >> 2) + 32 * (h & 3) + 16 * np + 8 * a + i; } };
struct MapGlu { __device__ __forceinline__ int operator()(int n) const { return n < 1024 ? 256 * (n >> 7) + (n & 127) : 256 * ((n - 1024) >> 7) + 128 + (n & 127); } };

template <class Map> __device__ __forceinline__ void transpose_item(const float* W, int K, int N, bf16_t* WT, const float* kscale, LAS float* scr, int item, int lane, Map map) {
    const int nblk = N / 32, kb = item / nblk, nb = item - kb * nblk, k0 = 64 * kb, n0 = 32 * nb;
#pragma unroll 8
    for (int i = 0; i < 32; ++i) { const int kk = 2 * i + (lane >> 5); float v = W[(size_t)(k0 + kk) * N + n0 + (lane & 31)]; if (kscale) v *= kscale[k0 + kk]; scr[kk * 33 + (lane & 31)] = v; }
    LDS_WAIT(); asm volatile("" ::: "memory");
    const int c = lane & 7;
#pragma unroll
    for (int j = 0; j < 4; ++j) { const int n = (lane >> 3) + 8 * j; const LAS float* s = scr + (8 * c) * 33 + n;
        u32x4 o; o.x = pg8::cvt_pk_bf16(s[0 * 33], s[1 * 33]); o.y = pg8::cvt_pk_bf16(s[2 * 33], s[3 * 33]); o.z = pg8::cvt_pk_bf16(s[4 * 33], s[5 * 33]); o.w = pg8::cvt_pk_bf16(s[6 * 33], s[7 * 33]);
        *(u32x4*)(WT + (size_t)map(n0 + n) * K + k0 + 8 * c) = o; }
    LDS_WAIT(); asm volatile("" ::: "memory");
}

__device__ __forceinline__ void p0_prologue(Frame& F, const KA& ka) {
    LAS float* scr = (LAS float*)(F.lds + RING_OFF + F.wave * 16384);
    const int gw = blockIdx.x * NWAVES + F.wave, NGW = F.G * NWAVES, lane = F.lane;
    constexpr int I_IN = 16 * 157, I_QB = 6 * 24, I_KVB = 4 * 32, I_MEM = 16 * 32, I_BR = 8 * 32, I_OUT = 16 * 32, I_W1 = 16 * 64, I_W2 = 16 * 32;
    constexpr int NITEMS = I_IN + I_QB + I_KVB + I_MEM + 3 * I_BR + I_OUT + NEXP * I_W1 + NEXP * I_W2;
    for (int it = gw; it < NITEMS; it += NGW) {
        int r = it;
        if (r < NEXP * I_W1) { const int e = r / I_W1; transpose_item(ka.in(21) + (size_t)e * 1024 * 2048, 1024, 2048, wsp<bf16_t>(ka, WS_W1) + (size_t)e * 2048 * 1024, nullptr, scr, r - e * I_W1, lane, MapGlu()); continue; } r -= NEXP * I_W1;
        if (r < NEXP * I_W2) { const int e = r / I_W2; transpose_item(ka.in(23) + (size_t)e * 1024 * 1024, 1024, 1024, wsp<bf16_t>(ka, WS_W2) + (size_t)e * 1024 * 1024, nullptr, scr, r - e * I_W2, lane, MapId()); continue; } r -= NEXP * I_W2;
        if (r < I_IN) { transpose_item(ka.in(4), 1024, IN_PROJ_W, wsp<bf16_t>(ka, WS_WIN), nullptr, scr, r, lane, MapInProj()); continue; } r -= I_IN;
        if (r < I_QB) { transpose_item(ka.in(10), QLAT, 768, wsp<bf16_t>(ka, WS_WQB), ka.in(8), scr, r, lane, MapQb()); continue; } r -= I_QB;
        if (r < I_KVB) { transpose_item(ka.in(11), KVLAT, 1024, wsp<bf16_t>(ka, WS_WKVB), ka.in(9), scr, r, lane, MapId()); continue; } r -= I_KVB;
        if (r < I_MEM) { transpose_item(ka.in(12), 1024, 1024, wsp<bf16_t>(ka, WS_WMEM), nullptr, scr, r, lane, MapId()); continue; } r -= I_MEM;
        if (r < I_BR) { transpose_item(ka.in(13), 512, 1024, wsp<bf16_t>(ka, WS_WBR), nullptr, scr, r, lane, MapId()); continue; } r -= I_BR;
        if (r < I_BR) { transpose_item(ka.in(14), 512, 1024, wsp<bf16_t>(ka, WS_WBR) + (size_t)1024 * 512, nullptr, scr, r, lane, MapId()); continue; } r -= I_BR;
        if (r < I_BR) { transpose_item(ka.in(15), 512, 1024, wsp<bf16_t>(ka, WS_WBR) + (size_t)2 * 1024 * 512, nullptr, scr, r, lane, MapId()); continue; } r -= I_BR;
        transpose_item(ka.in(16), 1024, 1024, wsp<bf16_t>(ka, WS_WOUT), nullptr, scr, r, lane, MapId());
    }
    { bf16_t* wp = wsp<bf16_t>(ka, WS_WIN) + (size_t)1184 * 1024; const int gt = blockIdx.x * 512 + F.tid, NGT = F.G * 512;
      for (int i = gt; i < 96 * 1024 / 8; i += NGT) *(u32x4*)(wp + (size_t)i * 8) = (u32x4){0u, 0u, 0u, 0u}; }
    { const int gt = blockIdx.x * 512 + F.tid; float* ra = wsp<float>(ka, WS_ROPEA); float* rb = wsp<float>(ka, WS_ROPEB);
      if (gt < 1024) { const int pos = gt >> 4, i = gt & 15; const float inv = __builtin_amdgcn_exp2f(-(float)i * (13.287712379549449f / 16.0f)); float rev = (float)pos * inv * 0.15915494309189535f; rev -= floorf(rev);
          ra[gt] = __builtin_amdgcn_cosf(rev); ra[1024 + gt] = __builtin_amdgcn_sinf(rev); }
      else if (gt < 1536) { const int q = gt - 1024, pos = q >> 3, i = q & 7; const float inv = __builtin_amdgcn_exp2f(-(float)i * (13.287712379549449f / 8.0f)); float rev = (float)pos * inv * 0.15915494309189535f; rev -= floorf(rev);
          rb[q] = __builtin_amdgcn_cosf(rev); rb[512 + q] = __builtin_amdgcn_sinf(rev); } }
    { const float* x = ka.in(0); const f32x4* gp = (const f32x4*)ka.in(2) + lane; const f32x4* bp = (const f32x4*)ka.in(3) + lane; f32x4 gv[4], bv[4];
#pragma unroll
      for (int j = 0; j < 4; ++j) { gv[j] = gp[64 * j]; bv[j] = bp[64 * j]; }
      bf16_t* H0 = wsp<bf16_t>(ka, WS_H0); float* st0 = wsp<float>(ka, WS_STATS0);
      for (int m = gw; m < NTOK; m += NGW) {
          const f32x4* xr = (const f32x4*)(x + (size_t)m * DM) + lane; f32x4 v[4]; float s = 0.f;
#pragma unroll
          for (int j = 0; j < 4; ++j) { v[j] = xr[64 * j]; s += (v[j][0] + v[j][1]) + (v[j][2] + v[j][3]); }
          const float mean = wave_sum(s) * (1.f / DM); float s2 = 0.f;
#pragma unroll
          for (int j = 0; j < 4; ++j) { const f32x4 d = v[j] - mean; s2 += ssq4(d); }
          const float rstd = 1.f / sqrtf(wave_sum(s2) * (1.f / DM) + LN_EPS);
          if (lane == 0) *(f32x2*)(st0 + (size_t)m * 2) = (f32x2){mean, rstd};
#pragma unroll
          for (int j = 0; j < 4; ++j) *(u32x2*)(H0 + (size_t)m * DM + 4 * lane + 256 * j) = pack4((v[j] - mean) * rstd * gv[j] + bv[j]);
      } }
    { const float* mem = ka.in(1); bf16_t* mb = wsp<bf16_t>(ka, WS_MEMB); const int gt = blockIdx.x * 512 + F.tid, NGT = F.G * 512;
      for (int i = gt; i < NMEM * DM / 4; i += NGT) *(u32x2*)(mb + (size_t)i * 4) = pack4(*(const f32x4*)(mem + (size_t)i * 4)); }
}

__device__ __forceinline__ void moe_tables(Frame& F, const KA& ka) {
    LAS int* TS = (LAS int*)(F.lds + L_TS); LAS int* CNT = (LAS int*)(F.lds + L_CNT); LAS int* TE = (LAS int*)(F.lds + L_TE);
    if (F.tid < NEXP) { int c = (int)__hip_atomic_load(ka.ctl() + CW_CNT + F.tid, RLX_AGENT); c = c < 0 ? 0 : (c > NTOK ? NTOK : c); CNT[F.tid] = c; }
    __syncthreads();
    if (F.tid == 0) { int s = 0; for (int e = 0; e < NEXP; ++e) { TS[e] = s; s += (CNT[e] + 255) >> 8; } TS[NEXP] = s; }
    __syncthreads();
    const int T = TS[NEXP];
    for (int t = F.tid; t < T; t += NWAVES * 64) { int e = 0; while (e < NEXP - 1 && TS[e + 1] <= t) ++e; TE[t] = e; }
    __syncthreads();
}

__device__ __forceinline__ void p6_route(Frame& F, const KA& ka) {
    LAS float* wT = (LAS float*)(F.lds + RING_OFF);
    LAS int* hist = (LAS int*)(F.lds + L_HIST); LAS int* base = (LAS int*)(F.lds + L_BASE); LAS int* asg_e = (LAS int*)(F.lds + L_ASGE); LAS float* asg_w = (LAS float*)(F.lds + L_ASGW);
    const int lane = F.lane, tid = F.tid;
    { const float* wr = ka.in(19); for (int idx = tid; idx < DM * NEXP; idx += NWAVES * 64) wT[(idx & 31) * DM + (idx >> 5)] = wr[idx]; }
    const float* pre = ka.out(); bf16_t* H1 = wsp<bf16_t>(ka, WS_H1); float* st1 = wsp<float>(ka, WS_STATS1);
    int* rtok = wsp<int>(ka, WS_RTOK); float* rw = wsp<float>(ka, WS_RW); int* toker = wsp<int>(ka, WS_TOKER);
    f32x4 gv[4], bv[4];
#pragma unroll
    for (int j = 0; j < 4; ++j) { gv[j] = ((const f32x4*)ka.in(17))[lane + 64 * j]; bv[j] = ((const f32x4*)ka.in(18))[lane + 64 * j]; }
    const float brt = lane < NEXP ? ka.in(20)[lane] : 0.f;
    __syncthreads();
    for (int chunk = blockIdx.x; chunk < NTOK / 128; chunk += F.G) {
        if (tid < NEXP) hist[tid] = 0;
        for (int r = 0; r < 16; ++r) {
            const int lrow = F.wave * 16 + r, m = chunk * 128 + lrow;
            const f32x4* xr = (const f32x4*)(pre + (size_t)m * DM) + lane; f32x4 v[4]; float s = 0.f;
#pragma unroll
            for (int j = 0; j < 4; ++j) { v[j] = xr[64 * j]; s += (v[j][0] + v[j][1]) + (v[j][2] + v[j][3]); }
            const float mean = wave_sum(s) * (1.f / DM); float s2 = 0.f;
#pragma unroll
            for (int j = 0; j < 4; ++j) { const f32x4 d = v[j] - mean; s2 += ssq4(d); }
            const float rstd = 1.f / sqrtf(wave_sum(s2) * (1.f / DM) + LN_EPS);
            if (lane == 0) *(f32x2*)(st1 + (size_t)m * 2) = (f32x2){mean, rstd};
#pragma unroll
            for (int j = 0; j < 4; ++j) { v[j] = (v[j] - mean) * rstd * gv[j] + bv[j]; *(u32x2*)(H1 + (size_t)m * DM + 4 * lane + 256 * j) = pack4(v[j]); }
            float mylogit = -INFINITY;
#pragma unroll 4
            for (int e = 0; e < NEXP; ++e) { float p = 0.f;
#pragma unroll
                for (int j = 0; j < 4; ++j) { const f32x4 w = *(const LAS f32x4*)(wT + e * DM + 4 * lane + 256 * j); p += (v[j][0] * w[0] + v[j][1] * w[1]) + (v[j][2] * w[2] + v[j][3] * w[3]); }
                p = wave_sum(p); if (lane == e) mylogit = p + brt; }
            float val[4]; int id[4];
#pragma unroll
            for (int k = 0; k < 4; ++k) { const float mx = wave_max(mylogit); const unsigned long long ball = __ballot(mylogit == mx); const int idx = ball ? (int)__builtin_ctzll(ball) : k;
                val[k] = mx; id[k] = idx; if (lane == idx) mylogit = -INFINITY; }
            const float e1 = __expf(val[1] - val[0]), e2 = __expf(val[2] - val[0]), e3 = __expf(val[3] - val[0]); const float inv = 1.f / (1.f + e1 + e2 + e3);
            if (lane < 4) { const int myid = lane == 0 ? id[0] : (lane == 1 ? id[1] : (lane == 2 ? id[2] : id[3])); const float myw = (lane == 0 ? 1.f : (lane == 1 ? e1 : (lane == 2 ? e2 : e3))) * inv;
                asg_e[lrow * 4 + lane] = myid; asg_w[lrow * 4 + lane] = myw; }
        }
        __syncthreads();
        const int e = asg_e[tid] & 31; const float w = asg_w[tid];
        const int lr = __hip_atomic_fetch_add(hist + e, 1, __ATOMIC_RELAXED, __HIP_MEMORY_SCOPE_WORKGROUP);
        __syncthreads();
        if (tid < NEXP) base[tid] = (int)__hip_atomic_fetch_add(ka.ctl() + CW_CNT + tid, (unsigned)hist[tid], RLX_AGENT);
        __syncthreads();
        const int rank = base[e] + lr, m = chunk * 128 + (tid >> 2);
        if (rank >= 0 && rank < NTOK) { rtok[(size_t)e * NTOK + rank] = m; rw[(size_t)e * NTOK + rank] = w; }
        toker[(size_t)m * 4 + (tid & 3)] = (e << 16) | (rank & 0xffff);
        __syncthreads();
    }
}

__device__ __forceinline__ void p7_gather(Frame& F, const KA& ka) {
    moe_tables(F, ka);
    const LAS int* TS = (const LAS int*)(F.lds + L_TS); const LAS int* CNT = (const LAS int*)(F.lds + L_CNT); const LAS int* TE = (const LAS int*)(F.lds + L_TE);
    const int T = TS[NEXP], gw = blockIdx.x * NWAVES + F.wave, NGW = F.G * NWAVES;
    const bf16_t* H1 = wsp<bf16_t>(ka, WS_H1); bf16_t* XS = wsp<bf16_t>(ka, WS_XS); const int* rtok = wsp<int>(ka, WS_RTOK);
    for (int s = gw; s < T * 256; s += NGW) {
        const int t = s >> 8, e = TE[t], rank = s - TS[e] * 256; int tok = 0;
        if (rank < CNT[e]) tok = rtok[(size_t)e * NTOK + rank];
        tok = (tok < 0 || tok >= NTOK) ? 0 : tok;
        const u32x4* src = (const u32x4*)(H1 + (size_t)tok * DM) + F.lane; u32x4* dst = (u32x4*)(XS + (size_t)s * DM) + F.lane;
        const u32x4 a = src[0], b = src[64]; dst[0] = a; dst[64] = b;
    }
}

__device__ __forceinline__ void p10_final(Frame& F, const KA& ka) {
    moe_tables(F, ka);
    const LAS int* TS = (const LAS int*)(F.lds + L_TS);
    const int gw = blockIdx.x * NWAVES + F.wave, NGW = F.G * NWAVES, lane = F.lane;
    const float* st1 = wsp<float>(ka, WS_STATS1); const int* toker = wsp<int>(ka, WS_TOKER); const bf16_t* YS = wsp<bf16_t>(ka, WS_YS);
    f32x4 g1[4], b1[4], g2[4], b2[4];
#pragma unroll
    for (int j = 0; j < 4; ++j) { g1[j] = ((const f32x4*)ka.in(17))[lane + 64 * j]; b1[j] = ((const f32x4*)ka.in(18))[lane + 64 * j]; g2[j] = ((const f32x4*)ka.in(25))[lane + 64 * j]; b2[j] = ((const f32x4*)ka.in(26))[lane + 64 * j]; }
    for (int m = gw; m < NTOK; m += NGW) {
        float* orow = ka.out() + (size_t)m * DM; const f32x2 st = *(const f32x2*)(st1 + (size_t)m * 2); f32x4 y[4];
#pragma unroll
        for (int j = 0; j < 4; ++j) { const f32x4 p = ((const f32x4*)orow)[lane + 64 * j]; y[j] = ((p - st.x) * st.y * g1[j] + b1[j]) * DN_ALPHA; }
#pragma unroll
        for (int k = 0; k < 4; ++k) { const int er = toker[(size_t)m * 4 + k], e = (er >> 16) & 31, rank = er & 0xffff; const size_t slot = (size_t)TS[e] * 256 + rank;
            const bf16_t* yr = YS + slot * DM + 4 * lane;
#pragma unroll
            for (int j = 0; j < 4; ++j) y[j] = y[j] + bf4_to_f32(*(const u32x2*)(yr + 256 * j)); }
        float s = 0.f;
#pragma unroll
        for (int j = 0; j < 4; ++j) s += (y[j][0] + y[j][1]) + (y[j][2] + y[j][3]);
        const float mean = wave_sum(s) * (1.f / DM); float s2 = 0.f;
#pragma unroll
        for (int j = 0; j < 4; ++j) { const f32x4 d = y[j] - mean; s2 += ssq4(d); }
        const float rstd = 1.f / sqrtf(wave_sum(s2) * (1.f / DM) + LN_EPS);
#pragma unroll
        for (int j = 0; j < 4; ++j) ((f32x4*)orow)[lane + 64 * j] = (y[j] - mean) * rstd * g2[j] + b2[j];
    }
}

__global__ void __launch_bounds__(NWAVES * 64, 2) mk_fwd(Args args) {
    extern __shared__ __attribute__((aligned(16))) unsigned char lds[];
    Frame F;
    F.lds = (LAS unsigned char*)lds;
    F.MISC = (volatile LAS unsigned*)(F.lds + MISC_OFF);
    F.tid = threadIdx.x; F.lane = F.tid & 63; F.wave = __builtin_amdgcn_readfirstlane(F.tid >> 6);
    F.G = gridDim.x;
    for (int u = F.tid; u < (LDS_BYTES - LDSCTL_OFF) / 4; u += NWAVES * 64) ((LAS unsigned*)(F.lds + LDSCTL_OFF))[u] = 0u;
    __syncthreads();
    XcdBarrier bar; bar.bar = (unsigned*)((gu32*)(args.ws + WS_CTL) + CW_BAR); bar.x = 0; bar.st = nullptr;
    if (N_LAUNCHES == 1) bar = xcd_barrier_post(bar.bar, F.MISC + 8);
#define GRID_BAR() do { if (N_LAUNCHES == 1) xcd_barrier(bar); } while (0)
    const int lo = args.ph_lo, hi = args.ph_hi;
#define IN(k) (lo <= (k) && (k) < hi)
#define BOTH(k) (IN(k) && IN((k) + 1))
    const int bx = blockIdx.x;

    if (IN(0)) { const KA ka = kargs(); p0_prologue(F, ka); if (BOTH(0)) GRID_BAR(); }

    if (IN(1)) { const KA ka = kargs();
        DenseOrder S; S.init(NTOK, NPROJ, DM, F.G, bx, wsp<bf16_t>(ka, WS_H0), wsp<bf16_t>(ka, WS_WIN));
        EpiInProj E{wsp<bf16_t>(ka, WS_QA), wsp<bf16_t>(ka, WS_KA), wsp<bf16_t>(ka, WS_VA), wsp<bf16_t>(ka, WS_QLAT), wsp<bf16_t>(ka, WS_KVLAT), wsp<bf16_t>(ka, WS_KB), wsp<bf16_t>(ka, WS_QM), wsp<bf16_t>(ka, WS_GATES),
                    wsp<float>(ka, WS_SSQ), ka.in(6), ka.in(7), ka.in(5), wsp<float>(ka, WS_ROPEA), wsp<float>(ka, WS_ROPEB)};
        pg8::gemm_phase<EpiInProj, DenseOrder, true, true>(F.lds + RING_OFF, DM, S, E);
        if (BOTH(1)) GRID_BAR();
    }

    if (IN(2)) { const KA ka = kargs();
        { DenseOrder S; S.init(NTOK, 768, QLAT, F.G, bx, wsp<bf16_t>(ka, WS_QLAT), wsp<bf16_t>(ka, WS_WQB));
          EpiQb E{wsp<bf16_t>(ka, WS_QB), wsp<float>(ka, WS_SSQ), wsp<float>(ka, WS_ROPEB)};
          pg8::gemm_phase<EpiQb, DenseOrder, true, true>(F.lds + RING_OFF, QLAT, S, E); }
        __syncthreads();
        { DenseOrder S; S.init(NTOK, 1024, KVLAT, F.G, bx, wsp<bf16_t>(ka, WS_KVLAT), wsp<bf16_t>(ka, WS_WKVB));
          EpiKVb E{wsp<bf16_t>(ka, WS_KB), wsp<bf16_t>(ka, WS_VB), wsp<float>(ka, WS_SSQ)};
          pg8::gemm_phase<EpiKVb, DenseOrder, true, true>(F.lds + RING_OFF, KVLAT, S, E); }
        __syncthreads();
        { DenseOrder S; S.init(NMEM, 1024, DM, F.G, (bx + 128) % F.G, wsp<bf16_t>(ka, WS_MEMB), wsp<bf16_t>(ka, WS_WMEM));
          EpiPlain E{wsp<bf16_t>(ka, WS_MKV), 1024};
          pg8::gemm_phase<EpiPlain, DenseOrder, true, true>(F.lds + RING_OFF, DM, S, E); }
        if (BOTH(2)) GRID_BAR();
    }

    if (IN(3)) { const KA ka = kargs();
        const int vcu = (F.G % 8 == 0) ? (bx % 8) * (F.G / 8) + bx / 8 : bx;
        char* al = (char*)lds + RING_OFF;
        const int NU = NB * 8 * 16;
        for (int ui = vcu; ui < NU; ui += F.G) {
            const int b = ui >> 7, h = (ui >> 4) & 7, qb = ui & 15; const size_t row0 = (size_t)b * SEQ + qb * 256;
            bf16_t* Q = wsp<bf16_t>(ka, WS_QA) + row0 * 512 + h * 64;
            const bf16_t* K = wsp<bf16_t>(ka, WS_KA) + (size_t)b * SEQ * 128 + (h >> 2) * 64; const bf16_t* V = wsp<bf16_t>(ka, WS_VA) + (size_t)b * SEQ * 128 + (h >> 2) * 64;
            att::attn_body<64, 64, 512, 128, 128, 512>(Q, K, V, Q, SEQ, 0.125f * LOG2E, att::THR / 0.125f, al);
        }
        for (int ui = vcu; ui < NU; ui += F.G) {
            const int b = ui >> 7, h = (ui >> 4) & 7, qb = ui & 15; const size_t row0 = (size_t)b * SEQ + qb * 256;
            const bf16_t* Q = wsp<bf16_t>(ka, WS_QB) + row0 * 768 + h * 96;
            const bf16_t* K = wsp<bf16_t>(ka, WS_KB) + (size_t)b * SEQ * 768 + h * 96; const bf16_t* V = wsp<bf16_t>(ka, WS_VB) + (size_t)b * SEQ * 512 + h * 64;
            bf16_t* O = wsp<bf16_t>(ka, WS_OB) + row0 * 512 + h * 64;
            att::attn_body<96, 64, 768, 768, 512, 512>(Q, K, V, O, SEQ, 0.10206207261596575f * LOG2E, att::THR / 0.10206207261596575f, al);
        }
        for (int ui = vcu; ui < NB * 4 * 16; ui += F.G) {
            const int b = ui >> 6, h = (ui >> 4) & 3, qb = ui & 15; const size_t row0 = (size_t)b * SEQ + qb * 256;
            bf16_t* Q = wsp<bf16_t>(ka, WS_QM) + row0 * 512 + h * 128;
            const bf16_t* K = wsp<bf16_t>(ka, WS_MKV) + (size_t)b * MEMLEN * 1024 + h * 128; const bf16_t* V = K + 512;
            att::attn_body<128, 128, 512, 1024, 1024, 512>(Q, K, V, Q, MEMLEN, 0.08838834764831845f * LOG2E, att::THR / 0.08838834764831845f, al);
        }
        if (BOTH(3)) GRID_BAR();
    }

    if (IN(4)) { const KA ka = kargs();
        BranchOrder S; S.G = F.G; S.c = bx; S.tstep = (size_t)256 * 512 * 2; S.astride = WS_OB - WS_QA; S.bstride = (size_t)1024 * 512 * 2;
        static_assert(WS_OB - WS_QA == WS_QM - WS_OB, "branch operands equally spaced");
        S.A = (const char*)wsp<bf16_t>(ka, WS_QA); S.B = (const char*)wsp<bf16_t>(ka, WS_WBR);
        EpiBranch E{wsp<bf16_t>(ka, WS_GATES), ka.out(), wsp<bf16_t>(ka, WS_MERGED)};
        pg8::gemm_phase<EpiBranch, BranchOrder, true, true>(F.lds + RING_OFF, 512, S, E);
        if (BOTH(4)) GRID_BAR();
    }

    if (IN(5)) { const KA ka = kargs();
        DenseOrder S; S.init(NTOK, DM, DM, F.G, bx, wsp<bf16_t>(ka, WS_MERGED), wsp<bf16_t>(ka, WS_WOUT));
        EpiOutProj E{ka.in(0), wsp<float>(ka, WS_STATS0), ka.in(2), ka.in(3), ka.out()};
        pg8::gemm_phase<EpiOutProj, DenseOrder, true, true>(F.lds + RING_OFF, DM, S, E);
        if (BOTH(5)) GRID_BAR();
    }

    if (IN(6)) { const KA ka = kargs(); p6_route(F, ka); if (BOTH(6)) GRID_BAR(); }

    if (IN(7)) { const KA ka = kargs(); p7_gather(F, ka); if (BOTH(7)) GRID_BAR(); }

    if (IN(8)) { const KA ka = kargs();
        moe_tables(F, ka);
        MoeOrder S; S.G = F.G; S.c = bx; S.T = ((const LAS int*)(F.lds + L_TS))[NEXP]; S.NPN = 8; S.A = (const char*)wsp<bf16_t>(ka, WS_XS); S.B = (const char*)wsp<bf16_t>(ka, WS_W1);
        S.tstep = (size_t)256 * 1024 * 2; S.tile_e = (const LAS int*)(F.lds + L_TE);
        EpiSwiglu E{ka.in(22), wsp<bf16_t>(ka, WS_ACT)};
        pg8::gemm_phase<EpiSwiglu, MoeOrder, true, true>(F.lds + RING_OFF, DM, S, E);
        if (BOTH(8)) GRID_BAR();
    }

    if (IN(9)) { const KA ka = kargs();
        moe_tables(F, ka);
        MoeOrder S; S.G = F.G; S.c = bx; S.T = ((const LAS int*)(F.lds + L_TS))[NEXP]; S.NPN = 4; S.A = (const char*)wsp<bf16_t>(ka, WS_ACT); S.B = (const char*)wsp<bf16_t>(ka, WS_W2);
        S.tstep = (size_t)256 * 1024 * 2; S.tile_e = (const LAS int*)(F.lds + L_TE);
        EpiExpOut E{ka.in(24), wsp<float>(ka, WS_RW), (const LAS int*)(F.lds + L_TS), wsp<bf16_t>(ka, WS_YS)};
        pg8::gemm_phase<EpiExpOut, MoeOrder, true, true>(F.lds + RING_OFF, DM, S, E);
        if (BOTH(9)) GRID_BAR();
    }

    if (IN(10)) { const KA ka = kargs(); p10_final(F, ka); }
#undef IN
#undef BOTH
#undef GRID_BAR
}

extern "C" void kernel_launch(void* const* d_in, const int* in_sizes, int n_in, void* d_out, int out_size, void* d_ws, size_t ws_size, hipStream_t stream) {
    static int grid = 0;
    if (grid == 0) {
        if (n_in != 27 || in_sizes[0] != NTOK * DM || out_size != NTOK * DM || ws_size < WS_END) { fprintf(stderr, "kernel_launch: shape mismatch (n_in %d, in0 %d, out %d, ws %zu)\n", n_in, n_in > 0 ? in_sizes[0] : -1, out_size, ws_size); grid = -1; return; }
        int dev = 0, cus = 0, per_cu = 0;
        if (hipGetDevice(&dev) != hipSuccess || hipDeviceGetAttribute(&cus, hipDeviceAttributeMultiprocessorCount, dev) != hipSuccess) { fprintf(stderr, "kernel_launch: device query failed\n"); grid = -1; return; }
        if (hipFuncSetAttribute((const void*)mk_fwd, hipFuncAttributeMaxDynamicSharedMemorySize, LDS_BYTES) != hipSuccess) { fprintf(stderr, "kernel_launch: hipFuncSetAttribute failed\n"); grid = -1; return; }
        if (hipOccupancyMaxActiveBlocksPerMultiprocessor(&per_cu, (const void*)mk_fwd, NWAVES * 64, LDS_BYTES) != hipSuccess || per_cu < 1) fprintf(stderr, "kernel_launch: note: occupancy query reports %d\n", per_cu);
        (void)hipGetLastError();
        grid = cus - (cus % 8);
        if (grid < 8) { grid = -1; return; }
    }
    if (grid < 0) return;
    if (hipMemsetAsync((char*)d_ws + WS_CTL, 0, CTL_ZERO_BYTES, stream) != hipSuccess) { fprintf(stderr, "kernel_launch: memset failed\n"); return; }
    Args a{};
    for (int i = 0; i < 27; ++i) a.in[i] = (const float*)d_in[i];
    a.out = (float*)d_out; a.ws = (unsigned char*)d_ws;
    for (int li = 0; li < N_LAUNCHES; ++li) {
        a.ph_lo = (N_LAUNCHES == 1) ? 0 : li; a.ph_hi = (N_LAUNCHES == 1) ? NPHASE : li + 1;
        hipLaunchKernelGGL(mk_fwd, dim3(grid), dim3(NWAVES * 64), LDS_BYTES, stream, a);
        const hipError_t le = hipPeekAtLastError();
        if (le != hipSuccess) { fprintf(stderr, "kernel_launch: launch %d failed: %s\n", li, hipGetErrorName(le)); break; }
    }
}
```

```cpp
#include <hip/hip_runtime.h>
#include <cstdio>
#include <cstdint>

namespace pg8 {
#define PG8_LAS __attribute__((address_space(3)))
typedef unsigned short bf16_t;
typedef short bf16x8 __attribute__((ext_vector_type(8)));
typedef float f32x4 __attribute__((ext_vector_type(4)));
typedef float f32x2 __attribute__((ext_vector_type(2)));
typedef unsigned u32x4 __attribute__((ext_vector_type(4)));
typedef unsigned u32x2 __attribute__((ext_vector_type(2)));
typedef int v4i32_t __attribute__((ext_vector_type(4)));
typedef int v8i32_t __attribute__((ext_vector_type(8)));
constexpr int BM = 256, BK = 64, HALF = 128, HTB = HALF * BK * 2  , STAGE_BYTES = 8 * HTB, NXCD = 8, WGM = 8;

__host__ __device__ __forceinline__ int lds_byte(int r, int c) { const int st = (r >> 4) * 2 + (c >> 5), rr = r & 15, cc = c & 31, ob = rr * 64 + cc * 2; return st * 1024 + (ob ^ (((ob >> 9) & 1) << 5)); }
__host__ __device__ __forceinline__ void stage_rc(int b, int& R, int& C) { const int st = b / 1024, sb = b % 1024, swz = sb ^ (((sb >> 9) & 1) << 5); R = (st >> 1) * 16 + swz / 64; C = (st & 1) * 32 + (swz % 64) / 2; }
__host__ __device__ __forceinline__ int perm32(int rho) { const int n = rho >> 4, i = rho & 15; return 8 * (i >> 2) + 4 * n + (i & 3); }

__device__ __forceinline__ int lane_now() { int l; asm volatile("v_mbcnt_lo_u32_b32 %0, -1, 0\n\tv_mbcnt_hi_u32_b32 %0, -1, %0" : "=v"(l)); return l; }
template <int MASK> __device__ __forceinline__ float swz_xor(float v) { return __uint_as_float((unsigned)__builtin_amdgcn_ds_swizzle((int)__float_as_uint(v), (MASK << 10) | 0x1f)); }
__device__ __forceinline__ float half_sum(float v) { const auto r = __builtin_amdgcn_permlane32_swap(__float_as_uint(v), __float_as_uint(v), false, false); return __uint_as_float(r[0]) + __uint_as_float(r[1]); }
__device__ __forceinline__ float half_max(float v) { const auto r = __builtin_amdgcn_permlane32_swap(__float_as_uint(v), __float_as_uint(v), false, false); return fmaxf(__uint_as_float(r[0]), __uint_as_float(r[1])); }
struct Unit { int pm, pn, aux; };

typedef __bf16 bf16x2_t __attribute__((ext_vector_type(2)));
__device__ __forceinline__ unsigned cvt_pk_bf16(float lo, float hi) { const f32x2 v = {lo, hi}; const bf16x2_t b = __builtin_convertvector(v, bf16x2_t); return __builtin_bit_cast(unsigned, b); }
__device__ __forceinline__ u32x2 pack4(f32x4 v) { u32x2 w; w.x = cvt_pk_bf16(v[0], v[1]); w.y = cvt_pk_bf16(v[2], v[3]); return w; }

template <class Epi, class Sched, bool ALIGN_EPI = false, bool SP2 = false, bool F8 = false, int PROBE = 0>
__device__ __forceinline__ void gemm_phase(PG8_LAS unsigned char* lds, const int Kdim, const Sched& S, const Epi& E, const int wave_id, const bool probe_skip_epi = false) {
    int l_ = lane_now(); asm volatile("" : "+v"(l_));
    const int wid = wave_id, lane = l_, tid = wave_id * 64 + lane, wr = wid >> 2, wc = wid & 3, fr = lane & 15, fq = lane >> 4;
    const int K = Kdim, nt = K / BK;
    unsigned voffA[2], voffB[2];
#pragma unroll
    for (int i = 0; i < 2; ++i) { int R, C; stage_rc(tid * 16 + i * 8192, R, C); const int Rb = Epi::PERM ? ((R & ~31) + perm32(R & 31)) : R;
        voffA[i] = (unsigned)(R * K + C) * 2u; voffB[i] = (unsigned)(Rb * K + C) * 2u; }
    const size_t kstep = (size_t)(BK * 2);
    const size_t hstep = (size_t)HALF * K * 2;
    const size_t tstep = 2 * hstep;
    const unsigned ldsw = (unsigned)wid * 1024u;
    const int aoff = lds_byte(wr * 64 + fr, fq * 8), boff = lds_byte(wc * 32 + fr, fq * 8);
#define PG8_SA(b, h) (((b) * 2 + (h)) * HTB)
#define PG8_SB(b, h) ((4 + (b) * 2 + (h)) * HTB)
#define PG8_STAGE(bufoff, gbase, voff) do { _Pragma("unroll") for (int _i = 0; _i < 2; ++_i) \
        __builtin_amdgcn_global_load_lds((const unsigned*)((const char*)(gbase) + (voff)[_i]), (PG8_LAS unsigned*)(lds + (bufoff) + ldsw + _i * 8192), 16, 0, 0); } while (0)
#define PG8_STAGEA(bufoff, gbase, h, isnext) do { if constexpr (Sched::GATHER) { const unsigned vs_[2] = {(isnext) ? voN[h][0] : voC[h][0], (isnext) ? voN[h][1] : voC[h][1]}; PG8_STAGE(bufoff, gbase, vs_); } \
        else { PG8_STAGE(bufoff, (gbase) + (h) * hstep, voffA); } } while (0)
#define PG8_LDA(dst, b, h) do { _Pragma("unroll") for (int m = 0; m < 4; ++m) { if constexpr (F8) dst##8[m] = PG8_CAT(*(const PG8_LAS bf16x8*)(lds + PG8_SA(b, h) + aoff + m * 2048), *(const PG8_LAS bf16x8*)(lds + PG8_SA(b, h) + aoff + m * 2048 + 1024)); \
        else { _Pragma("unroll") for (int k = 0; k < 2; ++k) dst[m][k] = *(const PG8_LAS bf16x8*)(lds + PG8_SA(b, h) + aoff + m * 2048 + k * 1024); } } } while (0)
#define PG8_LDB(dst, b, h) do { _Pragma("unroll") for (int n = 0; n < 2; ++n) { if constexpr (F8) dst##8[n] = PG8_CAT(*(const PG8_LAS bf16x8*)(lds + PG8_SB(b, h) + boff + n * 2048), *(const PG8_LAS bf16x8*)(lds + PG8_SB(b, h) + boff + n * 2048 + 1024)); \
        else { _Pragma("unroll") for (int k = 0; k < 2; ++k) dst[n][k] = *(const PG8_LAS bf16x8*)(lds + PG8_SB(b, h) + boff + n * 2048 + k * 1024); } } } while (0)
#define PG8_CAT(x0, x1) __builtin_shufflevector(__builtin_bit_cast(v4i32_t, x0), __builtin_bit_cast(v4i32_t, x1), 0, 1, 2, 3, 4, 5, 6, 7)
#define PG8_MMA(ai, bj, At, Bt) do { __builtin_amdgcn_s_setprio(1); \
    if constexpr (F8) { _Pragma("unroll") for (int m = 0; m < 4; ++m) _Pragma("unroll") for (int n = 0; n < 2; ++n) \
        asm volatile("v_mfma_scale_f32_16x16x128_f8f6f4 %0, %1, %2, %0, %3, %3 op_sel_hi:[0,0,0]" : "+v"(acc[ai][bj][m][n]) : "v"(Bt##8[n]), "v"(At##8[m]), "v"(f8_scale)); } \
    else { _Pragma("unroll") for (int m = 0; m < 4; ++m) _Pragma("unroll") for (int n = 0; n < 2; ++n) _Pragma("unroll") for (int k = 0; k < 2; ++k) \
        acc[ai][bj][m][n] = __builtin_amdgcn_mfma_f32_16x16x32_bf16(Bt[n][k], At[m][k], acc[ai][bj][m][n], 0, 0, 0); } \
    __builtin_amdgcn_s_setprio(0); } while (0)
#define PG8_PLDB(d, b, h) do { if constexpr (!(PROBE & 4)) PG8_LDB(d, b, h); } while (0)
#define PG8_PLDA(d, b, h) do { if constexpr (!(PROBE & 4)) PG8_LDA(d, b, h); } while (0)
#define PG8_PSTAGE(bo, g, v) do { if constexpr (!(PROBE & 24)) PG8_STAGE(bo, g, v); } while (0)
#define PG8_PSTAGEA(bo, g, h, n) do { if constexpr (!(PROBE & 8)) PG8_STAGEA(bo, g, h, n); } while (0)
#define PG8_PWAIT_V8() do { if constexpr (PROBE & 16) PG8_WAIT_V(4); else if constexpr (!(PROBE & 8)) PG8_WAIT_V(8); } while (0)
#define PG8_PMMA0(At, B0, B1) do { if constexpr (!(PROBE & 2)) { PG8_MMA(0, 0, At, B0); PG8_MMA(0, 1, At, B1); } } while (0)
#define PG8_PMMA1(At, B0, B1) do { if constexpr (!(PROBE & 3)) { PG8_MMA(1, 0, At, B0); PG8_MMA(1, 1, At, B1); } } while (0)
#define PG8_WAIT_V(n) asm volatile("s_waitcnt vmcnt(" #n ")" ::: "memory")
#define PG8_WAIT_L(n) asm volatile("s_waitcnt lgkmcnt(" #n ")" ::: "memory")
#define PG8_BAR __builtin_amdgcn_s_barrier()
#define PG8_SCHED __builtin_amdgcn_sched_barrier(0)
    Unit cur, nxt; int ui = 0;
    if (!S.next(0, cur)) return;
    unsigned voC[2][2], voN[2][2];
    if constexpr (Sched::GATHER) {
#pragma unroll
        for (int h = 0; h < 2; ++h)
#pragma unroll
            for (int i = 0; i < 2; ++i) { int R, C; stage_rc(tid * 16 + i * 8192, R, C); voC[h][i] = S.a_off(cur, h * HALF + R, C); voN[h][i] = voC[h][i]; }
    }
    f32x4 acc[2][2][4][2];
#pragma unroll
    for (int a = 0; a < 2; ++a)
#pragma unroll
        for (int b = 0; b < 2; ++b)
#pragma unroll
            for (int m = 0; m < 4; ++m)
#pragma unroll
                for (int n = 0; n < 2; ++n) acc[a][b][m][n] = (f32x4){0.f, 0.f, 0.f, 0.f};
    int f8_scale = 0x7F7F7F7F; asm volatile("" : "+v"(f8_scale));
    bf16x8 At[4][2], B0[2][2], B1[2][2]; v8i32_t At8[4], B08[2], B18[2];
    const char* cA = S.a_ptr(cur); const char* cB = S.b_ptr(cur);
    S.a_ready(cur);
    if constexpr (SP2) {
        PG8_STAGE(PG8_SB(0, 0), cB, voffB); PG8_STAGE(PG8_SB(0, 1), cB + hstep, voffB); PG8_STAGEA(PG8_SA(0, 0), cA, 0, false); PG8_STAGEA(PG8_SA(0, 1), cA, 1, false);
        if (wr == 1) PG8_BAR;
        PG8_WAIT_V(2); PG8_BAR;
        PG8_STAGE(PG8_SB(1, 0), cB + kstep, voffB); PG8_STAGEA(PG8_SA(1, 0), cA + kstep, 0, false); PG8_STAGE(PG8_SB(1, 1), cB + hstep + kstep, voffB);
        PG8_WAIT_V(6); PG8_BAR;
    } else {
        PG8_STAGE(PG8_SB(0, 0), cB, voffB); PG8_STAGEA(PG8_SA(0, 0), cA, 0, false); PG8_STAGE(PG8_SB(0, 1), cB + hstep, voffB); PG8_STAGEA(PG8_SA(0, 1), cA, 1, false);
        if (wr == 1) PG8_BAR;
        PG8_WAIT_V(4); PG8_BAR;
        PG8_STAGE(PG8_SB(1, 0), cB + kstep, voffB); PG8_STAGEA(PG8_SA(1, 0), cA + kstep, 0, false); PG8_STAGE(PG8_SB(1, 1), cB + hstep + kstep, voffB);
        PG8_WAIT_V(6); PG8_BAR;
    }
    for (;;) {
        const bool has_next = S.next(ui + 1, nxt);
        const char* nA = has_next ? S.a_ptr(nxt) : cA; const char* nB = has_next ? S.b_ptr(nxt) : cB;
        if constexpr (Sched::GATHER) { if (has_next) {
#pragma unroll
            for (int h = 0; h < 2; ++h)
#pragma unroll
                for (int i = 0; i < 2; ++i) { int R, C; stage_rc(tid * 16 + i * 8192, R, C); voN[h][i] = S.a_off(nxt, h * HALF + R, C); } } }
#pragma nounroll
        for (int t = 0; t < nt; t += 2) {
            const bool last = (t == nt - 2);
            const char* a1 = cA + (size_t)(t + 1) * kstep;
            const char* a2 = last ? nA : cA + (size_t)(t + 2) * kstep; const char* b2 = last ? nB : cB + (size_t)(t + 2) * kstep;
            const char* a3 = a2 + kstep; const char* b3 = b2 + kstep;
            if (last && has_next) S.a_ready(nxt);
            if constexpr (SP2) {
            PG8_PLDB(B0, 0, 0); PG8_PLDB(B1, 0, 1); PG8_SCHED; PG8_PLDA(At, 0, 0); PG8_PSTAGEA(PG8_SA(1, 1), a1, 1, false);
            PG8_PWAIT_V8(); PG8_WAIT_L(0); PG8_BAR; PG8_PMMA0(At, B0, B1); PG8_BAR; PG8_SCHED;
            PG8_PLDA(At, 0, 1); PG8_PSTAGE(PG8_SB(0, 0), b2, voffB); PG8_PSTAGE(PG8_SB(0, 1), b2 + hstep, voffB); PG8_PSTAGEA(PG8_SA(0, 0), a2, 0, last);
            PG8_PWAIT_V8(); PG8_WAIT_L(0); PG8_BAR; PG8_PMMA1(At, B0, B1); PG8_BAR; PG8_SCHED;
            PG8_PLDB(B0, 1, 0); PG8_PLDB(B1, 1, 1); PG8_SCHED; PG8_PLDA(At, 1, 0); PG8_PSTAGEA(PG8_SA(0, 1), a2, 1, last);
            PG8_PWAIT_V8(); PG8_WAIT_L(0); PG8_BAR; PG8_PMMA0(At, B0, B1); PG8_BAR; PG8_SCHED;
            PG8_PLDA(At, 1, 1); PG8_PSTAGE(PG8_SB(1, 0), b3, voffB); PG8_PSTAGE(PG8_SB(1, 1), b3 + hstep, voffB); PG8_PSTAGEA(PG8_SA(1, 0), a3, 0, last);
            PG8_PWAIT_V8(); PG8_WAIT_L(0); PG8_BAR; PG8_PMMA1(At, B0, B1); PG8_BAR; PG8_SCHED;
            } else {
            PG8_LDB(B0, 0, 0); PG8_SCHED; PG8_LDA(At, 0, 0); PG8_STAGEA(PG8_SA(1, 1), a1, 1, false);
            PG8_WAIT_L(8); PG8_BAR; PG8_WAIT_L(0); PG8_MMA(0, 0, At, B0); PG8_BAR; PG8_SCHED;
            PG8_LDB(B1, 0, 1); PG8_STAGE(PG8_SB(0, 0), b2, voffB);
            PG8_BAR; PG8_WAIT_L(0); PG8_MMA(0, 1, At, B1); PG8_BAR;
            PG8_LDA(At, 0, 1); PG8_STAGEA(PG8_SA(0, 0), a2, 0, last);
            PG8_BAR; PG8_WAIT_L(0); PG8_MMA(1, 0, At, B0); PG8_BAR; PG8_SCHED;
            PG8_STAGE(PG8_SB(0, 1), b2 + hstep, voffB);
            PG8_WAIT_V(6); PG8_BAR; PG8_MMA(1, 1, At, B1); PG8_BAR;
            PG8_LDB(B0, 1, 0); PG8_SCHED; PG8_LDA(At, 1, 0); PG8_STAGEA(PG8_SA(0, 1), a2, 1, last);
            PG8_WAIT_L(8); PG8_BAR; PG8_WAIT_L(0); PG8_MMA(0, 0, At, B0); PG8_BAR; PG8_SCHED;
            PG8_LDB(B1, 1, 1); PG8_STAGE(PG8_SB(1, 0), b3, voffB);
            PG8_BAR; PG8_WAIT_L(0); PG8_MMA(0, 1, At, B1); PG8_BAR;
            PG8_LDA(At, 1, 1); PG8_STAGEA(PG8_SA(1, 0), a3, 0, last);
            PG8_BAR; PG8_WAIT_L(0); PG8_MMA(1, 0, At, B0); PG8_BAR; PG8_SCHED;
            PG8_STAGE(PG8_SB(1, 1), b3 + hstep, voffB);
            PG8_WAIT_V(6); PG8_BAR; PG8_MMA(1, 1, At, B1); PG8_BAR;
            }
        }
        if constexpr (ALIGN_EPI) { if (wr == 0) PG8_BAR; }
        if constexpr (F8) asm volatile("s_nop 15\n\ts_nop 7" ::: "memory");
        if constexpr (!Epi::AFTER_DRAIN) if (!probe_skip_epi) { int t2_ = lane_now(); asm volatile("" : "+v"(t2_)); const int fr_ = t2_ & 15, fq_ = (t2_ >> 4) & 3; E(acc, cur, wr, wc, fr_, fq_); S.done(cur); }
        if (!has_next) break;
        bool keep_acc_ = false; if constexpr (Epi::KEEPS) keep_acc_ = E.keep(cur);
        if (!keep_acc_) {
#pragma unroll
        for (int a = 0; a < 2; ++a)
#pragma unroll
            for (int b = 0; b < 2; ++b)
#pragma unroll
                for (int m = 0; m < 4; ++m)
#pragma unroll
                    for (int n = 0; n < 2; ++n) acc[a][b][m][n] = (f32x4){0.f, 0.f, 0.f, 0.f};
        }
        cur = nxt; cA = nA; cB = nB; ++ui;
        if constexpr (Sched::GATHER) {
#pragma unroll
            for (int h = 0; h < 2; ++h)
#pragma unroll
                for (int i = 0; i < 2; ++i) voC[h][i] = voN[h][i]; }
        if constexpr (ALIGN_EPI) { if (wr == 1) PG8_BAR; }
    }
    PG8_WAIT_V(0);
    if constexpr (!ALIGN_EPI) { if (wr == 0) PG8_BAR; }
    PG8_BAR;
    if constexpr (Epi::AFTER_DRAIN) { E.fused(acc, cur, wr, wc, fr, fq, lds, wid, lane); S.done(cur); }
#undef PG8_SA
#undef PG8_SB
#undef PG8_STAGE
#undef PG8_STAGEA
#undef PG8_LDA
#undef PG8_LDB
#undef PG8_MMA
#undef PG8_PMMA0
#undef PG8_PLDB
#undef PG8_PLDA
#undef PG8_PSTAGE
#undef PG8_PSTAGEA
#undef PG8_PWAIT_V8
#undef PG8_PMMA1
#undef PG8_CAT
#undef PG8_WAIT_V
#undef PG8_WAIT_L
#undef PG8_BAR
#undef PG8_SCHED
}
}

constexpr int NB = 8, SEQ = 4096, DM = 1024, NTOK = NB * SEQ;
constexpr int MEMLEN = 256, NMEM = NB * MEMLEN;
constexpr int IN_PROJ_W = 5024, NPROJ = 5120;
constexpr int QLAT = 384, KVLAT = 256;
constexpr int NEXP = 32, TOPK = 4, DEXP = 1024;
constexpr int MAXTILES = 544;
constexpr float LN_EPS = 1e-5f, RMS_EPS = 1e-6f;
constexpr float DN_ALPHA = 1.189207115002721f;
constexpr float LOG2E = 1.4426950408889634f;

typedef pg8::bf16_t bf16_t;
typedef pg8::f32x4 f32x4;
typedef pg8::f32x2 f32x2;
typedef pg8::u32x2 u32x2;
typedef pg8::u32x4 u32x4;
using pg8::pack4;
using pg8::Unit;
#define LAS __attribute__((address_space(3)))
#define GAS __attribute__((address_space(1)))

__device__ __forceinline__ void tile_of(int L, int nM, int nN, int& pm, int& pn) {
    const int nwg = nM * nN; int wgid = L;
    { const int q = nwg / pg8::NXCD, r = nwg % pg8::NXCD, xcd = wgid % pg8::NXCD, off = wgid / pg8::NXCD; wgid = (xcd < r ? xcd * (q + 1) : r * (q + 1) + (xcd - r) * q) + off; }
    const int nig = pg8::WGM * nN, gid = wgid / nig, fm = gid * pg8::WGM, gsz = (nM - fm) < pg8::WGM ? (nM - fm) : pg8::WGM;
    pm = fm + ((wgid % nig) % gsz); pn = (wgid % nig) / gsz;
}
struct DenseOrder {
    static constexpr bool GATHER = false;
    int nM, nN, nwg, G, c; const char* A; const char* B; size_t tstep;
    __device__ __forceinline__ void init(int M, int N, int K, int G_, int c_, const void* A_, const void* B_) { nM = M / 256; nN = N / 256; nwg = nM * nN; G = G_; c = c_; A = (const char*)A_; B = (const char*)B_; tstep = (size_t)256 * K * 2; }
    __device__ __forceinline__ bool next(int i, Unit& u) const { const long L = (long)i * G + c; if (L >= nwg) return false; tile_of((int)L, nM, nN, u.pm, u.pn); u.aux = 0; return true; }
    __device__ __forceinline__ const char* a_ptr(const Unit& u) const { return A + (size_t)u.pm * tstep; }
    __device__ __forceinline__ const char* b_ptr(const Unit& u) const { return B + (size_t)u.pn * tstep; }
    __device__ __forceinline__ void a_ready(const Unit&) const {}
    __device__ __forceinline__ void done(const Unit&) const {}
};
struct KvbOrder : DenseOrder {
    int lo;
    __device__ __forceinline__ bool next(int i, Unit& u) const {
        const int d = c - lo; long L;
        if (d >= 0 && d < 32) { if (i > 0) return false; L = c; }
        else if (d >= 32 && d < 64) { if (i > 2) return false; L = i < 2 ? (long)i * G + c : (long)G + lo + (d - 32); }
        else { if (i > 1) return false; L = (long)i * G + c; }
        if (L >= nwg) return false; tile_of((int)L, nM, nN, u.pm, u.pn); u.aux = 0; return true; }
};
struct BranchOrder {
    static constexpr bool GATHER = false;
    int G, c; const char *A, *B; size_t tstep, astride, bstride;
    __device__ __forceinline__ bool next(int i, Unit& u) const { const int ti = i / 3, br = i - 3 * ti; const long L = (long)ti * G + c; if (L >= 128 * 4) return false; tile_of((int)L, 128, 4, u.pm, u.pn); u.aux = br; return true; }
    __device__ __forceinline__ const char* a_ptr(const Unit& u) const { return A + (size_t)u.aux * astride + (size_t)u.pm * tstep; }
    __device__ __forceinline__ const char* b_ptr(const Unit& u) const { return B + (size_t)u.aux * bstride + (size_t)u.pn * tstep; }
    __device__ __forceinline__ void a_ready(const Unit&) const {}
    __device__ __forceinline__ void done(const Unit&) const {}
};
template <bool GATHER_> struct MoeOrderT {
    static constexpr bool GATHER = GATHER_;
    int G, c, T, NPN; const char* A; const char* B; size_t tstep; const LAS int* tile_e; const LAS int* ts; const LAS int* cnt; const int* rtok; unsigned apitch;
    __device__ __forceinline__ bool next(int i, Unit& u) const {
        const int L = i * G + c, x = L & 7, y = L >> 3, tp = y / NPN, pn = y - tp * NPN, t = 8 * tp + x;
        if (t >= T) return false;
        u.pm = t; u.pn = pn; u.aux = __builtin_amdgcn_readfirstlane(tile_e[t]); return true;
    }
    __device__ __forceinline__ const char* a_ptr(const Unit& u) const { return GATHER ? A : A + (size_t)u.pm * tstep; }
    __device__ __forceinline__ const char* b_ptr(const Unit& u) const { return B + (size_t)(u.aux * NPN + u.pn) * tstep; }
    __device__ __forceinline__ unsigned a_off(const Unit& u, int r, int c) const {
        const int e = u.aux, rank = (u.pm - __builtin_amdgcn_readfirstlane(ts[e])) * 256 + r; int tok = 0;
        if (rank < __builtin_amdgcn_readfirstlane(cnt[e])) tok = rtok[(unsigned)(e * NTOK + rank)];
        tok = (tok < 0 || tok >= NTOK) ? 0 : tok;
        return (unsigned)tok * apitch + (unsigned)c * 2u;
    }
    __device__ __forceinline__ void a_ready(const Unit&) const {}
    __device__ __forceinline__ void done(const Unit&) const {}
};
typedef MoeOrderT<false> MoeOrder;
typedef MoeOrderT<true> MoeGatherOrder;

typedef const pg8::f32x4 (&AccRef)[2][2][4][2];
__device__ __forceinline__ float fast_sigmoid(float x) { return __builtin_amdgcn_rcpf(1.f + __builtin_amdgcn_exp2f(-x * LOG2E)); }
__device__ __forceinline__ f32x4 sigmoid4(f32x4 v) { f32x4 r; r[0] = fast_sigmoid(v[0]); r[1] = fast_sigmoid(v[1]); r[2] = fast_sigmoid(v[2]); r[3] = fast_sigmoid(v[3]); return r; }
__device__ __forceinline__ float sconst(float v) { return v; }
__device__ __forceinline__ float ssq4(f32x4 v) { return (v[0] * v[0] + v[1] * v[1]) + (v[2] * v[2] + v[3] * v[3]); }
__device__ __forceinline__ float quad_sum(float s) { s += pg8::swz_xor<16>(s); return pg8::half_sum(s); }

__device__ __forceinline__ u32x4 pack8(f32x4 a, f32x4 b) { u32x4 w; w.x = pg8::cvt_pk_bf16(a[0], a[1]); w.y = pg8::cvt_pk_bf16(a[2], a[3]); w.z = pg8::cvt_pk_bf16(b[0], b[1]); w.w = pg8::cvt_pk_bf16(b[2], b[3]); return w; }
__device__ __forceinline__ void unpack8(u32x4 w, f32x4& a, f32x4& b) { a[0] = __uint_as_float(w.x << 16); a[1] = __uint_as_float(w.x & 0xffff0000u); a[2] = __uint_as_float(w.y << 16); a[3] = __uint_as_float(w.y & 0xffff0000u);
    b[0] = __uint_as_float(w.z << 16); b[1] = __uint_as_float(w.z & 0xffff0000u); b[2] = __uint_as_float(w.w << 16); b[3] = __uint_as_float(w.w & 0xffff0000u); }
__device__ __forceinline__ unsigned pk4_u8(f32x4 g) { unsigned w = 0; w = __builtin_amdgcn_cvt_pk_u8_f32(fmaxf(g[0] * 255.0f, 1.0f), 0, w); w = __builtin_amdgcn_cvt_pk_u8_f32(fmaxf(g[1] * 255.0f, 1.0f), 1, w);
    w = __builtin_amdgcn_cvt_pk_u8_f32(fmaxf(g[2] * 255.0f, 1.0f), 2, w); w = __builtin_amdgcn_cvt_pk_u8_f32(fmaxf(g[3] * 255.0f, 1.0f), 3, w); return w; }
__device__ __forceinline__ f32x4 un4_u8(unsigned w) { f32x4 g; g[0] = (float)(w & 0xffu); g[1] = (float)((w >> 8) & 0xffu); g[2] = (float)((w >> 16) & 0xffu); g[3] = (float)(w >> 24); return g; }
__device__ __forceinline__ unsigned gate_rec(int pm, int br, int pn, int wave, int ai, int bj, int m, int lane) { return ((((unsigned)(pm * 3 + br) * 4 + pn) * 8 + wave) * 16 + (ai * 8 + bj * 4 + m)) * 64 + lane; }

__device__ __forceinline__ unsigned pk4_f8(float a, float b, float c, float d) { int w = 0; w = __builtin_amdgcn_cvt_pk_fp8_f32(a, b, w, false); w = __builtin_amdgcn_cvt_pk_fp8_f32(c, d, w, true); return (unsigned)w; }
constexpr float F8_WSCALE = 32.0f, F8_ASCALE = 4.0f, F8_YSCALE = 16.0f;
__device__ __forceinline__ f32x4 un4_f8(unsigned w) { const f32x2 a = __builtin_amdgcn_cvt_pk_f32_fp8((int)w, false), b = __builtin_amdgcn_cvt_pk_f32_fp8((int)w, true); return (f32x4){a[0], a[1], b[0], b[1]}; }

struct EpiInProj {
    static constexpr bool PERM = true, AFTER_DRAIN = false, KEEPS = false;
    bf16_t *Qa, *Ka, *Va, *Qlat, *KVlat, *Kb, *Qm; u32x2* Gates; float* ssq;
    const float *qn, *kn, *bgate, *ropeA, *ropeB;
    __device__ __forceinline__ void operator()(AccRef acc, const Unit& u, int wr, int wc, int fr, int fq) const {
        const int pn = u.pn, rowb = u.pm * 256 + wr * 64 + fr;
        if (pn <= 2) {
            if (pn == 2 && wc >= 2) {
#pragma unroll
                for (int ai = 0; ai < 2; ++ai)
#pragma unroll
                    for (int m = 0; m < 4; ++m) { const int row = rowb + ai * 128 + m * 16; bf16_t* d = Va + (unsigned)row * 128 + (wc - 2) * 64 + 4 * fq;
#pragma unroll
                        for (int bj = 0; bj < 2; ++bj)
#pragma unroll
                            for (int n = 0; n < 2; ++n) *(u32x2*)(d + 32 * bj + 16 * n) = pack4(acc[ai][bj][m][n]); }
            } else {
                const float* gain = pn < 2 ? qn : kn; const int pitch = pn < 2 ? 512 : 128;
                bf16_t* dst = pn < 2 ? Qa + (4 * pn + wc) * 64 : Ka + wc * 64;
                f32x4 g[2][2];
#pragma unroll
                for (int bj = 0; bj < 2; ++bj)
#pragma unroll
                    for (int n = 0; n < 2; ++n) g[bj][n] = *(const f32x4*)(gain + 32 * bj + 16 * n + 4 * fq);
                f32x4 cR[2], sR[2], cC[4], sC[4];
#pragma unroll
                for (int ai = 0; ai < 2; ++ai) { const int rp = ((rowb + ai * 128) & (SEQ - 1)) >> 6; cR[ai] = *(const f32x4*)(ropeA + rp * 16 + 4 * fq); sR[ai] = *(const f32x4*)(ropeA + 1024 + rp * 16 + 4 * fq); }
#pragma unroll
                for (int m = 0; m < 4; ++m) { const int cp = (rowb + m * 16) & 63; cC[m] = *(const f32x4*)(ropeA + cp * 16 + 4 * fq); sC[m] = *(const f32x4*)(ropeA + 1024 + cp * 16 + 4 * fq); }
#pragma unroll
                for (int ai = 0; ai < 2; ++ai)
#pragma unroll
                    for (int m = 0; m < 4; ++m) {
                        const int row = rowb + ai * 128 + m * 16;
                        float ss = (ssq4(acc[ai][0][m][0]) + ssq4(acc[ai][0][m][1])) + (ssq4(acc[ai][1][m][0]) + ssq4(acc[ai][1][m][1]));
                        ss = quad_sum(ss);
                        const float rinv = __builtin_amdgcn_rsqf(ss * (1.0f / 64.0f) + sconst(RMS_EPS)) * (pn < 2 ? 0.125f * LOG2E : 1.0f);
                        bf16_t* d = dst + (unsigned)row * pitch + 4 * fq;
#pragma unroll
                        for (int bj = 0; bj < 2; ++bj) { const f32x4 c4 = bj ? cC[m] : cR[ai], s4 = bj ? sC[m] : sR[ai];
                            const f32x4 x1 = acc[ai][bj][m][0] * rinv * g[bj][0], x2 = acc[ai][bj][m][1] * rinv * g[bj][1];
                            *(u32x2*)(d + 32 * bj) = pack4(x1 * c4 - x2 * s4); *(u32x2*)(d + 32 * bj + 16) = pack4(x2 * c4 + x1 * s4); }
                    }
            }
        } else if (pn == 3 || pn == 5) {
            bf16_t* dst = pn == 3 ? Qlat : KVlat; const int pitch = pn == 3 ? QLAT : KVLAT, slot = (pn == 3 ? 0 : 8) + wc;
#pragma unroll
            for (int ai = 0; ai < 2; ++ai)
#pragma unroll
                for (int m = 0; m < 4; ++m) { const int row = rowb + ai * 128 + m * 16; bf16_t* d = dst + (unsigned)row * pitch + 32 * wc + 8 * fq;
                    float ss = (ssq4(acc[ai][0][m][0]) + ssq4(acc[ai][0][m][1])) + (ssq4(acc[ai][1][m][0]) + ssq4(acc[ai][1][m][1]));
                    ss = quad_sum(ss); if (fq == 0) ssq[(unsigned)row * 12 + slot] = ss;
#pragma unroll
                    for (int bj = 0; bj < 2; ++bj) *(u32x4*)(d + 128 * bj) = pack8(acc[ai][bj][m][0], acc[ai][bj][m][1]); }
        } else if (pn == 4) {
            const int a_ = fq >> 1, i0_ = 4 * (fq & 1); f32x4 ec[4], es[4];
            if (wc == 0) {
#pragma unroll
                for (int k = 0; k < 4; ++k) { const int pos = a_ ? ((rowb + k * 16) & 63) : (((rowb + (k & 1) * 128) & (SEQ - 1)) >> 6);
                    ec[k] = *(const f32x4*)(ropeB + pos * 8 + i0_); es[k] = *(const f32x4*)(ropeB + 512 + pos * 8 + i0_); } }
#pragma unroll
            for (int ai = 0; ai < 2; ++ai)
#pragma unroll
                for (int m = 0; m < 4; ++m) { const int row = rowb + ai * 128 + m * 16;
                    float ss = ssq4(acc[ai][0][m][0]) + ssq4(acc[ai][0][m][1]);
                    ss = quad_sum(ss); if (fq == 0) ssq[(unsigned)row * 12 + 4 + wc] = ss;
                    *(u32x4*)(Qlat + (unsigned)row * QLAT + 256 + 32 * wc + 8 * fq) = pack8(acc[ai][0][m][0], acc[ai][0][m][1]);
                    if (wc == 0) { const int a = a_, i0 = i0_;
                        const f32x4 c4 = a ? ec[m] : ec[ai], s4 = a ? es[m] : es[ai];
                        const f32x4 x1 = acc[ai][1][m][0], x2 = acc[ai][1][m][1];
                        const u32x2 o1 = pack4(x1 * c4 - x2 * s4), o2 = pack4(x2 * c4 + x1 * s4);
                        bf16_t* kd = Kb + (unsigned)row * 768 + 64 + 16 * a + i0;
#pragma unroll
                        for (int h = 0; h < 8; ++h) { *(u32x2*)(kd + h * 96) = o1; *(u32x2*)(kd + h * 96 + 8) = o2; } }
                }
        } else if (pn <= 7) {
#pragma unroll
            for (int ai = 0; ai < 2; ++ai)
#pragma unroll
                for (int m = 0; m < 4; ++m) { const int row = rowb + ai * 128 + m * 16; bf16_t* d = Qm + (unsigned)row * 512 + (pn - 6) * 256 + 32 * wc + 8 * fq;
#pragma unroll
                    for (int bj = 0; bj < 2; ++bj) *(u32x4*)(d + 128 * bj) = pack8(acc[ai][bj][m][0], acc[ai][bj][m][1]); }
        } else {
            const int br = (pn - 8) >> 2, pt = (pn - 8) & 3, col0 = (pn - 8) * 256 + 32 * wc + 8 * fq, lane = fq * 16 + fr, wave = wr * 4 + wc; f32x4 bv[2][2];
#pragma unroll
            for (int bj = 0; bj < 2; ++bj)
#pragma unroll
                for (int n = 0; n < 2; ++n) bv[bj][n] = *(const f32x4*)(bgate + col0 + 128 * bj + 4 * n);
#pragma unroll
            for (int ai = 0; ai < 2; ++ai)
#pragma unroll
                for (int m = 0; m < 4; ++m)
#pragma unroll
                    for (int bj = 0; bj < 2; ++bj)
                        { u32x2 w; w.x = pk4_u8(sigmoid4(acc[ai][bj][m][0] + bv[bj][0])); w.y = pk4_u8(sigmoid4(acc[ai][bj][m][1] + bv[bj][1])); Gates[gate_rec(u.pm, br, pt, wave, ai, bj, m, lane)] = w; }
        }
    }
};
struct EpiQb {
    static constexpr bool PERM = true, AFTER_DRAIN = false, KEEPS = false;
    bf16_t* Qb; const float* ssq; const float* ropeB;
    __device__ __forceinline__ void operator()(AccRef acc, const Unit& u, int wr, int wc, int fr, int fq) const {
        const int pn = u.pn, rowb = u.pm * 256 + wr * 64 + fr; const float eps = sconst(RMS_EPS), invn = sconst(1.0f / (float)QLAT);
        float rinv[2][4];
#pragma unroll
        for (int ai = 0; ai < 2; ++ai) { f32x4 s0[4], s1[4];
#pragma unroll
            for (int m = 0; m < 4; ++m) { const int row = rowb + ai * 128 + m * 16; s0[m] = *(const f32x4*)(ssq + (unsigned)row * 12); s1[m] = *(const f32x4*)(ssq + (unsigned)row * 12 + 4); }
#pragma unroll
            for (int m = 0; m < 4; ++m) { const float tot = ((s0[m][0] + s0[m][1]) + (s0[m][2] + s0[m][3])) + ((s1[m][0] + s1[m][1]) + (s1[m][2] + s1[m][3]));
                rinv[ai][m] = __builtin_amdgcn_rsqf(tot * invn + eps) * (0.10206207261596575f * LOG2E); } }
        if (pn < 2) {
#pragma unroll
            for (int ai = 0; ai < 2; ++ai)
#pragma unroll
                for (int m = 0; m < 4; ++m) { const int row = rowb + ai * 128 + m * 16; const float ri = rinv[ai][m];
#pragma unroll
                    for (int bj = 0; bj < 2; ++bj) { const int c = 128 * bj + 32 * wc + 8 * fq, head = 4 * pn + (c >> 6), d = c & 63;
                        *(u32x4*)(Qb + (unsigned)row * 768 + head * 96 + d) = pack8(acc[ai][bj][m][0] * ri, acc[ai][bj][m][1] * ri); } }
        } else { const int a = fq >> 1, i0 = 4 * (fq & 1); f32x4 ec[4], es[4];
#pragma unroll
            for (int k = 0; k < 4; ++k) { const int pos = a ? ((rowb + k * 16) & 63) : (((rowb + (k & 1) * 128) & (SEQ - 1)) >> 6);
                ec[k] = *(const f32x4*)(ropeB + pos * 8 + i0); es[k] = *(const f32x4*)(ropeB + 512 + pos * 8 + i0); }
#pragma unroll
            for (int ai = 0; ai < 2; ++ai)
#pragma unroll
                for (int m = 0; m < 4; ++m) { const int row = rowb + ai * 128 + m * 16; const float ri = rinv[ai][m];
                    const f32x4 c4 = a ? ec[m] : ec[ai], s4 = a ? es[m] : es[ai];
#pragma unroll
                    for (int bj = 0; bj < 2; ++bj) { const f32x4 x1 = acc[ai][bj][m][0] * ri, x2 = acc[ai][bj][m][1] * ri;
                        bf16_t* qd = Qb + (unsigned)row * 768 + (4 * bj + wc) * 96 + 64 + 16 * a + i0;
                        *(u32x2*)qd = pack4(x1 * c4 - x2 * s4); *(u32x2*)(qd + 8) = pack4(x2 * c4 + x1 * s4); } }
        }
    }
};
struct EpiKVb {
    static constexpr bool PERM = true, AFTER_DRAIN = false, KEEPS = false;
    bf16_t *Kb, *Vb; const float* ssq;
    __device__ __forceinline__ void operator()(AccRef acc, const Unit& u, int wr, int wc, int fr, int fq) const {
        const int pn = u.pn, rowb = u.pm * 256 + wr * 64 + fr;
        f32x4 s0[2][4];
#pragma unroll
        for (int ai = 0; ai < 2; ++ai)
#pragma unroll
            for (int m = 0; m < 4; ++m) s0[ai][m] = *(const f32x4*)(ssq + (unsigned)(rowb + ai * 128 + m * 16) * 12 + 8);
#pragma unroll
        for (int ai = 0; ai < 2; ++ai)
#pragma unroll
            for (int m = 0; m < 4; ++m) { const int row = rowb + ai * 128 + m * 16;
                const float rinv = __builtin_amdgcn_rsqf(((s0[ai][m][0] + s0[ai][m][1]) + (s0[ai][m][2] + s0[ai][m][3])) * sconst(1.0f / (float)KVLAT) + sconst(RMS_EPS));
#pragma unroll
                for (int bj = 0; bj < 2; ++bj) { const int h = 2 * pn + bj, dd = 32 * wc + 8 * fq;
                    bf16_t* d = (wc < 2) ? Kb + (unsigned)row * 768 + h * 96 + dd : Vb + (unsigned)row * 512 + h * 64 + (dd - 64);
                    *(u32x4*)d = pack8(acc[ai][bj][m][0] * rinv, acc[ai][bj][m][1] * rinv); }
            }
    }
};
struct EpiPlain {
    static constexpr bool PERM = true, AFTER_DRAIN = false, KEEPS = false;
    bf16_t* O; int ldc;
    __device__ __forceinline__ void operator()(AccRef acc, const Unit& u, int wr, int wc, int fr, int fq) const {
        const int rowb = u.pm * 256 + wr * 64 + fr, col0 = u.pn * 256 + 32 * wc + 8 * fq;
#pragma unroll
        for (int ai = 0; ai < 2; ++ai)
#pragma unroll
            for (int m = 0; m < 4; ++m) { bf16_t* d = O + (unsigned)(rowb + ai * 128 + m * 16) * (unsigned)ldc + col0;
#pragma unroll
                for (int bj = 0; bj < 2; ++bj) *(u32x4*)(d + 128 * bj) = pack8(acc[ai][bj][m][0], acc[ai][bj][m][1]); }
    }
};
struct EpiBranch {
    static constexpr bool PERM = true, AFTER_DRAIN = false, KEEPS = true;
    const u32x2* Gates; bf16_t* Merged;
    __device__ __forceinline__ bool keep(const Unit& u) const { return u.aux < 2; }
    __device__ __forceinline__ void operator()(pg8::f32x4 (&acc)[2][2][4][2], const Unit& u, int wr, int wc, int fr, int fq) const {
        const int br = u.aux, rowb = u.pm * 256 + wr * 64 + fr, col0 = u.pn * 256 + 32 * wc + 8 * fq, lane = fq * 16 + fr, wave = wr * 4 + wc;
        if (br < 2) {
#pragma unroll
            for (int ai = 0; ai < 2; ++ai) { u32x2 ga[4][2], gb[4][2];
#pragma unroll
                for (int m = 0; m < 4; ++m)
#pragma unroll
                    for (int bj = 0; bj < 2; ++bj) { ga[m][bj] = Gates[gate_rec(u.pm, br, u.pn, wave, ai, bj, m, lane)]; gb[m][bj] = Gates[gate_rec(u.pm, br + 1, u.pn, wave, ai, bj, m, lane)]; }
#pragma unroll
                for (int m = 0; m < 4; ++m)
#pragma unroll
                    for (int bj = 0; bj < 2; ++bj) { const f32x4 a0 = un4_u8(ga[m][bj].x), a1 = un4_u8(ga[m][bj].y), b0 = un4_u8(gb[m][bj].x), b1 = un4_u8(gb[m][bj].y);
#pragma unroll
                        for (int j = 0; j < 4; ++j) { acc[ai][bj][m][0][j] *= a0[j] * __builtin_amdgcn_rcpf(b0[j]); acc[ai][bj][m][1][j] *= a1[j] * __builtin_amdgcn_rcpf(b1[j]); } } }
        } else {
#pragma unroll
            for (int ai = 0; ai < 2; ++ai) { u32x2 gw[4][2];
#pragma unroll
                for (int m = 0; m < 4; ++m)
#pragma unroll
                    for (int bj = 0; bj < 2; ++bj) gw[m][bj] = Gates[gate_rec(u.pm, 2, u.pn, wave, ai, bj, m, lane)];
#pragma unroll
                for (int m = 0; m < 4; ++m) { const int row = rowb + ai * 128 + m * 16;
#pragma unroll
                    for (int bj = 0; bj < 2; ++bj) { const f32x4 g0 = un4_u8(gw[m][bj].x) * (1.0f / 255.0f), g1 = un4_u8(gw[m][bj].y) * (1.0f / 255.0f);
                        *(u32x4*)(Merged + (unsigned)row * 1024 + col0 + 128 * bj) = pack8(acc[ai][bj][m][0] * g0, acc[ai][bj][m][1] * g1); } } }
        }
    }
};
struct EpiOutProj {
    static constexpr bool PERM = true, AFTER_DRAIN = false, KEEPS = false;
    const float* x; const float* stats0; const float* g; const float* b; float* pre;
    __device__ __forceinline__ void operator()(AccRef acc, const Unit& u, int wr, int wc, int fr, int fq) const {
        const int rowb = u.pm * 256 + wr * 64 + fr, col0 = u.pn * 256 + 32 * wc + 8 * fq; f32x4 gv[2][2], bv[2][2];
#pragma unroll
        for (int bj = 0; bj < 2; ++bj)
#pragma unroll
            for (int n = 0; n < 2; ++n) { gv[bj][n] = *(const f32x4*)(g + col0 + 128 * bj + 4 * n); bv[bj][n] = *(const f32x4*)(b + col0 + 128 * bj + 4 * n); }
#pragma unroll
        for (int ai = 0; ai < 2; ++ai)
#pragma unroll
            for (int m = 0; m < 4; ++m) { const int row = rowb + ai * 128 + m * 16; const f32x2 st = *(const f32x2*)(stats0 + (unsigned)row * 2);
#pragma unroll
                for (int bj = 0; bj < 2; ++bj)
#pragma unroll
                    for (int n = 0; n < 2; ++n) { const unsigned off = (unsigned)row * 1024 + col0 + 128 * bj + 4 * n;
                        const f32x4 xv = *(const f32x4*)(x + off); const f32x4 h0 = (xv - st.x) * st.y * gv[bj][n] + bv[bj][n];
                        *(f32x4*)(pre + off) = h0 * DN_ALPHA + acc[ai][bj][m][n]; }
            }
    }
};
struct EpiSwiglu {
    static constexpr bool PERM = true, AFTER_DRAIN = false, KEEPS = false;
    const float* bin; unsigned char* Act;
    __device__ __forceinline__ void operator()(AccRef acc, const Unit& u, int wr, int wc, int fr, int fq) const {
        const int e = u.aux, rowb = u.pm * 256 + wr * 64 + fr, col0 = u.pn * 128 + 32 * wc + 8 * fq; f32x4 bg[2], bl[2];
#pragma unroll
        for (int n = 0; n < 2; ++n) { bg[n] = *(const f32x4*)(bin + (size_t)e * 2048 + col0 + 4 * n); bl[n] = *(const f32x4*)(bin + (size_t)e * 2048 + 1024 + col0 + 4 * n); }
#pragma unroll
        for (int ai = 0; ai < 2; ++ai)
#pragma unroll
            for (int m = 0; m < 4; ++m) { const int row = rowb + ai * 128 + m * 16; f32x4 o[2];
#pragma unroll
                for (int n = 0; n < 2; ++n) { const f32x4 hg = acc[ai][0][m][n] * (1.0f / F8_WSCALE) + bg[n], hl = acc[ai][1][m][n] * (1.0f / F8_WSCALE) + bl[n];
#pragma unroll
                    for (int j = 0; j < 4; ++j) { const float xg = fminf(hg[j], 7.0f), xl = fminf(fmaxf(hl[j], -7.0f), 7.0f); o[n][j] = xg * fast_sigmoid(1.702f * xg) * (xl + 1.0f) * F8_ASCALE; } }
                u32x2 w; w.x = pk4_f8(o[0][0], o[0][1], o[0][2], o[0][3]); w.y = pk4_f8(o[1][0], o[1][1], o[1][2], o[1][3]);
                *(u32x2*)(Act + (unsigned)row * 1024 + col0) = w;
            }
    }
};
struct EpiExpOut {
    static constexpr bool PERM = true, AFTER_DRAIN = false, KEEPS = false;
    const float* bout; const float* rank_w; const LAS int* tstart; unsigned char* Ys;
    __device__ __forceinline__ void operator()(AccRef acc, const Unit& u, int wr, int wc, int fr, int fq) const {
        const int e = u.aux, rl = wr * 64 + fr, rowb = u.pm * 256 + rl, col0 = u.pn * 256 + 32 * wc + 8 * fq; f32x4 bv[2][2];
        const int rank0 = (u.pm - __builtin_amdgcn_readfirstlane(tstart[e])) * 256 + rl;
#pragma unroll
        for (int bj = 0; bj < 2; ++bj)
#pragma unroll
            for (int n = 0; n < 2; ++n) bv[bj][n] = *(const f32x4*)(bout + (size_t)e * 1024 + col0 + 128 * bj + 4 * n);
        float wv[2][4];
#pragma unroll
        for (int ai = 0; ai < 2; ++ai)
#pragma unroll
            for (int m = 0; m < 4; ++m) wv[ai][m] = rank_w[(size_t)e * NTOK + rank0 + ai * 128 + m * 16];
#pragma unroll
        for (int ai = 0; ai < 2; ++ai)
#pragma unroll
            for (int m = 0; m < 4; ++m) { const int row = rowb + ai * 128 + m * 16; const float w = wv[ai][m] * F8_YSCALE;
#pragma unroll
                for (int bj = 0; bj < 2; ++bj) { const f32x4 y0 = (acc[ai][bj][m][0] * (1.0f / (F8_WSCALE * F8_ASCALE)) + bv[bj][0]) * w, y1 = (acc[ai][bj][m][1] * (1.0f / (F8_WSCALE * F8_ASCALE)) + bv[bj][1]) * w;
                    u32x2 o; o.x = pk4_f8(y0[0], y0[1], y0[2], y0[3]); o.y = pk4_f8(y1[0], y1[1], y1[2], y1[3]); *(u32x2*)(Ys + (unsigned)row * 1024 + col0 + 128 * bj) = o; } }
    }
};

namespace att {
using bf16x8 = __attribute__((ext_vector_type(8))) short;
using s16x4  = __attribute__((ext_vector_type(4))) short;
using f32x16 = __attribute__((ext_vector_type(16))) float;
#define ASBAR() __builtin_amdgcn_sched_barrier(0)
__device__ __forceinline__ int crow(int r, int hi) { return (r & 3) + 8 * (r >> 2) + 4 * hi; }
__device__ __forceinline__ unsigned cvtpk(float lo, float hi) { return pg8::cvt_pk_bf16(lo, hi); }
constexpr float THR = 8.f;
__device__ __forceinline__ void partialSM(f32x16& p0, f32x16& p1, float& m_reg, float& mn, float& alpha, float C, float thr_raw) {
  float pmax = p0[0];
#pragma unroll
  for (int r = 1; r < 16; ++r) pmax = fmaxf(pmax, p0[r]);
#pragma unroll
  for (int r = 0; r < 16; ++r) pmax = fmaxf(pmax, p1[r]);
  { auto rr = __builtin_amdgcn_permlane32_swap(__float_as_uint(pmax), __float_as_uint(pmax), false, false);
    pmax = fmaxf(__uint_as_float(rr[0]), __uint_as_float(rr[1])); }
  if (__builtin_expect(__all(pmax - m_reg <= thr_raw), 1)) { mn = m_reg; alpha = 1.f; }
  else { mn = fmaxf(m_reg, pmax); alpha = __builtin_amdgcn_exp2f((m_reg - mn) * C); m_reg = mn; }
  const float mnC = -mn * C;
#pragma unroll
  for (int r = 0; r < 16; ++r) p0[r] = fmaf(p0[r], C, mnC);
#pragma unroll
  for (int r = 0; r < 16; ++r) p1[r] = fmaf(p1[r], C, mnC);
#pragma unroll
  for (int r = 0; r < 16; ++r) p0[r] = __builtin_amdgcn_exp2f(p0[r]);
}
__device__ __forceinline__ void finishSM(f32x16& p0, f32x16& p1, float alpha, float& l_reg, bf16x8& pa0, bf16x8& pa1, bf16x8& pa2, bf16x8& pa3) {
#pragma unroll
  for (int r = 0; r < 16; ++r) p1[r] = __builtin_amdgcn_exp2f(p1[r]);
  float ps = 0;
#pragma unroll
  for (int r = 0; r < 16; ++r) ps += p0[r];
#pragma unroll
  for (int r = 0; r < 16; ++r) ps += p1[r];
  { auto rr = __builtin_amdgcn_permlane32_swap(__float_as_uint(ps), __float_as_uint(ps), false, false);
    ps = __uint_as_float(rr[0]) + __uint_as_float(rr[1]); }
  l_reg = l_reg * alpha + ps;
#define ATT_PK4(P, BASE, OUT) do { unsigned a0 = cvtpk(P[BASE + 0], P[BASE + 1]), a1 = cvtpk(P[BASE + 2], P[BASE + 3]);   \
    unsigned b0 = cvtpk(P[BASE + 4], P[BASE + 5]), b1 = cvtpk(P[BASE + 6], P[BASE + 7]);                              \
    auto r0 = __builtin_amdgcn_permlane32_swap(a0, b0, false, false); auto r1 = __builtin_amdgcn_permlane32_swap(a1, b1, false, false); \
    u32x4 w = {r0[0], r1[0], r0[1], r1[1]}; OUT = *reinterpret_cast<bf16x8*>(&w); } while (0)
  ATT_PK4(p0, 0, pa0); ATT_PK4(p0, 8, pa1); ATT_PK4(p1, 0, pa2); ATT_PK4(p1, 8, pa3);
#undef ATT_PK4
}
template <int DQK> __device__ __forceinline__ void qkt(f32x16& p0, f32x16& p1, const char* Ks, const bf16x8* qr, int r32, int hi) {
  constexpr int KROW = DQK * 2 + 16;
  p0 = f32x16{}; p1 = f32x16{};
#pragma unroll
  for (int d0 = 0; d0 < DQK / 16; ++d0) { const int cb = (d0 * 16 + hi * 8) * 2;
    const bf16x8 b0 = *reinterpret_cast<const bf16x8*>(Ks + r32 * KROW + cb);
    const bf16x8 b1 = *reinterpret_cast<const bf16x8*>(Ks + (32 + r32) * KROW + cb);
    p0 = __builtin_amdgcn_mfma_f32_32x32x16_bf16(b0, qr[d0], p0, 0, 0, 0);
    p1 = __builtin_amdgcn_mfma_f32_32x32x16_bf16(b1, qr[d0], p1, 0, 0, 0); }
}
template <int NCG, bool SW23 = true> __device__ __forceinline__ int v_st(int k, int c) { const int kk = SW23 ? ((k & ~0xC) | ((k & 4) << 1) | ((k & 8) >> 1)) : k; return ((kk >> 3) * NCG + (c >> 5)) * 512 + ((kk & 7) * 32 + (c & 31)) * 2; }
__device__ __forceinline__ int v_rd_base(int lane) { return ((lane & 3) << 3) | (((lane >> 2) & 3) << 6) | (((lane >> 4) & 1) << 5) | (((lane >> 5) & 1) << 8); }
template <int OFF> __device__ __forceinline__ s16x4 tr_read(int vb) { s16x4 r; asm volatile("ds_read_b64_tr_b16 %0, %1 offset:%2" : "=&v"(r) : "v"(vb), "i"(OFF) : "memory"); return r; }
template <int D0, int NCG> __device__ __forceinline__ void pv_one(f32x16& od, int vb, bf16x8 pa0, bf16x8 pa1, bf16x8 pa2, bf16x8 pa3) {
  constexpr int KS = 2 * NCG * 512, HF = NCG * 512, B = D0 * 512;
  const s16x4 l0 = tr_read<B + 0 * KS>(vb), h0 = tr_read<B + 0 * KS + HF>(vb), l1 = tr_read<B + 1 * KS>(vb), h1 = tr_read<B + 1 * KS + HF>(vb);
  const s16x4 l2 = tr_read<B + 2 * KS>(vb), h2 = tr_read<B + 2 * KS + HF>(vb), l3 = tr_read<B + 3 * KS>(vb), h3 = tr_read<B + 3 * KS + HF>(vb);
  asm volatile("s_waitcnt lgkmcnt(0)" ::: "memory"); ASBAR();
#define ATT_PK(L, H) (bf16x8){L[0], L[1], L[2], L[3], H[0], H[1], H[2], H[3]}
  od = __builtin_amdgcn_mfma_f32_32x32x16_bf16(pa0, ATT_PK(l0, h0), od, 0, 0, 0);
  od = __builtin_amdgcn_mfma_f32_32x32x16_bf16(pa1, ATT_PK(l1, h1), od, 0, 0, 0);
  od = __builtin_amdgcn_mfma_f32_32x32x16_bf16(pa2, ATT_PK(l2, h2), od, 0, 0, 0);
  od = __builtin_amdgcn_mfma_f32_32x32x16_bf16(pa3, ATT_PK(l3, h3), od, 0, 0, 0);
#undef ATT_PK
}
template <int NCG> __device__ __forceinline__ void pv_all(f32x16* o, int vb, bf16x8 pa0, bf16x8 pa1, bf16x8 pa2, bf16x8 pa3) {
  pv_one<0, NCG>(o[0], vb, pa0, pa1, pa2, pa3); pv_one<1, NCG>(o[1], vb, pa0, pa1, pa2, pa3);
  if constexpr (NCG == 4) { pv_one<2, NCG>(o[2], vb, pa0, pa1, pa2, pa3); pv_one<3, NCG>(o[3], vb, pa0, pa1, pa2, pa3); }
}
template <int OFF> __device__ __forceinline__ bf16x8 lds_read128(int addr) { bf16x8 r; asm volatile("ds_read_b128 %0, %1 offset:%2" : "=&v"(r) : "v"(addr), "i"(OFF) : "memory"); return r; }
template <int N> __device__ __forceinline__ void lgkm_wait() { asm volatile("s_waitcnt lgkmcnt(%0)" :: "n"(N) : "memory"); __builtin_amdgcn_sched_barrier(0); }
template <int D0, int NCG> __device__ __forceinline__ void v_reads(s16x4 (&vl)[4], s16x4 (&vh)[4], int vb) {
  constexpr int KS = 2 * NCG * 512, HF = NCG * 512, B = D0 * 512;
  vl[0] = tr_read<B + 0 * KS>(vb); vh[0] = tr_read<B + 0 * KS + HF>(vb); vl[1] = tr_read<B + 1 * KS>(vb); vh[1] = tr_read<B + 1 * KS + HF>(vb);
  vl[2] = tr_read<B + 2 * KS>(vb); vh[2] = tr_read<B + 2 * KS + HF>(vb); vl[3] = tr_read<B + 3 * KS>(vb); vh[3] = tr_read<B + 3 * KS + HF>(vb);
}
__device__ __forceinline__ void pv_mma(f32x16& od, const s16x4 (&vl)[4], const s16x4 (&vh)[4], bf16x8 pa0, bf16x8 pa1, bf16x8 pa2, bf16x8 pa3) {
#define ATT_PK(L, H) (bf16x8){L[0], L[1], L[2], L[3], H[0], H[1], H[2], H[3]}
  od = __builtin_amdgcn_mfma_f32_32x32x16_bf16(pa0, ATT_PK(vl[0], vh[0]), od, 0, 0, 0);
  od = __builtin_amdgcn_mfma_f32_32x32x16_bf16(pa1, ATT_PK(vl[1], vh[1]), od, 0, 0, 0);
  od = __builtin_amdgcn_mfma_f32_32x32x16_bf16(pa2, ATT_PK(vl[2], vh[2]), od, 0, 0, 0);
  od = __builtin_amdgcn_mfma_f32_32x32x16_bf16(pa3, ATT_PK(vl[3], vh[3]), od, 0, 0, 0);
#undef ATT_PK
}
template <int DQK, int NCG, bool PV> __device__ __forceinline__ void m_segment(f32x16& p0, f32x16& p1, f32x16* o, const char* Ks, int vb, const bf16x8* qr, bf16x8 pa0, bf16x8 pa1, bf16x8 pa2, bf16x8 pa3, int r32, int hi) {
  constexpr int KROW = DQK * 2 + 16, ND0 = DQK / 16;
  const int ka = (int)(uintptr_t)Ks + r32 * KROW + hi * 16;
  bf16x8 kf[2 * ND0];
  kf[0] = lds_read128<0>(ka); kf[1] = lds_read128<32 * KROW>(ka); kf[2] = lds_read128<32>(ka); kf[3] = lds_read128<32 + 32 * KROW>(ka);
  kf[4] = lds_read128<64>(ka); kf[5] = lds_read128<64 + 32 * KROW>(ka); kf[6] = lds_read128<96>(ka); kf[7] = lds_read128<96 + 32 * KROW>(ka);
  if constexpr (ND0 > 4) { kf[8] = lds_read128<128>(ka); kf[9] = lds_read128<128 + 32 * KROW>(ka); kf[10] = lds_read128<160>(ka); kf[11] = lds_read128<160 + 32 * KROW>(ka); }
  if constexpr (ND0 > 6) { kf[12] = lds_read128<192>(ka); kf[13] = lds_read128<192 + 32 * KROW>(ka); kf[14] = lds_read128<224>(ka); kf[15] = lds_read128<224 + 32 * KROW>(ka); }
  s16x4 vlA[4], vhA[4], vlB[4], vhB[4];
  if constexpr (PV) { v_reads<0, NCG>(vlA, vhA, vb); lgkm_wait<8>(); } else lgkm_wait<0>();
  p0 = f32x16{}; p1 = f32x16{};
#pragma unroll
  for (int d0 = 0; d0 < ND0; ++d0) { p0 = __builtin_amdgcn_mfma_f32_32x32x16_bf16(kf[2 * d0], qr[d0], p0, 0, 0, 0); p1 = __builtin_amdgcn_mfma_f32_32x32x16_bf16(kf[2 * d0 + 1], qr[d0], p1, 0, 0, 0); }
  if constexpr (PV) {
    __builtin_amdgcn_sched_barrier(0);
    v_reads<1, NCG>(vlB, vhB, vb); lgkm_wait<8>(); pv_mma(o[0], vlA, vhA, pa0, pa1, pa2, pa3);
    if constexpr (NCG == 2) { lgkm_wait<0>(); pv_mma(o[1], vlB, vhB, pa0, pa1, pa2, pa3); }
    else { __builtin_amdgcn_sched_barrier(0); v_reads<2, NCG>(vlA, vhA, vb); lgkm_wait<8>(); pv_mma(o[1], vlB, vhB, pa0, pa1, pa2, pa3);
           __builtin_amdgcn_sched_barrier(0); v_reads<3, NCG>(vlB, vhB, vb); lgkm_wait<8>(); pv_mma(o[2], vlA, vhA, pa0, pa1, pa2, pa3);
           lgkm_wait<0>(); pv_mma(o[3], vlB, vhB, pa0, pa1, pa2, pa3); }
  }
}
template <int DQK, int DV> struct Cfg {
  static constexpr int KROW = DQK * 2 + 16, SHM_K = 64 * KROW, SHM_V = 64 * DV * 2, NCG = DV / 32, KCH = DQK / 8, VCH = DV / 8;
  static constexpr int KPT = (64 * KCH + 511) / 512, VPT = (64 * VCH + 511) / 512, LDS = 2 * SHM_V + 2 * SHM_K + 8 * 64 * 4, LDS2 = LDS + 8 * 32 * 64 * 2;
};
template <int DQK, int DV, int LDQ, int LDK, int LDV, int LDO>
__device__ __forceinline__ void attn_body(const bf16_t* Qb, const bf16_t* __restrict__ Kh, const bf16_t* __restrict__ Vh, bf16_t* Ob, int seq, float C, float thr_raw, char* lds, const int wave_id) {
  using CF = Cfg<DQK, DV>;
  constexpr int KROW = CF::KROW, SHM_K = CF::SHM_K, SHM_V = CF::SHM_V, NCG = CF::NCG, KCH = CF::KCH, VCH = CF::VCH, KPT = CF::KPT, VPT = CF::VPT, ND0 = DQK / 16, NDB = DV / 32, SDEPTH = 2;
  int lane_ = pg8::lane_now(); asm volatile("" : "+v"(lane_));
  const int lane = lane_, wid = wave_id, tid = wave_id * 64 + lane, r32 = lane & 31, hi = lane >> 5;
  char* V_lds = lds; char* K_lds = lds + 2 * SHM_V;
  float* ws = (float*)(lds + 2 * SHM_V + 2 * SHM_K) + wid * 64; float* li_l = ws; float* al_l = ws + 32;
  float m_reg = -1e30f, l_reg = 0; f32x16 o[NDB]; bf16x8 qr[ND0];
#pragma unroll
  for (int d = 0; d < NDB; ++d) o[d] = f32x16{};
  const bf16_t* Qw = Qb + (long)(wid * 32 + r32) * LDQ + hi * 8;
#pragma unroll
  for (int d0 = 0; d0 < ND0; ++d0) qr[d0] = *reinterpret_cast<const bf16x8*>(Qw + d0 * 16);
  int kgo[KPT], klo[KPT], vgo[VPT], vlo[VPT]; bool kval[KPT];
#pragma unroll
  for (int j = 0; j < KPT; ++j) { const int p = tid + 512 * j, row = p / KCH, ch = p - row * KCH; kval[j] = p < 64 * KCH; kgo[j] = row * LDK + ch * 8; klo[j] = row * KROW + ch * 16; }
#pragma unroll
  for (int j = 0; j < VPT; ++j) { const int p = tid + 512 * j, key = p / VCH, c = (p - key * VCH) * 8; vgo[j] = key * LDV + c; vlo[j] = v_st<NCG>(key, c); }
  const int vb0 = (int)(uintptr_t)V_lds + v_rd_base(lane);
  bf16x8 sk[SDEPTH][KPT], sv[SDEPTH][VPT];
#define ATT_SLOAD(i, k0) do { _Pragma("unroll") for (int j_ = 0; j_ < VPT; ++j_) sv[i][j_] = *reinterpret_cast<const bf16x8*>(Vh + (long)(k0) * LDV + vgo[j_]); \
    _Pragma("unroll") for (int j_ = 0; j_ < KPT; ++j_) if (kval[j_]) sk[i][j_] = *reinterpret_cast<const bf16x8*>(Kh + (long)(k0) * LDK + kgo[j_]); } while (0)
#define ATT_SWRITE(b, i) do { _Pragma("unroll") for (int j_ = 0; j_ < VPT; ++j_) *reinterpret_cast<bf16x8*>(V_lds + (b) * SHM_V + vlo[j_]) = sv[i][j_]; \
    _Pragma("unroll") for (int j_ = 0; j_ < KPT; ++j_) if (kval[j_]) *reinterpret_cast<bf16x8*>(K_lds + (b) * SHM_K + klo[j_]) = sk[i][j_]; } while (0)
#define ATT_SWAIT() asm volatile("s_waitcnt vmcnt(%0)" :: "n"(KPT + VPT) : "memory")
#define ATT_RESC(a) do { if (__any((a) < 1.f)) { if (hi == 0) al_l[r32] = (a); asm volatile("s_waitcnt lgkmcnt(0)" ::: "memory"); \
    _Pragma("unroll") for (int d_ = 0; d_ < NDB; ++d_) _Pragma("unroll") for (int r_ = 0; r_ < 16; ++r_) o[d_][r_] *= al_l[crow(r_, hi)]; } } while (0)
  f32x16 pA0, pA1, pB0, pB1; float mnA, mnB, alA, alB; bf16x8 pa0, pa1, pa2, pa3; const int NT = seq / 64;
  constexpr int SE = 0, SO = SDEPTH - 1;
  ATT_SLOAD(SE, 0); asm volatile("s_waitcnt vmcnt(0)" ::: "memory"); ATT_SWRITE(0, SE); __syncthreads();
  qkt<DQK>(pA0, pA1, K_lds, qr, r32, hi); partialSM(pA0, pA1, m_reg, mnA, alA, C, thr_raw);
  ATT_SLOAD(SO, 64); if (2 < NT) ATT_SLOAD(SE, 2 * 64);
  ATT_SWAIT(); ATT_SWRITE(1, SO); __syncthreads();
  for (int j = 1; j + 1 < NT; j += 2) {
    ASBAR(); qkt<DQK>(pB0, pB1, K_lds + SHM_K, qr, r32, hi);
    finishSM(pA0, pA1, alA, l_reg, pa0, pa1, pa2, pa3); ASBAR();
    ATT_SLOAD(SO, (j + SDEPTH) * 64); ASBAR();
    pv_all<NCG>(o, vb0, pa0, pa1, pa2, pa3); partialSM(pB0, pB1, m_reg, mnB, alB, C, thr_raw);
    __syncthreads(); ATT_SWAIT(); ATT_SWRITE(0, SE);
    ATT_RESC(alB); __syncthreads();
    ASBAR(); qkt<DQK>(pA0, pA1, K_lds, qr, r32, hi);
    finishSM(pB0, pB1, alB, l_reg, pa0, pa1, pa2, pa3); ASBAR();
    if (j + 3 < NT) ATT_SLOAD(SE, (j + 1 + SDEPTH) * 64); ASBAR();
    pv_all<NCG>(o, vb0 + SHM_V, pa0, pa1, pa2, pa3); partialSM(pA0, pA1, m_reg, mnA, alA, C, thr_raw);
    __syncthreads(); ATT_SWAIT(); ATT_SWRITE(1, SO);
    ATT_RESC(alA); __syncthreads();
  }
  ASBAR(); qkt<DQK>(pB0, pB1, K_lds + SHM_K, qr, r32, hi);
  finishSM(pA0, pA1, alA, l_reg, pa0, pa1, pa2, pa3); ASBAR();
  pv_all<NCG>(o, vb0, pa0, pa1, pa2, pa3); partialSM(pB0, pB1, m_reg, mnB, alB, C, thr_raw);
  __syncthreads(); ATT_RESC(alB);
  finishSM(pB0, pB1, alB, l_reg, pa0, pa1, pa2, pa3); ASBAR();
  pv_all<NCG>(o, vb0 + SHM_V, pa0, pa1, pa2, pa3);
  if (hi == 0) li_l[r32] = l_reg; asm volatile("s_waitcnt lgkmcnt(0)" ::: "memory");
  float rli[16];
#pragma unroll
  for (int r = 0; r < 16; ++r) rli[r] = __builtin_amdgcn_rcpf(li_l[crow(r, hi)]);
  bf16_t* Ow = Ob + (long)(wid * 32) * LDO;
#pragma unroll
  for (int r = 0; r < 16; ++r) { const int orow = crow(r, hi);
#pragma unroll
    for (int d0 = 0; d0 < NDB; ++d0) { const unsigned w = cvtpk(o[d0][r] * rli[r], 0.f); Ow[(long)orow * LDO + d0 * 32 + r32] = (bf16_t)(w & 0xffffu); } }
  __syncthreads();
#undef ATT_SLOAD
#undef ATT_SWRITE
#undef ATT_SWAIT
#undef ATT_RESC
}

template <int DQK, int DV, int LDQ, int LDK, int LDV, int LDO>
__device__ __forceinline__ void attn_body2(const bf16_t* Qb, const bf16_t* __restrict__ Kh, const bf16_t* __restrict__ Vh, bf16_t* Ob, int seq, float C, float thr_raw, char* lds, const int wave_id) {
  using CF = Cfg<DQK, DV>;
  constexpr int KROW = CF::KROW, SHM_K = CF::SHM_K, SHM_V = CF::SHM_V, NCG = CF::NCG, KCH = CF::KCH, VCH = CF::VCH, KPT = CF::KPT, VPT = CF::VPT, ND0 = DQK / 16, NDB = DV / 32;
  int lane_ = pg8::lane_now(); asm volatile("" : "+v"(lane_));
  const int lane = lane_, wid = wave_id, tid = wave_id * 64 + lane, r32 = lane & 31, hi = lane >> 5, g = wid >> 2;
  char* V_lds = lds; char* K_lds = lds + 2 * SHM_V;
  float* ws = (float*)(lds + 2 * SHM_V + 2 * SHM_K) + wid * 64; float* li_l = ws; float* al_l = ws + 32;
  bf16_t* stg = (bf16_t*)(lds + 2 * SHM_V + 2 * SHM_K + 8 * 64 * 4) + wid * (32 * 64);
  float m_reg = -1e30f, l_reg = 0; f32x16 o[NDB]; bf16x8 qr[ND0];
#pragma unroll
  for (int d = 0; d < NDB; ++d) o[d] = f32x16{};
  const bf16_t* Qw = Qb + (long)(wid * 32 + r32) * LDQ + hi * 8;
#pragma unroll
  for (int d0 = 0; d0 < ND0; ++d0) qr[d0] = *reinterpret_cast<const bf16x8*>(Qw + d0 * 16);
  int kgo[KPT], klo[KPT], vgo[VPT], vlo[VPT];
#pragma unroll
  for (int j = 0; j < KPT; ++j) { int p = tid + 512 * j; if (p >= 64 * KCH) p = tid; const int row = p / KCH, ch = p - row * KCH; kgo[j] = row * LDK + ch * 8; klo[j] = row * KROW + ch * 16; }
#pragma unroll
  for (int j = 0; j < VPT; ++j) { const int p = tid + 512 * j, key = p / VCH, c = (p - key * VCH) * 8; vgo[j] = key * LDV + c; vlo[j] = v_st<NCG>(key, c); }
  const int vb0 = (int)(uintptr_t)V_lds + v_rd_base(lane);
  bf16x8 sk0[KPT], sv0[VPT], sk1[KPT], sv1[VPT], sk2[KPT], sv2[VPT], sk3[KPT], sv3[VPT];
  const int NT = seq / 64, TL = NT - 1;
#define A2_LOAD(S, kx, vx) do { const int kx_ = (kx) < TL ? (kx) : TL, vx_ = (vx) < TL ? (vx) : TL; \
    _Pragma("unroll") for (int j_ = 0; j_ < KPT; ++j_) sk##S[j_] = *reinterpret_cast<const bf16x8*>(Kh + (long)kx_ * 64 * LDK + kgo[j_]); \
    _Pragma("unroll") for (int j_ = 0; j_ < VPT; ++j_) sv##S[j_] = *reinterpret_cast<const bf16x8*>(Vh + (long)vx_ * 64 * LDV + vgo[j_]); } while (0)
#define A2_WRITE(S, kx, vx) do { _Pragma("unroll") for (int j_ = 0; j_ < KPT; ++j_) *reinterpret_cast<bf16x8*>(K_lds + ((kx) & 1) * SHM_K + klo[j_]) = sk##S[j_]; \
    _Pragma("unroll") for (int j_ = 0; j_ < VPT; ++j_) *reinterpret_cast<bf16x8*>(V_lds + ((vx) & 1) * SHM_V + vlo[j_]) = sv##S[j_]; } while (0)
#define A2_STAGE(S, t_) do { A2_WRITE(S, (t_) + 1 + g, (t_) + g); A2_LOAD(S, (t_) + 5 + g, (t_) + 4 + g); } while (0)
#define A2_PIN_O() do { _Pragma("unroll") for (int d_ = 0; d_ < NDB; ++d_) asm volatile("" : "+v"(o[d_])); } while (0)
#define A2_MSEG(t_) do { if ((t_) > 0) m_segment<DQK, NCG, true>(p0, p1, o, K_lds + ((t_) & 1) * SHM_K, vb0 + (((t_) - 1) & 1) * SHM_V, qr, pa0, pa1, pa2, pa3, r32, hi); \
    else m_segment<DQK, NCG, false>(p0, p1, o, K_lds + ((t_) & 1) * SHM_K, vb0, qr, pa0, pa1, pa2, pa3, r32, hi); \
    ASBAR(); __syncthreads(); ASBAR(); asm volatile("" : "+v"(p0), "+v"(p1)); A2_PIN_O(); } while (0)
#define A2_VSEG(S, t_) do { { float mn_; partialSM(p0, p1, m_reg, mn_, alpha, C, thr_raw); (void)mn_; } \
    finishSM(p0, p1, alpha, l_reg, pa0, pa1, pa2, pa3); \
    if (__any(alpha < 1.f)) { if (hi == 0) al_l[r32] = alpha; asm volatile("s_waitcnt lgkmcnt(0)" ::: "memory"); \
      _Pragma("unroll") for (int d_ = 0; d_ < NDB; ++d_) _Pragma("unroll") for (int r_ = 0; r_ < 16; ++r_) o[d_][r_] *= al_l[crow(r_, hi)]; } \
    A2_STAGE(S, t_); asm volatile("" : "+v"(pa0), "+v"(pa1), "+v"(pa2), "+v"(pa3), "+v"(l_reg), "+v"(m_reg)); A2_PIN_O(); ASBAR(); __syncthreads(); ASBAR(); } while (0)
  { A2_LOAD(0, 0, 0); _Pragma("unroll") for (int j_ = 0; j_ < KPT; ++j_) *reinterpret_cast<bf16x8*>(K_lds + klo[j_]) = sk0[j_]; }
  if (g) { A2_LOAD(3, 1, 0); A2_LOAD(0, 2, 1); A2_LOAD(1, 3, 2); A2_LOAD(2, 4, 3); }
  else   { A2_LOAD(0, 1, 0); A2_LOAD(1, 2, 1); A2_LOAD(2, 3, 2); A2_LOAD(3, 4, 3); }
  __syncthreads();
  if (g) { A2_STAGE(3, -1); __syncthreads(); }
  f32x16 p0, p1; bf16x8 pa0, pa1, pa2, pa3; float alpha = 1.f;
  for (int t = 0; t < NT; t += 4) {
    A2_MSEG(t);     A2_VSEG(0, t);
    A2_MSEG(t + 1); A2_VSEG(1, t + 1);
    A2_MSEG(t + 2); A2_VSEG(2, t + 2);
    A2_MSEG(t + 3); A2_VSEG(3, t + 3);
  }
  pv_all<NCG>(o, vb0 + ((NT - 1) & 1) * SHM_V, pa0, pa1, pa2, pa3);
  if (!g) __syncthreads();
  if (hi == 0) li_l[r32] = l_reg; asm volatile("s_waitcnt lgkmcnt(0)" ::: "memory");
  float rli[16];
#pragma unroll
  for (int r = 0; r < 16; ++r) rli[r] = __builtin_amdgcn_rcpf(li_l[crow(r, hi)]);
  bf16_t* Ow = Ob + (long)(wid * 32) * LDO;
#pragma unroll
  for (int hb = 0; hb < NDB / 2; ++hb) {
#pragma unroll
    for (int r = 0; r < 16; ++r) { const int orow = crow(r, hi);
#pragma unroll
      for (int d0 = 0; d0 < 2; ++d0) stg[orow * 64 + d0 * 32 + r32] = (bf16_t)(cvtpk(o[2 * hb + d0][r] * rli[r], 0.f) & 0xffffu); }
    asm volatile("s_waitcnt lgkmcnt(0)" ::: "memory");
#pragma unroll
    for (int i = 0; i < 4; ++i) { const int idx = i * 64 + lane, row = idx >> 3, ch = idx & 7;
      *reinterpret_cast<u32x4*>(Ow + (long)row * LDO + hb * 64 + ch * 8) = *reinterpret_cast<const u32x4*>(stg + row * 64 + ch * 8); }
    asm volatile("s_waitcnt lgkmcnt(0)" ::: "memory");
  }
  __syncthreads();
#undef A2_LOAD
#undef A2_WRITE
#undef A2_STAGE
#undef A2_MSEG
#undef A2_PIN_O
#undef A2_VSEG
}

template <int DQK, int DV, int LDQ, int LDK, int LDV, int LDO>
__device__ __forceinline__ void attn_body3(const bf16_t* Qb, const bf16_t* __restrict__ Kh, const bf16_t* __restrict__ Vh, bf16_t* Ob, int seq, float C, float thr_raw, char* lds, const int wave_id) {
  using CF = Cfg<DQK, DV>;
  constexpr int KROW = CF::KROW, SHM_K = CF::SHM_K, SHM_V = CF::SHM_V, NCG = CF::NCG, KCH = CF::KCH, VCH = CF::VCH, KPT = CF::KPT, VPT = CF::VPT, ND0 = DQK / 16, NDB = DV / 32;
  static_assert(NCG == 2, "attn_body3: DV = 64");
  int lane_ = pg8::lane_now(); asm volatile("" : "+v"(lane_));
  const int lane = lane_, wid = wave_id, tid = wave_id * 64 + lane, r32 = lane & 31, hi = lane >> 5;
  char* V_lds = lds; char* K_lds = lds + 2 * SHM_V;
  float* ws = (float*)(lds + 2 * SHM_V + 2 * SHM_K) + wid * 64; float* li_l = ws; float* al_l = ws + 32;
  bf16_t* stg = (bf16_t*)(lds + 2 * SHM_V + 2 * SHM_K + 8 * 64 * 4) + wid * (32 * 64);
  float m_reg = -1e30f, l_reg = 0; f32x16 o[NDB]; bf16x8 qr[ND0];
#pragma unroll
  for (int d = 0; d < NDB; ++d) o[d] = f32x16{};
  const bf16_t* Qw = Qb + (long)(wid * 32 + r32) * LDQ + hi * 8;
#pragma unroll
  for (int d0 = 0; d0 < ND0; ++d0) qr[d0] = *reinterpret_cast<const bf16x8*>(Qw + d0 * 16);
  int kgo[KPT], klo[KPT], vgo[VPT], vlo[VPT];
#pragma unroll
  for (int j = 0; j < KPT; ++j) { int p = tid + 512 * j; if (p >= 64 * KCH) p = tid; const int row = p / KCH, ch = p - row * KCH; kgo[j] = row * LDK + ch * 8; klo[j] = row * KROW + ch * 16; }
#pragma unroll
  for (int j = 0; j < VPT; ++j) { const int p = tid + 512 * j, key = p / VCH, c = (p - key * VCH) * 8; vgo[j] = key * LDV + c; vlo[j] = v_st<NCG>(key, c); }
  const int vb0 = (int)(uintptr_t)V_lds + v_rd_base(lane);
  const int ka0 = (int)(uintptr_t)K_lds + r32 * KROW + hi * 16;
  bf16x8 sk0[KPT], sv0[VPT], sk1[KPT], sv1[VPT];
  const int NT = seq / 64, TL = NT - 1;
#define A3_KLOAD(S, kx) do { const int kx_ = (kx) < TL ? (kx) : TL; _Pragma("unroll") for (int j_ = 0; j_ < KPT; ++j_) sk##S[j_] = *reinterpret_cast<const bf16x8*>(Kh + (long)kx_ * 64 * LDK + kgo[j_]); } while (0)
#define A3_VLOAD(S, vx) do { const int vx_ = (vx) < TL ? (vx) : TL; _Pragma("unroll") for (int j_ = 0; j_ < VPT; ++j_) sv##S[j_] = *reinterpret_cast<const bf16x8*>(Vh + (long)vx_ * 64 * LDV + vgo[j_]); } while (0)
#define A3_KWRITE(S, kx) do { _Pragma("unroll") for (int j_ = 0; j_ < KPT; ++j_) *reinterpret_cast<bf16x8*>(K_lds + ((kx) & 1) * SHM_K + klo[j_]) = sk##S[j_]; } while (0)
#define A3_VWRITE(S, vx) do { _Pragma("unroll") for (int j_ = 0; j_ < VPT; ++j_) *reinterpret_cast<bf16x8*>(V_lds + ((vx) & 1) * SHM_V + vlo[j_]) = sv##S[j_]; } while (0)
#define A3_KREADS(kf, x) do { const int ka_ = ka0 + ((x) & 1) * SHM_K; \
    kf[0] = lds_read128<0>(ka_); kf[1] = lds_read128<32 * KROW>(ka_); kf[2] = lds_read128<32>(ka_); kf[3] = lds_read128<32 + 32 * KROW>(ka_); \
    kf[4] = lds_read128<64>(ka_); kf[5] = lds_read128<64 + 32 * KROW>(ka_); kf[6] = lds_read128<96>(ka_); kf[7] = lds_read128<96 + 32 * KROW>(ka_); \
    if constexpr (ND0 > 4) { kf[8] = lds_read128<128>(ka_); kf[9] = lds_read128<128 + 32 * KROW>(ka_); kf[10] = lds_read128<160>(ka_); kf[11] = lds_read128<160 + 32 * KROW>(ka_); } } while (0)
#define A3_SGB_MFMA_VALU(nm, nv) do { _Pragma("unroll") for (int i_ = 0; i_ < (nm); ++i_) { __builtin_amdgcn_sched_group_barrier(0x008, 1, 0); __builtin_amdgcn_sched_group_barrier(0x002, (nv), 0); } } while (0)
#define A3_ITER(t_, S, PC0, PC1, PN0, PN1, PV_) do { \
    __syncthreads(); \
    bf16x8 kf_[2 * ND0]; s16x4 vlA_[4], vhA_[4], vlB_[4], vhB_[4]; const int vp_ = vb0 + (((t_) - 1) & 1) * SHM_V; \
    v_reads<0, NCG>(vlA_, vhA_, vp_); v_reads<1, NCG>(vlB_, vhB_, vp_); A3_KREADS(kf_, (t_) + 1); \
    A3_KWRITE(S, (t_) + 2); A3_VWRITE(S, (t_)); A3_KLOAD(S, (t_) + 4); A3_VLOAD(S, (t_) + 2); \
    lgkm_wait<0>(); \
    if (PV_) { pv_mma(o[0], vlA_, vhA_, pa0, pa1, pa2, pa3); pv_mma(o[1], vlB_, vhB_, pa0, pa1, pa2, pa3); } \
    { float mn_; partialSM(PC0, PC1, m_reg, mn_, alpha, C, thr_raw); (void)mn_; } \
    A3_SGB_MFMA_VALU(8, 10); ASBAR(); \
    PN0 = f32x16{}; PN1 = f32x16{}; \
    _Pragma("unroll") for (int d0 = 0; d0 < ND0; ++d0) { PN0 = __builtin_amdgcn_mfma_f32_32x32x16_bf16(kf_[2 * d0], qr[d0], PN0, 0, 0, 0); PN1 = __builtin_amdgcn_mfma_f32_32x32x16_bf16(kf_[2 * d0 + 1], qr[d0], PN1, 0, 0, 0); } \
    finishSM(PC0, PC1, alpha, l_reg, pa0, pa1, pa2, pa3); \
    A3_SGB_MFMA_VALU(2 * ND0, 6); ASBAR(); \
    if (__any(alpha < 1.f)) { if (hi == 0) al_l[r32] = alpha; asm volatile("s_waitcnt lgkmcnt(0)" ::: "memory"); \
      _Pragma("unroll") for (int d_ = 0; d_ < NDB; ++d_) _Pragma("unroll") for (int r_ = 0; r_ < 16; ++r_) o[d_][r_] *= al_l[crow(r_, hi)]; } \
  } while (0)
  A3_KLOAD(0, 0); A3_KLOAD(1, 1); A3_KWRITE(0, 0); A3_KWRITE(1, 1);
  A3_KLOAD(0, 2); A3_VLOAD(0, 0); A3_KLOAD(1, 3); A3_VLOAD(1, 1);
  __syncthreads();
  f32x16 pA0, pA1, pB0, pB1; bf16x8 pa0, pa1, pa2, pa3; float alpha = 1.f;
  pa0 = bf16x8{}; pa1 = bf16x8{}; pa2 = bf16x8{}; pa3 = bf16x8{};
  qkt<DQK>(pA0, pA1, K_lds, qr, r32, hi);
  A3_ITER(0, 0, pA0, pA1, pB0, pB1, 0);
  for (int t = 1; t + 1 < NT; t += 2) {
    A3_ITER(t, 1, pB0, pB1, pA0, pA1, 1);
    A3_ITER(t + 1, 0, pA0, pA1, pB0, pB1, 1);
  }
  A3_ITER(NT - 1, 1, pB0, pB1, pA0, pA1, 1);
  __syncthreads();
  { s16x4 vlA_[4], vhA_[4], vlB_[4], vhB_[4]; const int vp_ = vb0 + ((NT - 1) & 1) * SHM_V;
    v_reads<0, NCG>(vlA_, vhA_, vp_); v_reads<1, NCG>(vlB_, vhB_, vp_); lgkm_wait<0>();
    pv_mma(o[0], vlA_, vhA_, pa0, pa1, pa2, pa3); pv_mma(o[1], vlB_, vhB_, pa0, pa1, pa2, pa3); }
  if (hi == 0) li_l[r32] = l_reg; asm volatile("s_waitcnt lgkmcnt(0)" ::: "memory");
  float rli[16];
#pragma unroll
  for (int r = 0; r < 16; ++r) rli[r] = __builtin_amdgcn_rcpf(li_l[crow(r, hi)]);
  bf16_t* Ow = Ob + (long)(wid * 32) * LDO;
#pragma unroll
  for (int r = 0; r < 16; ++r) { const int orow = crow(r, hi);
#pragma unroll
    for (int d0 = 0; d0 < 2; ++d0) stg[orow * 64 + d0 * 32 + r32] = (bf16_t)(cvtpk(o[d0][r] * rli[r], 0.f) & 0xffffu); }
  asm volatile("s_waitcnt lgkmcnt(0)" ::: "memory");
#pragma unroll
  for (int i = 0; i < 4; ++i) { const int idx = i * 64 + lane, row = idx >> 3, ch = idx & 7;
    *reinterpret_cast<u32x4*>(Ow + (long)row * LDO + ch * 8) = *reinterpret_cast<const u32x4*>(stg + row * 64 + ch * 8); }
  __syncthreads();
#undef A3_KLOAD
#undef A3_VLOAD
#undef A3_KWRITE
#undef A3_VWRITE
#undef A3_KREADS
#undef A3_SGB_MFMA_VALU
#undef A3_ITER
}

constexpr float THR2 = 11.541560327111707f;
template <int DQK, int DV, int LDQ, int LDK, int LDV, int LDO, bool NOMAX, int NS, bool MSUM, bool KHOIST>
__device__ __forceinline__ void attn_body4(const bf16_t* Qb, const bf16_t* __restrict__ Kh, const bf16_t* __restrict__ Vh, bf16_t* Ob, int seq, float offs, char* lds, const int wave_id) {
  using CF = Cfg<DQK, DV>;
  constexpr int KROW = CF::KROW, SHM_K = CF::SHM_K, SHM_V = CF::SHM_V, NCG = CF::NCG, KCH = CF::KCH, VCH = CF::VCH, KPT = CF::KPT, VPT = CF::VPT, ND0 = DQK / 16, NDB = DV / 32;
  static_assert(NCG == 2, "attn_body4: DV = 64");
  int lane_ = pg8::lane_now(); asm volatile("" : "+v"(lane_));
  const int lane = lane_, wid = wave_id, tid = wave_id * 64 + lane, r32 = lane & 31, hi = lane >> 5;
  char* V_lds = lds; char* K_lds = lds + 2 * SHM_V;
  float* ws = (float*)(lds + 2 * SHM_V + 2 * SHM_K) + wid * 64; float* li_l = ws; float* al_l = ws + 32;
  bf16_t* stg = (bf16_t*)(lds + 2 * SHM_V + 2 * SHM_K + 8 * 64 * 4) + wid * (32 * 64);
  float m_run = 0.f, l_reg = 0.f; f32x16 o[NDB], osum, negt; bf16x8 qr[ND0];
#pragma unroll
  for (int d = 0; d < NDB; ++d) o[d] = f32x16{};
  osum = f32x16{};
#pragma unroll
  for (int r = 0; r < 16; ++r) negt[r] = NOMAX ? -offs : 0.f;
  const short one_ = (r32 == 0) ? (short)0x3F80 : (short)0;
  const bf16x8 ones = {one_, one_, one_, one_, one_, one_, one_, one_};
  const bf16_t* Qw = Qb + (long)(wid * 32 + r32) * LDQ + hi * 8;
#pragma unroll
  for (int d0 = 0; d0 < ND0; ++d0) qr[d0] = *reinterpret_cast<const bf16x8*>(Qw + d0 * 16);
  int kgo[KPT], klo[KPT], vgo[VPT], vlo[VPT];
#pragma unroll
  for (int j = 0; j < KPT; ++j) { int p = tid + 512 * j; if (p >= 64 * KCH) p = tid; const int row = p / KCH, ch = p - row * KCH; kgo[j] = row * LDK + ch * 8; klo[j] = row * KROW + ch * 16; }
#pragma unroll
  for (int j = 0; j < VPT; ++j) { const int p = tid + 512 * j, key = p / VCH, c = (p - key * VCH) * 8; vgo[j] = key * LDV + c; vlo[j] = v_st<NCG>(key, c); }
  const int vb0 = (int)(uintptr_t)V_lds + v_rd_base(lane);
  const int ka0 = (int)(uintptr_t)K_lds + r32 * KROW + hi * 16;
  bf16x8 sk0[KPT], sv0[VPT], sk1[KPT], sv1[VPT], sk2[KPT], sv2[VPT], sk3[KPT], sv3[VPT];
  const int NT = seq / 64, TL = NT - 1;
#define A4_KLOAD(S, kx) do { const int kx_ = (kx) < TL ? (kx) : TL; _Pragma("unroll") for (int j_ = 0; j_ < KPT; ++j_) sk##S[j_] = *reinterpret_cast<const bf16x8*>(Kh + (long)kx_ * 64 * LDK + kgo[j_]); } while (0)
#define A4_VLOAD(S, vx) do { const int vx_ = (vx) < TL ? (vx) : TL; _Pragma("unroll") for (int j_ = 0; j_ < VPT; ++j_) sv##S[j_] = *reinterpret_cast<const bf16x8*>(Vh + (long)vx_ * 64 * LDV + vgo[j_]); } while (0)
#define A4_KWRITE(S, kx) do { _Pragma("unroll") for (int j_ = 0; j_ < KPT; ++j_) *reinterpret_cast<bf16x8*>(K_lds + ((kx) & 1) * SHM_K + klo[j_]) = sk##S[j_]; } while (0)
#define A4_VWRITE(S, vx) do { _Pragma("unroll") for (int j_ = 0; j_ < VPT; ++j_) *reinterpret_cast<bf16x8*>(V_lds + ((vx) & 1) * SHM_V + vlo[j_]) = sv##S[j_]; } while (0)
#define A4_KREADS(kf, x) do { const int ka_ = ka0 + ((x) & 1) * SHM_K; \
    kf[0] = lds_read128<0>(ka_); kf[1] = lds_read128<32 * KROW>(ka_); kf[2] = lds_read128<32>(ka_); kf[3] = lds_read128<32 + 32 * KROW>(ka_); \
    kf[4] = lds_read128<64>(ka_); kf[5] = lds_read128<64 + 32 * KROW>(ka_); kf[6] = lds_read128<96>(ka_); kf[7] = lds_read128<96 + 32 * KROW>(ka_); \
    if constexpr (ND0 > 4) { kf[8] = lds_read128<128>(ka_); kf[9] = lds_read128<128 + 32 * KROW>(ka_); kf[10] = lds_read128<160>(ka_); kf[11] = lds_read128<160 + 32 * KROW>(ka_); } } while (0)
#define A4_SGB(nm, nv) do { _Pragma("unroll") for (int i_ = 0; i_ < (nm); ++i_) { __builtin_amdgcn_sched_group_barrier(0x008, 1, 0); __builtin_amdgcn_sched_group_barrier(0x002, (nv), 0); } } while (0)
#define A4_PK4(P, BASE, OUT) do { unsigned a0_ = cvtpk(P[BASE + 0], P[BASE + 1]), a1_ = cvtpk(P[BASE + 2], P[BASE + 3]), b0_ = cvtpk(P[BASE + 4], P[BASE + 5]), b1_ = cvtpk(P[BASE + 6], P[BASE + 7]); \
    auto r0_ = __builtin_amdgcn_permlane32_swap(a0_, b0_, false, false); auto r1_ = __builtin_amdgcn_permlane32_swap(a1_, b1_, false, false); \
    u32x4 w_ = {r0_[0], r1_[0], r0_[1], r1_[1]}; OUT = *reinterpret_cast<bf16x8*>(&w_); } while (0)
#define A4_PV(vlA, vhA, vlB, vhB) do { pv_mma(o[0], vlA, vhA, pa0, pa1, pa2, pa3); pv_mma(o[1], vlB, vhB, pa0, pa1, pa2, pa3); \
    if constexpr (MSUM) { osum = __builtin_amdgcn_mfma_f32_32x32x16_bf16(pa0, ones, osum, 0, 0, 0); osum = __builtin_amdgcn_mfma_f32_32x32x16_bf16(pa1, ones, osum, 0, 0, 0); \
                           osum = __builtin_amdgcn_mfma_f32_32x32x16_bf16(pa2, ones, osum, 0, 0, 0); osum = __builtin_amdgcn_mfma_f32_32x32x16_bf16(pa3, ones, osum, 0, 0, 0); } } while (0)
#define A4_QK(PN0, PN1, x) do { const char* kb_ = K_lds + ((x) & 1) * SHM_K + r32 * KROW + hi * 16; \
    PN0 = __builtin_amdgcn_mfma_f32_32x32x16_bf16(*reinterpret_cast<const bf16x8*>(kb_), qr[0], negt, 0, 0, 0); \
    PN1 = __builtin_amdgcn_mfma_f32_32x32x16_bf16(*reinterpret_cast<const bf16x8*>(kb_ + 32 * KROW), qr[0], negt, 0, 0, 0); \
    _Pragma("unroll") for (int d0 = 1; d0 < ND0; ++d0) { \
      PN0 = __builtin_amdgcn_mfma_f32_32x32x16_bf16(*reinterpret_cast<const bf16x8*>(kb_ + d0 * 32), qr[d0], PN0, 0, 0, 0); \
      PN1 = __builtin_amdgcn_mfma_f32_32x32x16_bf16(*reinterpret_cast<const bf16x8*>(kb_ + d0 * 32 + 32 * KROW), qr[d0], PN1, 0, 0, 0); } } while (0)
#define A4_OSUM() do { if constexpr (MSUM) { osum = __builtin_amdgcn_mfma_f32_32x32x16_bf16(pa0, ones, osum, 0, 0, 0); osum = __builtin_amdgcn_mfma_f32_32x32x16_bf16(pa1, ones, osum, 0, 0, 0); \
    osum = __builtin_amdgcn_mfma_f32_32x32x16_bf16(pa2, ones, osum, 0, 0, 0); osum = __builtin_amdgcn_mfma_f32_32x32x16_bf16(pa3, ones, osum, 0, 0, 0); } } while (0)
#define A4_ITER(t_, S, PC0, PC1, PN0, PN1, PV_) do { \
    __syncthreads(); \
    s16x4 vlA_[4], vhA_[4]; const int vp_ = vb0 + (((t_) - 1) & 1) * SHM_V; \
    if (PV_) v_reads<0, NCG>(vlA_, vhA_, vp_); \
    bf16x8 kf_[2 * ND0]; if constexpr (KHOIST) A4_KREADS(kf_, (t_) + 1); \
    A4_KWRITE(S, (t_) + 2); A4_VWRITE(S, (t_)); A4_KLOAD(S, (t_) + 2 + NS); A4_VLOAD(S, (t_) + NS); \
    if (PV_) A4_OSUM(); \
    if constexpr (!NOMAX) { \
      float pmax_ = PC0[0]; \
      _Pragma("unroll") for (int r_ = 1; r_ < 16; ++r_) pmax_ = fmaxf(pmax_, PC0[r_]); \
      _Pragma("unroll") for (int r_ = 0; r_ < 16; ++r_) pmax_ = fmaxf(pmax_, PC1[r_]); \
      { auto rr_ = __builtin_amdgcn_permlane32_swap(__float_as_uint(pmax_), __float_as_uint(pmax_), false, false); pmax_ = fmaxf(__uint_as_float(rr_[0]), __uint_as_float(rr_[1])); } \
      if (__builtin_expect(__all(pmax_ <= THR2), 1)) alpha = 1.f; \
      else { const float dl_ = fmaxf(pmax_, 0.f); m_run += dl_; alpha = __builtin_amdgcn_exp2f(-dl_); \
        _Pragma("unroll") for (int r_ = 0; r_ < 16; ++r_) { PC0[r_] -= dl_; PC1[r_] -= dl_; negt[r_] = -m_run; } } \
    } \
    if constexpr (KHOIST) lgkm_wait<2 * ND0 + KPT + VPT>(); else lgkm_wait<0>(); \
    if (PV_) pv_mma(o[0], vlA_, vhA_, pa0, pa1, pa2, pa3); \
    _Pragma("unroll") for (int r_ = 0; r_ < 8; ++r_) PC0[r_] = __builtin_amdgcn_exp2f(PC0[r_]); \
    A4_SGB((PV_) ? 4 : 0, 2); ASBAR(); \
    s16x4 vlB_[4], vhB_[4]; \
    if (PV_) v_reads<1, NCG>(vlB_, vhB_, vp_); \
    _Pragma("unroll") for (int r_ = 8; r_ < 16; ++r_) PC0[r_] = __builtin_amdgcn_exp2f(PC0[r_]); \
    lgkm_wait<0>(); \
    if (PV_) pv_mma(o[1], vlB_, vhB_, pa0, pa1, pa2, pa3); \
    _Pragma("unroll") for (int r_ = 0; r_ < 8; ++r_) PC1[r_] = __builtin_amdgcn_exp2f(PC1[r_]); \
    A4_SGB((PV_) ? 4 : 0, 2); ASBAR(); \
    if constexpr (KHOIST) { PN0 = __builtin_amdgcn_mfma_f32_32x32x16_bf16(kf_[0], qr[0], negt, 0, 0, 0); PN1 = __builtin_amdgcn_mfma_f32_32x32x16_bf16(kf_[1], qr[0], negt, 0, 0, 0); \
      _Pragma("unroll") for (int d0 = 1; d0 < ND0; ++d0) { PN0 = __builtin_amdgcn_mfma_f32_32x32x16_bf16(kf_[2 * d0], qr[d0], PN0, 0, 0, 0); PN1 = __builtin_amdgcn_mfma_f32_32x32x16_bf16(kf_[2 * d0 + 1], qr[d0], PN1, 0, 0, 0); } } \
    else A4_QK(PN0, PN1, (t_) + 1); \
    _Pragma("unroll") for (int r_ = 8; r_ < 16; ++r_) PC1[r_] = __builtin_amdgcn_exp2f(PC1[r_]); \
    if constexpr (!MSUM) { float ps_ = 0.f; \
      _Pragma("unroll") for (int r_ = 0; r_ < 16; ++r_) ps_ += PC0[r_]; \
      _Pragma("unroll") for (int r_ = 0; r_ < 16; ++r_) ps_ += PC1[r_]; \
      { auto rr_ = __builtin_amdgcn_permlane32_swap(__float_as_uint(ps_), __float_as_uint(ps_), false, false); ps_ = __uint_as_float(rr_[0]) + __uint_as_float(rr_[1]); } \
      l_reg = l_reg * alpha + ps_; } \
    A4_PK4(PC0, 0, pa0); A4_PK4(PC0, 8, pa1); A4_PK4(PC1, 0, pa2); A4_PK4(PC1, 8, pa3); \
    if constexpr (!KHOIST) { __builtin_amdgcn_sched_group_barrier(0x100, 2 * ND0, 0); __builtin_amdgcn_sched_group_barrier(0x002, 10, 0); } A4_SGB(2 * ND0, MSUM ? 3 : 5); ASBAR(); \
    if constexpr (!NOMAX) { if (__any(alpha < 1.f)) { if (hi == 0) al_l[r32] = alpha; asm volatile("s_waitcnt lgkmcnt(0)" ::: "memory"); \
      _Pragma("unroll") for (int r_ = 0; r_ < 16; ++r_) { const float f_ = al_l[crow(r_, hi)]; o[0][r_] *= f_; o[1][r_] *= f_; if constexpr (MSUM) osum[r_] *= f_; } } } \
  } while (0)
  A4_KLOAD(0, 0); A4_KLOAD(1, 1); A4_KWRITE(0, 0); A4_KWRITE(1, 1);
  A4_KLOAD(0, 2); A4_VLOAD(0, 0); A4_KLOAD(1, 3); A4_VLOAD(1, 1);
  if constexpr (NS == 4) { A4_KLOAD(2, 4); A4_VLOAD(2, 2); A4_KLOAD(3, 5); A4_VLOAD(3, 3); }
  __syncthreads();
  f32x16 pA0, pA1, pB0, pB1; bf16x8 pa0, pa1, pa2, pa3; float alpha = 1.f;
  pa0 = bf16x8{}; pa1 = bf16x8{}; pa2 = bf16x8{}; pa3 = bf16x8{};
  A4_QK(pA0, pA1, 0);
  A4_ITER(0, 0, pA0, pA1, pB0, pB1, 0);
  if constexpr (NS == 2) {
    for (int t = 1; t + 1 < NT; t += 2) {
      A4_ITER(t, 1, pB0, pB1, pA0, pA1, 1);
      A4_ITER(t + 1, 0, pA0, pA1, pB0, pB1, 1);
    }
    A4_ITER(NT - 1, 1, pB0, pB1, pA0, pA1, 1);
  } else {
    for (int t = 1; t + 3 < NT; t += 4) {
      A4_ITER(t, 1, pB0, pB1, pA0, pA1, 1);
      A4_ITER(t + 1, 2, pA0, pA1, pB0, pB1, 1);
      A4_ITER(t + 2, 3, pB0, pB1, pA0, pA1, 1);
      A4_ITER(t + 3, 0, pA0, pA1, pB0, pB1, 1);
    }
    A4_ITER(NT - 3, 1, pB0, pB1, pA0, pA1, 1);
    A4_ITER(NT - 2, 2, pA0, pA1, pB0, pB1, 1);
    A4_ITER(NT - 1, 3, pB0, pB1, pA0, pA1, 1);
  }
  __syncthreads();
  { s16x4 vlA_[4], vhA_[4], vlB_[4], vhB_[4]; const int vp_ = vb0 + ((NT - 1) & 1) * SHM_V;
    v_reads<0, NCG>(vlA_, vhA_, vp_); v_reads<1, NCG>(vlB_, vhB_, vp_); lgkm_wait<0>();
    A4_OSUM(); pv_mma(o[0], vlA_, vhA_, pa0, pa1, pa2, pa3); pv_mma(o[1], vlB_, vhB_, pa0, pa1, pa2, pa3); }
  if constexpr (MSUM) { if (r32 == 0) {
#pragma unroll
      for (int r = 0; r < 16; ++r) li_l[crow(r, hi)] = osum[r]; } }
  else { if (hi == 0) li_l[r32] = l_reg; }
  asm volatile("s_waitcnt lgkmcnt(0)" ::: "memory");
  float rli[16];
#pragma unroll
  for (int r = 0; r < 16; ++r) rli[r] = __builtin_amdgcn_rcpf(li_l[crow(r, hi)]);
  bf16_t* Ow = Ob + (long)(wid * 32) * LDO;
#pragma unroll
  for (int r = 0; r < 16; ++r) { const int orow = crow(r, hi);
#pragma unroll
    for (int d0 = 0; d0 < 2; ++d0) stg[orow * 64 + d0 * 32 + r32] = (bf16_t)(cvtpk(o[d0][r] * rli[r], 0.f) & 0xffffu); }
  asm volatile("s_waitcnt lgkmcnt(0)" ::: "memory");
#pragma unroll
  for (int i = 0; i < 4; ++i) { const int idx = i * 64 + lane, row = idx >> 3, ch = idx & 7;
    *reinterpret_cast<u32x4*>(Ow + (long)row * LDO + ch * 8) = *reinterpret_cast<const u32x4*>(stg + row * 64 + ch * 8); }
  __syncthreads();
#undef A4_KLOAD
#undef A4_VLOAD
#undef A4_KWRITE
#undef A4_VWRITE
#undef A4_QK
#undef A4_KREADS
#undef A4_SGB
#undef A4_PK4
#undef A4_PV
#undef A4_OSUM
#undef A4_ITER
}
template <int DQK, int DV, int LDQ, int LDK, int LDV, int LDO, bool NOMAX, int NS, bool MSUM, bool KHOIST>
__device__ __forceinline__ void attn_body5(const bf16_t* Qb, const bf16_t* __restrict__ Kh, const bf16_t* __restrict__ Vh, bf16_t* Ob, int seq, float offs, char* lds, const int wave_id) {
  using CF = Cfg<DQK, DV>;
  constexpr int KROW = CF::KROW, SHM_K = CF::SHM_K, SHM_V = CF::SHM_V, NCG = CF::NCG, KCH = CF::KCH, VCH = CF::VCH, KPT = CF::KPT, VPT = CF::VPT, ND0 = DQK / 16, NDB = DV / 32;
  static_assert(NCG == 2 && !KHOIST, "attn_body5: DV = 64");
  float lac0 = 0.f, lac1 = 0.f;
  constexpr int KAH = ND0 > 4 ? 8 : 8;
  int lane_ = pg8::lane_now(); asm volatile("" : "+v"(lane_));
  const int lane = lane_, wid = wave_id, tid = wave_id * 64 + lane, r32 = lane & 31, hi = lane >> 5;
  char* V_lds = lds; char* K_lds = lds + 2 * SHM_V;
  float* ws = (float*)(lds + 2 * SHM_V + 2 * SHM_K) + wid * 64; float* li_l = ws; float* al_l = ws + 32;
  bf16_t* stg = (bf16_t*)(lds + 2 * SHM_V + 2 * SHM_K + 8 * 64 * 4) + wid * (32 * 64);
  float m_run = 0.f, l_reg = 0.f; f32x16 o[NDB], osum, negt; bf16x8 qr[ND0];
#pragma unroll
  for (int d = 0; d < NDB; ++d) o[d] = f32x16{};
  osum = f32x16{};
#pragma unroll
  for (int r = 0; r < 16; ++r) negt[r] = -offs;
  bool anym = false;
  const short one_ = (r32 == 0) ? (short)0x3F80 : (short)0;
  const bf16x8 ones = {one_, one_, one_, one_, one_, one_, one_, one_};
  const bf16_t* Qw = Qb + (long)(wid * 32 + r32) * LDQ + hi * 8;
#pragma unroll
  for (int d0 = 0; d0 < ND0; ++d0) qr[d0] = *reinterpret_cast<const bf16x8*>(Qw + d0 * 16);
  int kgo[KPT], klo[KPT], vgo[VPT], vlo[VPT];
#pragma unroll
  for (int j = 0; j < KPT; ++j) { int p = tid + 512 * j; if (p >= 64 * KCH) p = tid; const int row = p / KCH, ch = p - row * KCH; kgo[j] = row * LDK + ch * 8; klo[j] = row * KROW + ch * 16; }
#pragma unroll
  for (int j = 0; j < VPT; ++j) { const int p = tid + 512 * j, key = p / VCH, c = (p - key * VCH) * 8; vgo[j] = key * LDV + c; vlo[j] = v_st<NCG>(key, c); }
  const int vb0 = (int)(uintptr_t)V_lds + v_rd_base(lane);
  const int ka0 = (int)(uintptr_t)K_lds + r32 * KROW + hi * 16;
  bf16x8 sk0[KPT], sv0[VPT], sk1[KPT], sv1[VPT], sk2[KPT], sv2[VPT], sk3[KPT], sv3[VPT];
  const int NT = seq / 64, TL = NT - 1;
#define A5_KLOAD(S, kx) do { const int kx_ = (kx) < TL ? (kx) : TL; _Pragma("unroll") for (int j_ = 0; j_ < KPT; ++j_) sk##S[j_] = *reinterpret_cast<const bf16x8*>(Kh + (long)kx_ * 64 * LDK + kgo[j_]); } while (0)
#define A5_VLOAD(S, vx) do { const int vx_ = (vx) < TL ? (vx) : TL; _Pragma("unroll") for (int j_ = 0; j_ < VPT; ++j_) sv##S[j_] = *reinterpret_cast<const bf16x8*>(Vh + (long)vx_ * 64 * LDV + vgo[j_]); } while (0)
#define A5_KWRITE(S, kx) do { _Pragma("unroll") for (int j_ = 0; j_ < KPT; ++j_) *reinterpret_cast<bf16x8*>(K_lds + ((kx) & 1) * SHM_K + klo[j_]) = sk##S[j_]; } while (0)
#define A5_VWRITE(S, vx) do { _Pragma("unroll") for (int j_ = 0; j_ < VPT; ++j_) *reinterpret_cast<bf16x8*>(V_lds + ((vx) & 1) * SHM_V + vlo[j_]) = sv##S[j_]; } while (0)
#define A5_KREADS(kf, x) do { const int ka_ = ka0 + ((x) & 1) * SHM_K; \
    kf[0] = lds_read128<0>(ka_); kf[1] = lds_read128<32 * KROW>(ka_); kf[2] = lds_read128<32>(ka_); kf[3] = lds_read128<32 + 32 * KROW>(ka_); \
    kf[4] = lds_read128<64>(ka_); kf[5] = lds_read128<64 + 32 * KROW>(ka_); kf[6] = lds_read128<96>(ka_); kf[7] = lds_read128<96 + 32 * KROW>(ka_); \
    if constexpr (ND0 > 4) { kf[8] = lds_read128<128>(ka_); kf[9] = lds_read128<128 + 32 * KROW>(ka_); kf[10] = lds_read128<160>(ka_); kf[11] = lds_read128<160 + 32 * KROW>(ka_); } } while (0)
#define A5_SGB(nm, nv) do { _Pragma("unroll") for (int i_ = 0; i_ < (nm); ++i_) { __builtin_amdgcn_sched_group_barrier(0x008, 1, 0); __builtin_amdgcn_sched_group_barrier(0x002, (nv), 0); } } while (0)
#define A5_PK4(P, BASE, OUT) do { unsigned a0_ = cvtpk(P[BASE + 0], P[BASE + 1]), a1_ = cvtpk(P[BASE + 2], P[BASE + 3]), b0_ = cvtpk(P[BASE + 4], P[BASE + 5]), b1_ = cvtpk(P[BASE + 6], P[BASE + 7]); \
    auto r0_ = __builtin_amdgcn_permlane32_swap(a0_, b0_, false, false); auto r1_ = __builtin_amdgcn_permlane32_swap(a1_, b1_, false, false); \
    u32x4 w_ = {r0_[0], r1_[0], r0_[1], r1_[1]}; OUT = *reinterpret_cast<bf16x8*>(&w_); } while (0)
#define A5_PV(vlA, vhA, vlB, vhB) do { pv_mma(o[0], vlA, vhA, pa0, pa1, pa2, pa3); pv_mma(o[1], vlB, vhB, pa0, pa1, pa2, pa3); \
    if constexpr (MSUM) { osum = __builtin_amdgcn_mfma_f32_32x32x16_bf16(pa0, ones, osum, 0, 0, 0); osum = __builtin_amdgcn_mfma_f32_32x32x16_bf16(pa1, ones, osum, 0, 0, 0); \
                           osum = __builtin_amdgcn_mfma_f32_32x32x16_bf16(pa2, ones, osum, 0, 0, 0); osum = __builtin_amdgcn_mfma_f32_32x32x16_bf16(pa3, ones, osum, 0, 0, 0); } } while (0)
#define A5_QK(PN0, PN1, x) do { const char* kb_ = K_lds + ((x) & 1) * SHM_K + r32 * KROW + hi * 16; \
    if constexpr (NOMAX) { PN0 = __builtin_amdgcn_mfma_f32_32x32x16_bf16(*reinterpret_cast<const bf16x8*>(kb_), qr[0], negt, 0, 0, 0); \
    PN1 = __builtin_amdgcn_mfma_f32_32x32x16_bf16(*reinterpret_cast<const bf16x8*>(kb_ + 32 * KROW), qr[0], negt, 0, 0, 0); } \
    else { PN0 = __builtin_amdgcn_mfma_f32_32x32x16_bf16(*reinterpret_cast<const bf16x8*>(kb_), qr[0], f32x16{}, 0, 0, 0); \
    PN1 = __builtin_amdgcn_mfma_f32_32x32x16_bf16(*reinterpret_cast<const bf16x8*>(kb_ + 32 * KROW), qr[0], f32x16{}, 0, 0, 0); } \
    _Pragma("unroll") for (int d0 = 1; d0 < ND0; ++d0) { \
      PN0 = __builtin_amdgcn_mfma_f32_32x32x16_bf16(*reinterpret_cast<const bf16x8*>(kb_ + d0 * 32), qr[d0], PN0, 0, 0, 0); \
      PN1 = __builtin_amdgcn_mfma_f32_32x32x16_bf16(*reinterpret_cast<const bf16x8*>(kb_ + d0 * 32 + 32 * KROW), qr[d0], PN1, 0, 0, 0); } } while (0)
#define A5_OSUM() do { if constexpr (MSUM) { osum = __builtin_amdgcn_mfma_f32_32x32x16_bf16(pa0, ones, osum, 0, 0, 0); osum = __builtin_amdgcn_mfma_f32_32x32x16_bf16(pa1, ones, osum, 0, 0, 0); \
    osum = __builtin_amdgcn_mfma_f32_32x32x16_bf16(pa2, ones, osum, 0, 0, 0); osum = __builtin_amdgcn_mfma_f32_32x32x16_bf16(pa3, ones, osum, 0, 0, 0); } } while (0)
#define A5_MF(a, b, c) __builtin_amdgcn_mfma_f32_32x32x16_bf16(a, b, c, 0, 0, 0)
#define A5_VPK(L, H) (bf16x8){L[0], L[1], L[2], L[3], H[0], H[1], H[2], H[3]}
#define A5_EX2(P, i) do { P[i] = __builtin_amdgcn_exp2f(P[i]); P[(i) + 1] = __builtin_amdgcn_exp2f(P[(i) + 1]); if constexpr (!MSUM) { lac0 += P[i]; lac1 += P[(i) + 1]; } } while (0)
#define A5_V(g, PC0, PC1) do { constexpr int k_ = (g) - (NOMAX ? 1 : 5); \
    if constexpr (k_ >= 0 && k_ < 8) A5_EX2(PC0, 2 * k_); else if constexpr (k_ >= 8 && k_ < 16) A5_EX2(PC1, 2 * (k_ - 8)); \
    else if constexpr (k_ == 16) A5_PK4(PC0, 0, pa0); else if constexpr (k_ == 17) A5_PK4(PC0, 8, pa1); else if constexpr (k_ == 18) A5_PK4(PC1, 0, pa2); else if constexpr (k_ == 19) A5_PK4(PC1, 8, pa3); } while (0)
#define A5_MAX8(P, b) fmaxf(fmaxf(fmaxf(P[b], P[b + 1]), fmaxf(P[b + 2], P[b + 3])), fmaxf(fmaxf(P[b + 4], P[b + 5]), fmaxf(P[b + 6], P[b + 7])))
#define A5_VB(i) do { constexpr int KS_ = 2 * NCG * 512; vlB_[i] = tr_read<512 + (i) * KS_>(vp_); vhB_[i] = tr_read<512 + (i) * KS_ + NCG * 512>(vp_); } while (0)
#define A5_VA(i) do { constexpr int KS_ = 2 * NCG * 512; vlA_[i] = tr_read<(i) * KS_>(vp_); vhA_[i] = tr_read<(i) * KS_ + NCG * 512>(vp_); } while (0)
#define A5_KG(g, QK_) do { constexpr int j_ = (g) - (13 - KAH); if constexpr (j_ >= 0 && j_ < 2 * ND0) { if (QK_) kf_[j_] = lds_read128<(j_ >> 1) * 32 + (j_ & 1) * 32 * KROW>(ka_); } } while (0)
#define A5_QKM(j, PN0, PN1) do { constexpr int w_ = (KAH - 1) < (2 * ND0 - 1 - (j)) ? (KAH - 1) : (2 * ND0 - 1 - (j)); lgkm_wait<w_>(); \
    if constexpr ((j) == 0) { if constexpr (NOMAX) PN0 = A5_MF(kf_[0], qr[0], negt); else PN0 = A5_MF(kf_[0], qr[0], f32x16{}); } else if constexpr ((j) == 1) { if constexpr (NOMAX) PN1 = A5_MF(kf_[1], qr[0], negt); else PN1 = A5_MF(kf_[1], qr[0], f32x16{}); } \
    else if constexpr (((j) & 1) == 0) PN0 = A5_MF(kf_[j], qr[(j) >> 1], PN0); else PN1 = A5_MF(kf_[j], qr[(j) >> 1], PN1); } while (0)
#define A5_QG(g, PC0, PC1, PN0, PN1, QK_) do { if (QK_) A5_QKM((g) - 13, PN0, PN1); A5_KG(g, QK_); A5_V(g, PC0, PC1); ASBAR(); } while (0)
#define A5_CHECK(P0, P1) do { float pmax_ = fmaxf(fmaxf(A5_MAX8(P0, 0), A5_MAX8(P0, 8)), fmaxf(A5_MAX8(P1, 0), A5_MAX8(P1, 8))); \
      { auto rr_ = __builtin_amdgcn_permlane32_swap(__float_as_uint(pmax_), __float_as_uint(pmax_), false, false); pmax_ = fmaxf(__uint_as_float(rr_[0]), __uint_as_float(rr_[1])); } \
      if (__builtin_expect(__all(pmax_ <= THR2), 1)) alpha = 1.f; \
      else { const float dl_ = fmaxf(pmax_, 0.f); m_run += dl_; alpha = __builtin_amdgcn_exp2f(-dl_); \
        _Pragma("unroll") for (int r_ = 0; r_ < 16; ++r_) { P0[r_] -= dl_; P1[r_] -= dl_; negt[r_] = -m_run; } } } while (0)
#define A5_ITER(t_, S, PC0, PC1, PN0, PN1, PV_, QK_) do { \
    __syncthreads(); \
    s16x4 vlA_[4], vhA_[4], vlB_[4], vhB_[4]; bf16x8 kf_[2 * ND0]; float pm0_ = 0.f, pm1_ = 0.f, pm2_ = 0.f, pm3_ = 0.f; \
    const int vp_ = vb0 + (((t_) - 1) & 1) * SHM_V, ka_ = ka0 + (((t_) + 1) & 1) * SHM_K; \
    if (PV_) { A5_VA(0); A5_VA(1); A5_VA(2); A5_VA(3); } \
    if constexpr (!NOMAX) { if (anym) { _Pragma("unroll") for (int r_ = 0; r_ < 16; ++r_) { PC0[r_] -= m_run; PC1[r_] -= m_run; } } } \
    A5_KWRITE(S, (t_) + 2); A5_VWRITE(S, (t_)); A5_KLOAD(S, (t_) + 2 + NS); A5_VLOAD(S, (t_) + NS); ASBAR(); \
    if (PV_) { if constexpr (MSUM) osum = A5_MF(pa0, ones, osum); A5_VB(0); } if constexpr (NOMAX) A5_V(1, PC0, PC1); else pm0_ = A5_MAX8(PC0, 0); ASBAR(); \
    if (PV_) { if constexpr (MSUM) osum = A5_MF(pa1, ones, osum); A5_VB(1); } if constexpr (NOMAX) A5_V(2, PC0, PC1); else pm1_ = A5_MAX8(PC0, 8); ASBAR(); \
    if (PV_) { if constexpr (MSUM) osum = A5_MF(pa2, ones, osum); A5_VB(2); } if constexpr (NOMAX) A5_V(3, PC0, PC1); else pm2_ = A5_MAX8(PC1, 0); ASBAR(); \
    if (PV_) { if constexpr (MSUM) osum = A5_MF(pa3, ones, osum); A5_VB(3); } if constexpr (NOMAX) A5_V(4, PC0, PC1); else pm3_ = A5_MAX8(PC1, 8); ASBAR(); \
    if constexpr (!NOMAX) { float pmax_ = fmaxf(fmaxf(pm0_, pm1_), fmaxf(pm2_, pm3_)); \
      { auto rr_ = __builtin_amdgcn_permlane32_swap(__float_as_uint(pmax_), __float_as_uint(pmax_), false, false); pmax_ = fmaxf(__uint_as_float(rr_[0]), __uint_as_float(rr_[1])); } \
      if (__builtin_expect(__all(pmax_ <= THR2), 1)) alpha = 1.f; \
      else { const float dl_ = fmaxf(pmax_, 0.f); m_run += dl_; alpha = __builtin_amdgcn_exp2f(-dl_); \
        anym = true; _Pragma("unroll") for (int r_ = 0; r_ < 16; ++r_) { PC0[r_] -= dl_; PC1[r_] -= dl_; } } ASBAR(); } \
    lgkm_wait<8>(); \
    if (PV_) o[0] = A5_MF(pa0, A5_VPK(vlA_[0], vhA_[0]), o[0]); A5_KG(5, QK_); A5_V(5, PC0, PC1); ASBAR(); \
    if (PV_) o[0] = A5_MF(pa1, A5_VPK(vlA_[1], vhA_[1]), o[0]); A5_KG(6, QK_); A5_V(6, PC0, PC1); ASBAR(); \
    if (PV_) o[0] = A5_MF(pa2, A5_VPK(vlA_[2], vhA_[2]), o[0]); A5_KG(7, QK_); A5_V(7, PC0, PC1); ASBAR(); \
    if (PV_) o[0] = A5_MF(pa3, A5_VPK(vlA_[3], vhA_[3]), o[0]); A5_KG(8, QK_); A5_V(8, PC0, PC1); ASBAR(); \
    if (QK_) lgkm_wait<(KAH > 4 ? KAH - 4 : 0)>(); else lgkm_wait<0>(); \
    if (PV_) o[1] = A5_MF(pa0, A5_VPK(vlB_[0], vhB_[0]), o[1]); A5_KG(9, QK_); A5_V(9, PC0, PC1); ASBAR(); \
    if (PV_) o[1] = A5_MF(pa1, A5_VPK(vlB_[1], vhB_[1]), o[1]); A5_KG(10, QK_); A5_V(10, PC0, PC1); ASBAR(); \
    if (PV_) o[1] = A5_MF(pa2, A5_VPK(vlB_[2], vhB_[2]), o[1]); A5_KG(11, QK_); A5_V(11, PC0, PC1); ASBAR(); \
    if (PV_) o[1] = A5_MF(pa3, A5_VPK(vlB_[3], vhB_[3]), o[1]); A5_KG(12, QK_); A5_V(12, PC0, PC1); ASBAR(); \
    A5_QG(13, PC0, PC1, PN0, PN1, QK_); A5_QG(14, PC0, PC1, PN0, PN1, QK_); A5_QG(15, PC0, PC1, PN0, PN1, QK_); A5_QG(16, PC0, PC1, PN0, PN1, QK_); \
    A5_QG(17, PC0, PC1, PN0, PN1, QK_); A5_QG(18, PC0, PC1, PN0, PN1, QK_); A5_QG(19, PC0, PC1, PN0, PN1, QK_); A5_QG(20, PC0, PC1, PN0, PN1, QK_); \
    if constexpr (ND0 > 4) { A5_QG(21, PC0, PC1, PN0, PN1, QK_); A5_QG(22, PC0, PC1, PN0, PN1, QK_); A5_QG(23, PC0, PC1, PN0, PN1, QK_); A5_QG(24, PC0, PC1, PN0, PN1, QK_); } \
    if constexpr (!NOMAX) { if (__any(alpha < 1.f)) { if (hi == 0) al_l[r32] = alpha; asm volatile("s_waitcnt lgkmcnt(0)" ::: "memory"); \
      _Pragma("unroll") for (int r_ = 0; r_ < 16; ++r_) { const float f_ = al_l[crow(r_, hi)]; o[0][r_] *= f_; o[1][r_] *= f_; if constexpr (MSUM) osum[r_] *= f_; } if constexpr (!MSUM) { lac0 *= alpha; lac1 *= alpha; } } \
      } \
  } while (0)
  A5_KLOAD(0, 0); A5_KLOAD(1, 1); A5_KWRITE(0, 0); A5_KWRITE(1, 1);
  A5_KLOAD(0, 2); A5_VLOAD(0, 0); A5_KLOAD(1, 3); A5_VLOAD(1, 1);
  if constexpr (NS == 4) { A5_KLOAD(2, 4); A5_VLOAD(2, 2); A5_KLOAD(3, 5); A5_VLOAD(3, 3); }
  __syncthreads();
  f32x16 pA0, pA1, pB0, pB1; bf16x8 pa0, pa1, pa2, pa3; float alpha = 1.f;
  pa0 = bf16x8{}; pa1 = bf16x8{}; pa2 = bf16x8{}; pa3 = bf16x8{};
  A5_QK(pA0, pA1, 0);
  A5_ITER(0, 0, pA0, pA1, pB0, pB1, 0, 1);
  if constexpr (NS == 2) {
    for (int t = 1; t + 1 < NT; t += 2) {
      A5_ITER(t, 1, pB0, pB1, pA0, pA1,  1, 1);
      A5_ITER(t + 1, 0, pA0, pA1, pB0, pB1,  1, 1);
    }
    A5_ITER(NT - 1, 1, pB0, pB1, pA0, pA1,  1, 0);
  } else {
    for (int t = 1; t + 3 < NT; t += 4) {
      A5_ITER(t, 1, pB0, pB1, pA0, pA1,  1, 1);
      A5_ITER(t + 1, 2, pA0, pA1, pB0, pB1,  1, 1);
      A5_ITER(t + 2, 3, pB0, pB1, pA0, pA1,  1, 1);
      A5_ITER(t + 3, 0, pA0, pA1, pB0, pB1,  1, 1);
    }
    A5_ITER(NT - 3, 1, pB0, pB1, pA0, pA1,  1, 1);
    A5_ITER(NT - 2, 2, pA0, pA1, pB0, pB1,  1, 1);
    A5_ITER(NT - 1, 3, pB0, pB1, pA0, pA1,  1, 0);
  }
  __syncthreads();
  { s16x4 vlA_[4], vhA_[4], vlB_[4], vhB_[4]; const int vp_ = vb0 + ((NT - 1) & 1) * SHM_V;
    A5_VA(0); A5_VA(1); A5_VA(2); A5_VA(3); A5_VB(0); A5_VB(1); A5_VB(2); A5_VB(3); lgkm_wait<0>();
    A5_OSUM(); pv_mma(o[0], vlA_, vhA_, pa0, pa1, pa2, pa3); pv_mma(o[1], vlB_, vhB_, pa0, pa1, pa2, pa3); }
  if constexpr (MSUM) { if (r32 == 0) {
#pragma unroll
      for (int r = 0; r < 16; ++r) li_l[crow(r, hi)] = osum[r]; } }
  else { l_reg = pg8::half_sum(lac0 + lac1); if (hi == 0) li_l[r32] = l_reg; }
  asm volatile("s_waitcnt lgkmcnt(0)" ::: "memory");
  float rli[16];
#pragma unroll
  for (int r = 0; r < 16; ++r) rli[r] = __builtin_amdgcn_rcpf(li_l[crow(r, hi)]);
  bf16_t* Ow = Ob + (long)(wid * 32) * LDO;
#pragma unroll
  for (int r = 0; r < 16; ++r) { const int orow = crow(r, hi);
#pragma unroll
    for (int d0 = 0; d0 < 2; ++d0) stg[orow * 64 + d0 * 32 + r32] = (bf16_t)(cvtpk(o[d0][r] * rli[r], 0.f) & 0xffffu); }
  asm volatile("s_waitcnt lgkmcnt(0)" ::: "memory");
#pragma unroll
  for (int i = 0; i < 4; ++i) { const int idx = i * 64 + lane, row = idx >> 3, ch = idx & 7;
    *reinterpret_cast<u32x4*>(Ow + (long)row * LDO + ch * 8) = *reinterpret_cast<const u32x4*>(stg + row * 64 + ch * 8); }
  __syncthreads();
#undef A5_KLOAD
#undef A5_VLOAD
#undef A5_KWRITE
#undef A5_VWRITE
#undef A5_QK
#undef A5_KREADS
#undef A5_SGB
#undef A5_PK4
#undef A5_PV
#undef A5_OSUM
#undef A5_ITER
#undef A5_MF
#undef A5_VPK
#undef A5_EX2
#undef A5_V
#undef A5_MAX8
#undef A5_CHECK
#undef A5_VB
#undef A5_VA
#undef A5_KR
#undef A5_QKM
#undef A5_KG
#undef A5_QG
}
#undef ASBAR
}

constexpr int NWAVES = 8;
constexpr int NPHASE = 11;
#ifndef MK_BARMASK
#define MK_BARMASK 0x3ff
#endif
#ifndef MK_LAUNCHES
#define MK_LAUNCHES {{0, 11, 7}}
#endif
struct LaunchSpec { int lo, hi, amask; };
constexpr LaunchSpec LAUNCHES[] = MK_LAUNCHES;
constexpr int N_LAUNCHES = (int)(sizeof(LAUNCHES) / sizeof(LaunchSpec));

constexpr size_t MiB = 1u << 20;
constexpr size_t WS_CTL = 0, CTL_ZERO_BYTES = 1 * MiB;
constexpr size_t WS_STATS0 = 1 * MiB, WS_STATS1 = WS_STATS0 + 256 * 1024, WS_ROPEA = WS_STATS1 + 256 * 1024, WS_ROPEB = WS_ROPEA + 8192;
constexpr size_t WS_SSQ = 2 * MiB, WS_TOKER = 4 * MiB, WS_RTOK = 5 * MiB, WS_RW = 10 * MiB;
constexpr size_t WS_WIN = 16 * MiB, WS_WQB = 26 * MiB, WS_WKVB = 27 * MiB, WS_WMEM = 28 * MiB, WS_WBR = 30 * MiB, WS_WOUT = 33 * MiB;
constexpr size_t WS_MEMB = 36 * MiB, WS_MKV = 40 * MiB, WS_W1 = 44 * MiB, WS_W2 = 172 * MiB;
constexpr size_t WS_H0 = 236 * MiB, WS_H1 = WS_H0;
constexpr size_t WS_QA = 300 * MiB, WS_OB = 332 * MiB, WS_QM = 364 * MiB, WS_KA = 396 * MiB, WS_VA = 404 * MiB, WS_QLAT = 412 * MiB, WS_KVLAT = 436 * MiB, WS_GATES = 452 * MiB;
constexpr size_t WS_QB = 644 * MiB, WS_KB = 692 * MiB, WS_VB = 740 * MiB, WS_MERGED = 772 * MiB;
constexpr size_t WS_XS = 300 * MiB, WS_ACT = 572 * MiB, WS_YS = WS_XS, WS_H1B = 444 * MiB, WS_MIX = 940 * MiB,     WS_END = 1004 * MiB;
#ifdef MK_INPLACE_O
constexpr size_t WS_OA = WS_QA, WS_OB2 = WS_OB, WS_OC = WS_QM;
#else
constexpr size_t WS_OA = 844 * MiB, WS_OB2 = 876 * MiB, WS_OC = 908 * MiB;
#endif
static_assert(WS_RTOK + (size_t)(NEXP * NTOK + 256) * 4 <= WS_RW && WS_RW + (size_t)(NEXP * NTOK + 256) * 4 <= WS_WIN, "routing arrays");
static_assert(WS_XS + (size_t)MAXTILES * 256 * 2048 <= WS_ACT && WS_ACT + (size_t)MAXTILES * 256 * 2048 <= WS_END, "moe slabs");
constexpr int CW_TMO = 0, CW_BAR = 4096, CW_CNT = 65536;
constexpr int RING_OFF = 0, RING_BYTES = 131072;
constexpr int LDSCTL_OFF = RING_BYTES, MISC_OFF = LDSCTL_OFF + 320;
constexpr int L_TS = LDSCTL_OFF + 512, L_CNT = LDSCTL_OFF + 704, L_TE = LDSCTL_OFF + 1024, L_HIST = LDSCTL_OFF + 4096, L_BASE = LDSCTL_OFF + 4224, L_ASGE = LDSCTL_OFF + 4608, L_ASGW = LDSCTL_OFF + 6656;
constexpr int LDS_BYTES = 147456;
static_assert(att::Cfg<128, 128>::LDS2 <= RING_BYTES && att::Cfg<96, 64>::LDS2 <= RING_BYTES, "attention LDS");

typedef GAS unsigned gu32;
#define RLX_AGENT __ATOMIC_RELAXED, __HIP_MEMORY_SCOPE_AGENT
#define LDS_WAIT() asm volatile("s_waitcnt lgkmcnt(0)" ::: "memory")
#define VM_WAIT() asm volatile("s_waitcnt vmcnt(0)" ::: "memory")

#define XB_TMO      128
#define XB_XCNT(j)  (256  + 64 * (j))
#define XB_XSUB(j)  (1280 + 64 * (j))
#define XB_XGEN(j)  (2304 + 64 * (j))
#define XB_TOP      3328
#define XB_TOPGEN   3392
#define XCD_BAR_WORDS 3456
#define XB_SPIN_CAP (1u << 18)
__device__ __forceinline__ unsigned xb_ld(unsigned* p)              { return __hip_atomic_load(p, __ATOMIC_RELAXED, __HIP_MEMORY_SCOPE_AGENT); }
__device__ __forceinline__ unsigned xb_add(unsigned* p, unsigned v) { return __hip_atomic_fetch_add(p, v, __ATOMIC_RELAXED, __HIP_MEMORY_SCOPE_AGENT); }
__device__ __forceinline__ unsigned xb_xcc_id() { return (unsigned)__builtin_amdgcn_s_getreg((3 << 11) | 20) & 0xFu; }
#define XB_SPIN(cond, bar) do { unsigned _sp = 0; while (cond) { __builtin_amdgcn_s_sleep(1); \
    if ((++_sp & 255u) == 0u) { if (xb_ld(&(bar)[XB_TMO])) break; if (_sp > XB_SPIN_CAP) { atomicAdd(&(bar)[XB_TMO], 1u); break; } } } } while (0)
struct XcdBarrier { unsigned* bar; unsigned x; volatile LAS unsigned* st; };
__device__ __forceinline__ XcdBarrier xcd_barrier_post(unsigned* bar, volatile LAS unsigned* st, const int wave_id) {
    XcdBarrier b; b.bar = bar; b.x = xb_xcc_id(); b.st = st;
    if (wave_id == 0 && pg8::lane_now() == 0) (void)xb_add(&bar[XB_XCNT(b.x)], 1u);
    return b;
}
__device__ __forceinline__ void xcd_barrier_complete(unsigned* bar, unsigned x, unsigned& nloc, unsigned& nx) {
    const unsigned G = gridDim.x * gridDim.y * gridDim.z;
    unsigned sum, cnt, mine, sp = 0u;
    for (;;) {
        sum = 0u; cnt = 0u; mine = 0u;
#pragma unroll
        for (unsigned j = 0; j < 16; ++j) { const unsigned c = xb_ld(&bar[XB_XCNT(j)]); sum += c; cnt += (c > 0u) ? 1u : 0u; mine = (j == x) ? c : mine; }
        if (sum == G) break;
        __builtin_amdgcn_s_sleep(1);
        if ((++sp & 255u) == 0u) { if (xb_ld(&bar[XB_TMO])) break; if (sp > XB_SPIN_CAP) { atomicAdd(&bar[XB_TMO], 1u); break; } }
    }
    nloc = mine > 0u ? mine : 1u; nx = cnt > 0u ? cnt : 1u;
}
__device__ __forceinline__ void xcd_barrier(const XcdBarrier& b, const int wave_id) {
    asm volatile("s_waitcnt vmcnt(0)" ::: "memory");
    __syncthreads();
    if (wave_id == 0 && pg8::lane_now() == 0) {
        unsigned* bar = b.bar;
        __builtin_amdgcn_s_waitcnt(0);
#if defined(XB_EXP_RELALL)
        __builtin_amdgcn_fence(__ATOMIC_RELEASE, "agent"); asm volatile("s_waitcnt vmcnt(0)" ::: "memory");
#endif
        unsigned nloc = b.st[0], nx = b.st[1];
        if (nloc == 0u) { xcd_barrier_complete(bar, b.x, nloc, nx); b.st[0] = nloc; b.st[1] = nx; }
        const unsigned old = xb_add(&bar[XB_XSUB(b.x)], 1u);
        const unsigned gen = old / nloc;
        if (old + 1u == (gen + 1u) * nloc) {
            __builtin_amdgcn_fence(__ATOMIC_RELEASE, "agent");
            asm volatile("s_waitcnt vmcnt(0)" ::: "memory");
            const unsigned og = xb_add(&bar[XB_TOP], 1u);
            const unsigned tg = og / nx;
            if (og + 1u == (tg + 1u) * nx) xb_add(&bar[XB_TOPGEN], 1u);
            else XB_SPIN(xb_ld(&bar[XB_TOPGEN]) == tg, bar);
            __builtin_amdgcn_fence(__ATOMIC_ACQUIRE, "agent");
            xb_add(&bar[XB_XGEN(b.x)], 1u);
            asm volatile("s_waitcnt vmcnt(0)" ::: "memory");
        } else {
            XB_SPIN(xb_ld(&bar[XB_XGEN(b.x)]) == gen, bar);
            __builtin_amdgcn_fence(__ATOMIC_ACQUIRE, "agent");
            asm volatile("s_waitcnt vmcnt(0)" ::: "memory");
        }
    }
    __syncthreads();
#if defined(XB_EXP_DELAY)
    { const unsigned long long t0 = __builtin_amdgcn_s_memrealtime(); while (__builtin_amdgcn_s_memrealtime() - t0 < 3000ull) __builtin_amdgcn_s_sleep(8); }
#endif
#if defined(XB_EXP_ACQALL)
    __builtin_amdgcn_fence(__ATOMIC_ACQUIRE, "agent"); asm volatile("s_waitcnt vmcnt(0)" ::: "memory"); __syncthreads();
#endif
}

struct Frame {
    LAS unsigned char* lds;
    volatile LAS unsigned* MISC;
    int wave, G;
};
__device__ __forceinline__ int tid_now(const Frame& F) { int l = pg8::lane_now(); asm volatile("" : "+v"(l)); return F.wave * 64 + l; }
struct Args { const float* in[27]; float* out; unsigned char* ws; int ph_lo, ph_hi, li, amask; };
#define CAS __attribute__((address_space(4)))
struct KA { const CAS char* p;
    __device__ __forceinline__ const float* in(int i) const { return *(const float* const CAS*)(p + 8 * i); }
    __device__ __forceinline__ float* out() const { return *(float* const CAS*)(p + 216); }
    __device__ __forceinline__ unsigned char* ws() const { return *(unsigned char* const CAS*)(p + 224); }
    __device__ __forceinline__ gu32* ctl() const { return (gu32*)(ws() + WS_CTL); }
};
static_assert(offsetof(Args, out) == 216 && offsetof(Args, ws) == 224 && offsetof(Args, ph_lo) == 232, "Args layout");
__device__ __forceinline__ KA kargs() { KA k; k.p = (const CAS char*)__builtin_amdgcn_kernarg_segment_ptr(); asm volatile("" : "+s"(k.p)); return k; }
template <class T> __device__ __forceinline__ T* wsp(const KA& ka, size_t off) { return (T*)(ka.ws() + off); }
__device__ __forceinline__ float wave_sum(float v) { v += pg8::swz_xor<1>(v); v += pg8::swz_xor<2>(v); v += pg8::swz_xor<4>(v); v += pg8::swz_xor<8>(v); v += pg8::swz_xor<16>(v); return pg8::half_sum(v); }
__device__ __forceinline__ float wave_max(float v) { v = fmaxf(v, pg8::swz_xor<1>(v)); v = fmaxf(v, pg8::swz_xor<2>(v)); v = fmaxf(v, pg8::swz_xor<4>(v)); v = fmaxf(v, pg8::swz_xor<8>(v)); v = fmaxf(v, pg8::swz_xor<16>(v)); return pg8::half_max(v); }
__device__ __forceinline__ f32x4 bf4_to_f32(u32x2 w) { f32x4 g; g[0] = __uint_as_float(w.x << 16); g[1] = __uint_as_float(w.x & 0xffff0000u); g[2] = __uint_as_float(w.y << 16); g[3] = __uint_as_float(w.y & 0xffff0000u); return g; }

struct MapId { __device__ __forceinline__ int operator()(int n) const { return n; } };
__device__ __forceinline__ int rot16(int d32) { const int np = (d32 >> 4) & 1, i = d32 & 15; return 8 * (i >> 2) + 4 * np + (i & 3); }
__device__ __forceinline__ int rot8(int d32) { const int a = d32 >> 4, np = (d32 >> 3) & 1, i = d32 & 7; return 16 * a + 8 * (i >> 2) + 4 * np + (i & 3); }
struct MapInProj { __device__ __forceinline__ int operator()(int n) const {
    if (n < 512) { const int h = n >> 6, d = n & 63; return 256 * (h >> 2) + 128 * (d >> 5) + 32 * (h & 3) + rot16(d & 31); }
    if (n < 768) { const int g = (n - 512) >> 6, d = n & 63; return 512 + 128 * (d >> 5) + 32 * g + rot16(d & 31); }
    if (n < 1152) { const int i = n - 768; return i < 256 ? 768 + i : 1024 + (i - 256); }
    if (n < 1408) return 1280 + (n - 1152);
    if (n < 1440) return 1024 + 128 + rot8(n - 1408);
    if (n < 1952) return 1536 + (n - 1440);
    return 2048 + (n - 1952); } };
struct MapQb { __device__ __forceinline__ int operator()(int c) const { const int h = c / 96, r = c - 96 * h;
    if (r < 64) return 256 * (h >> 2) + 64 * (h & 3) + r;
    return 512 + 128 * (h >> 2) + 32 * (h & 3) + rot8(r - 64); } };
struct MapGlu { __device__ __forceinline__ int operator()(int n) const { return n < 1024 ? 256 * (n >> 7) + (n & 127) : 256 * ((n - 1024) >> 7) + 128 + (n & 127); } };

template <class Map> __device__ __forceinline__ void transpose_item(const float* W, int K, int N, bf16_t* WT, const float* kscale, LAS float* scr, int item, int lane, Map map) {
    const int nblk = N / 32, kb = item / nblk, nb = item - kb * nblk, k0 = 64 * kb, n0 = 32 * nb;
#pragma unroll
    for (int i = 0; i < 8; ++i) { const int kk = 8 * i + (lane >> 3), nq = 4 * (lane & 7); f32x4 v = *(const f32x4*)(W + (size_t)(k0 + kk) * N + n0 + nq); if (kscale) v = v * kscale[k0 + kk];
        LAS float* d = scr + kk * 33 + nq; d[0] = v[0]; d[1] = v[1]; d[2] = v[2]; d[3] = v[3]; }
    LDS_WAIT(); asm volatile("" ::: "memory");
    const int c = lane & 7;
#pragma unroll
    for (int j = 0; j < 4; ++j) { const int n = (lane >> 3) + 8 * j; const LAS float* s = scr + (8 * c) * 33 + n;
        u32x4 o; o.x = pg8::cvt_pk_bf16(s[0 * 33], s[1 * 33]); o.y = pg8::cvt_pk_bf16(s[2 * 33], s[3 * 33]); o.z = pg8::cvt_pk_bf16(s[4 * 33], s[5 * 33]); o.w = pg8::cvt_pk_bf16(s[6 * 33], s[7 * 33]);
        *(u32x4*)(WT + (size_t)map(n0 + n) * K + k0 + 8 * c) = o; }
    LDS_WAIT(); asm volatile("" ::: "memory");
}

template <class Map> __device__ __forceinline__ void transpose_item_f8(const float* W, int K, int N, unsigned char* WT, float scale, LAS float* scr, int item, int lane, Map map) {
    const int nblk = N / 32, kb = item / nblk, nb = item - kb * nblk, k0 = 64 * kb, n0 = 32 * nb;
#pragma unroll
    for (int i = 0; i < 8; ++i) { const int kk = 8 * i + (lane >> 3), nq = 4 * (lane & 7); const f32x4 v = *(const f32x4*)(W + (size_t)(k0 + kk) * N + n0 + nq) * scale;
        LAS float* d = scr + kk * 33 + nq; d[0] = v[0]; d[1] = v[1]; d[2] = v[2]; d[3] = v[3]; }
    LDS_WAIT(); asm volatile("" ::: "memory");
#pragma unroll
    for (int h = 0; h < 2; ++h) { const int idx = lane + 64 * h, n = idx >> 2, c = idx & 3; const LAS float* s = scr + (16 * c) * 33 + n;
        u32x4 o; o.x = pk4_f8(s[0 * 33], s[1 * 33], s[2 * 33], s[3 * 33]); o.y = pk4_f8(s[4 * 33], s[5 * 33], s[6 * 33], s[7 * 33]);
        o.z = pk4_f8(s[8 * 33], s[9 * 33], s[10 * 33], s[11 * 33]); o.w = pk4_f8(s[12 * 33], s[13 * 33], s[14 * 33], s[15 * 33]);
        *(u32x4*)(WT + (size_t)map(n0 + n) * K + k0 + 16 * c) = o; }
    LDS_WAIT(); asm volatile("" ::: "memory");
}
__device__ __forceinline__ void p0_prologue(Frame& F, const KA& ka) {
    LAS float* scr = (LAS float*)(F.lds + RING_OFF + F.wave * 16384);
    const int tid = tid_now(F), lane = tid & 63;
    const int gw = blockIdx.x * NWAVES + F.wave, NGW = F.G * NWAVES;
    constexpr int I_IN = 16 * 157, I_QB = 6 * 24, I_KVB = 4 * 32, I_MEM = 16 * 32, I_BR = 8 * 32, I_OUT = 16 * 32, I_W1 = 16 * 64, I_W2 = 16 * 32;
    constexpr int NITEMS = I_IN + I_QB + I_KVB + I_MEM + 3 * I_BR + I_OUT + NEXP * I_W1 + NEXP * I_W2;
#ifdef MK_P0PROBE
    const unsigned long long p0t0_ = __builtin_amdgcn_s_memrealtime();
#endif
    for (int it = gw; it < NITEMS; it += NGW) {
        int r = it;
        if (r < NEXP * I_W1) { const int e = r / I_W1; transpose_item_f8(ka.in(21) + (size_t)e * 1024 * 2048, 1024, 2048, wsp<unsigned char>(ka, WS_W1) + (size_t)e * 2048 * 1024, F8_WSCALE, scr, r - e * I_W1, lane, MapGlu()); continue; } r -= NEXP * I_W1;
        if (r < NEXP * I_W2) { const int e = r / I_W2; transpose_item_f8(ka.in(23) + (size_t)e * 1024 * 1024, 1024, 1024, wsp<unsigned char>(ka, WS_W2) + (size_t)e * 1024 * 1024, F8_WSCALE, scr, r - e * I_W2, lane, MapId()); continue; } r -= NEXP * I_W2;
        if (r < I_IN) { transpose_item(ka.in(4), 1024, IN_PROJ_W, wsp<bf16_t>(ka, WS_WIN), nullptr, scr, r, lane, MapInProj()); continue; } r -= I_IN;
        if (r < I_QB) { transpose_item(ka.in(10), QLAT, 768, wsp<bf16_t>(ka, WS_WQB), ka.in(8), scr, r, lane, MapQb()); continue; } r -= I_QB;
        if (r < I_KVB) { transpose_item(ka.in(11), KVLAT, 1024, wsp<bf16_t>(ka, WS_WKVB), ka.in(9), scr, r, lane, MapId()); continue; } r -= I_KVB;
        if (r < I_MEM) { transpose_item(ka.in(12), 1024, 1024, wsp<bf16_t>(ka, WS_WMEM), nullptr, scr, r, lane, MapId()); continue; } r -= I_MEM;
        if (r < I_BR) { transpose_item(ka.in(13), 512, 1024, wsp<bf16_t>(ka, WS_WBR), nullptr, scr, r, lane, MapId()); continue; } r -= I_BR;
        if (r < I_BR) { transpose_item(ka.in(14), 512, 1024, wsp<bf16_t>(ka, WS_WBR) + (size_t)1024 * 512, nullptr, scr, r, lane, MapId()); continue; } r -= I_BR;
        if (r < I_BR) { transpose_item(ka.in(15), 512, 1024, wsp<bf16_t>(ka, WS_WBR) + (size_t)2 * 1024 * 512, nullptr, scr, r, lane, MapId()); continue; } r -= I_BR;
        transpose_item(ka.in(16), 1024, 1024, wsp<bf16_t>(ka, WS_WOUT), nullptr, scr, r, lane, MapId());
    }
#ifdef MK_P0PROBE
    if (MK_P0PROBE == 1 && tid == 0) F.MISC[40] = (unsigned)(__builtin_amdgcn_s_memrealtime() - p0t0_);
#endif
    { bf16_t* wp = wsp<bf16_t>(ka, WS_WIN) + (size_t)1184 * 1024; const int gt = blockIdx.x * 512 + tid, NGT = F.G * 512;
      for (int i = gt; i < 96 * 1024 / 8; i += NGT) *(u32x4*)(wp + (size_t)i * 8) = (u32x4){0u, 0u, 0u, 0u}; }
    { const int gt = blockIdx.x * 512 + tid; float* ra = wsp<float>(ka, WS_ROPEA); float* rb = wsp<float>(ka, WS_ROPEB);
      if (gt < 1024) { const int pos = gt >> 4, i = gt & 15; const float inv = __builtin_amdgcn_exp2f(-(float)i * (13.287712379549449f / 16.0f)); float rev = (float)pos * inv * 0.15915494309189535f; rev -= floorf(rev);
          ra[gt] = __builtin_amdgcn_cosf(rev); ra[1024 + gt] = __builtin_amdgcn_sinf(rev); }
      else if (gt < 1536) { const int q = gt - 1024, pos = q >> 3, i = q & 7; const float inv = __builtin_amdgcn_exp2f(-(float)i * (13.287712379549449f / 8.0f)); float rev = (float)pos * inv * 0.15915494309189535f; rev -= floorf(rev);
          rb[q] = __builtin_amdgcn_cosf(rev); rb[512 + q] = __builtin_amdgcn_sinf(rev); } }
#ifdef MK_P0PROBE
    const unsigned long long p0t1_ = __builtin_amdgcn_s_memrealtime();
#endif
    { const float* x = ka.in(0); const f32x4* gp = (const f32x4*)ka.in(2) + lane; const f32x4* bp = (const f32x4*)ka.in(3) + lane; f32x4 gv[4], bv[4];
#pragma unroll
      for (int j = 0; j < 4; ++j) { gv[j] = gp[64 * j]; bv[j] = bp[64 * j]; }
      bf16_t* H0 = wsp<bf16_t>(ka, WS_H0); float* st0 = wsp<float>(ka, WS_STATS0);
      for (int m = gw; m < NTOK; m += 4 * NGW) {
          f32x4 v[4][4];
#pragma unroll
          for (int q = 0; q < 4; ++q) { const f32x4* xr = (const f32x4*)(x + (size_t)(m + q * NGW) * DM) + lane;
#pragma unroll
              for (int j = 0; j < 4; ++j) v[q][j] = xr[64 * j]; }
#pragma unroll
          for (int q = 0; q < 4; ++q) { const int mm = m + q * NGW; float s = 0.f;
#pragma unroll
              for (int j = 0; j < 4; ++j) s += (v[q][j][0] + v[q][j][1]) + (v[q][j][2] + v[q][j][3]);
              const float mean = wave_sum(s) * (1.f / DM); float s2 = 0.f;
#pragma unroll
              for (int j = 0; j < 4; ++j) { const f32x4 d = v[q][j] - mean; s2 += ssq4(d); }
              const float rstd = 1.f / sqrtf(wave_sum(s2) * (1.f / DM) + LN_EPS);
              if (lane == 0) *(f32x2*)(st0 + (size_t)mm * 2) = (f32x2){mean, rstd};
#pragma unroll
              for (int j = 0; j < 4; ++j) *(u32x2*)(H0 + (size_t)mm * DM + 4 * lane + 256 * j) = pack4((v[q][j] - mean) * rstd * gv[j] + bv[j]); }
      } }
#ifdef MK_P0PROBE
    if (MK_P0PROBE == 2 && tid == 0) F.MISC[40] = (unsigned)(__builtin_amdgcn_s_memrealtime() - p0t1_);
#endif
    { const float* mem = ka.in(1); bf16_t* mb = wsp<bf16_t>(ka, WS_MEMB); const int gt = blockIdx.x * 512 + tid, NGT = F.G * 512;
      for (int i = gt; i < NMEM * DM / 4; i += NGT) *(u32x2*)(mb + (size_t)i * 4) = pack4(*(const f32x4*)(mem + (size_t)i * 4)); }
}

struct Pre1Raw { f32x4 xv[4]; u32x2 mw[4]; f32x2 st; };
__device__ __forceinline__ void pre1_load(const float* x, const float* st0, const bf16_t* mix, int m, int lane, Pre1Raw& r) {
    r.st = *(const f32x2*)(st0 + (size_t)m * 2);
#pragma unroll
    for (int j = 0; j < 4; ++j) { r.xv[j] = ((const f32x4*)(x + (size_t)m * DM))[lane + 64 * j]; r.mw[j] = *(const u32x2*)(mix + (size_t)m * DM + 4 * lane + 256 * j); }
}
__device__ __forceinline__ void pre1_calc(const Pre1Raw& r, const f32x4 (&g0)[4], const f32x4 (&b0)[4], f32x4 (&v)[4]) {
#pragma unroll
    for (int j = 0; j < 4; ++j) v[j] = ((r.xv[j] - r.st.x) * r.st.y * g0[j] + b0[j]) * DN_ALPHA + bf4_to_f32(r.mw[j]);
}
__device__ __forceinline__ void pre1_row(const float* x, const float* st0, const bf16_t* mix, const f32x4 (&g0)[4], const f32x4 (&b0)[4], int m, int lane, f32x4 (&v)[4]) {
    Pre1Raw r; pre1_load(x, st0, mix, m, lane, r); pre1_calc(r, g0, b0, v);
}
__device__ __forceinline__ void moe_tables(Frame& F, const KA& ka) {
    LAS int* TS = (LAS int*)(F.lds + L_TS); LAS int* CNT = (LAS int*)(F.lds + L_CNT); LAS int* TE = (LAS int*)(F.lds + L_TE);
    const int tid = tid_now(F);
    if (tid < NEXP) { int c = (int)__hip_atomic_load(ka.ctl() + CW_CNT + tid, RLX_AGENT); c = c < 0 ? 0 : (c > NTOK ? NTOK : c); CNT[tid] = c; }
    __syncthreads();
    if (tid == 0) { int s = 0; for (int e = 0; e < NEXP; ++e) { TS[e] = s; s += (CNT[e] + 255) >> 8; } TS[NEXP] = s; }
    __syncthreads();
    const int T = TS[NEXP];
    for (int t = tid; t < T; t += NWAVES * 64) { int e = 0; while (e < NEXP - 1 && TS[e + 1] <= t) ++e; TE[t] = e; }
    __syncthreads();
}

__device__ __forceinline__ float treduce32(const float (&v)[32], int lane) {
    float u[16], w[8], x[4], y[2];
#pragma unroll
    for (int i = 0; i < 16; ++i) { const auto r = __builtin_amdgcn_permlane32_swap(__float_as_uint(v[i]), __float_as_uint(v[16 + i]), false, false); u[i] = __uint_as_float(r[0]) + __uint_as_float(r[1]); }
#pragma unroll
    for (int i = 0; i < 8; ++i) { const auto r = __builtin_amdgcn_permlane16_swap(__float_as_uint(u[i]), __float_as_uint(u[8 + i]), false, false); w[i] = __uint_as_float(r[0]) + __uint_as_float(r[1]); }
    const bool b3 = (lane & 8) != 0, b2 = (lane & 4) != 0, b1 = (lane & 2) != 0;
#pragma unroll
    for (int i = 0; i < 4; ++i) { const float send = b3 ? w[i] : w[4 + i], keep = b3 ? w[4 + i] : w[i]; x[i] = keep + pg8::swz_xor<8>(send); }
#pragma unroll
    for (int i = 0; i < 2; ++i) { const float send = b2 ? x[i] : x[2 + i], keep = b2 ? x[2 + i] : x[i]; y[i] = keep + pg8::swz_xor<4>(send); }
    const float send = b1 ? y[0] : y[1], keep = b1 ? y[1] : y[0]; float z = keep + pg8::swz_xor<2>(send);
    return z + pg8::swz_xor<1>(z);
}
__device__ __forceinline__ void p6_route(Frame& F, const KA& ka) {
    constexpr int HS = 1028;
    LAS float* HT = (LAS float*)(F.lds + RING_OFF); LAS float* PART = (LAS float*)(F.lds + RING_OFF + 16 * HS * 4);
    LAS int* hist = (LAS int*)(F.lds + L_HIST); LAS int* base = (LAS int*)(F.lds + L_BASE); LAS int* asg_e = (LAS int*)(F.lds + L_ASGE); LAS float* asg_w = (LAS float*)(F.lds + L_ASGW);
    const int tid = tid_now(F), lane = tid & 63, wv = F.wave;
    const float* xin = ka.in(0); const float* st0 = wsp<float>(ka, WS_STATS0); const bf16_t* mixp = wsp<bf16_t>(ka, WS_MIX); unsigned char* H1 = wsp<unsigned char>(ka, WS_H1);   float* st1 = wsp<float>(ka, WS_STATS1);
    int* rtok = wsp<int>(ka, WS_RTOK); float* rw = wsp<float>(ka, WS_RW); int* toker = wsp<int>(ka, WS_TOKER); bf16_t* H1b = wsp<bf16_t>(ka, WS_H1B);
    const float brt = ka.in(20)[lane >> 1];
    float wB[32][2];
    { const float* wr = ka.in(19) + (size_t)(128 * wv + (lane >> 4)) * NEXP + (lane & 15);
#pragma unroll
      for (int s_ = 0; s_ < 32; ++s_) { wB[s_][0] = wr[(size_t)(4 * s_) * NEXP]; wB[s_][1] = wr[(size_t)(4 * s_) * NEXP + 16]; } }
    for (int chunk = blockIdx.x; chunk < NTOK / 128; chunk += F.G) {
        if (tid < NEXP) hist[tid] = 0;
        Pre1Raw ra, rb;
        pre1_load(xin, st0, mixp, chunk * 128 + 2 * wv, lane, ra); pre1_load(xin, st0, mixp, chunk * 128 + 2 * wv + 1, lane, rb);
        for (int grp = 0; grp < 8; ++grp) {
            const int lrow = grp * 16 + 2 * wv, m = chunk * 128 + lrow;
            f32x4 va[4], vb[4];
            { const float* g0p = ka.in(2); const float* b0p = ka.in(3); asm volatile("" : "+s"(g0p), "+s"(b0p));
              f32x4 g0[4], b0[4];
#pragma unroll
              for (int j = 0; j < 4; ++j) { g0[j] = ((const f32x4*)g0p)[lane + 64 * j]; b0[j] = ((const f32x4*)b0p)[lane + 64 * j]; }
              pre1_calc(ra, g0, b0, va); pre1_calc(rb, g0, b0, vb);
              { const int mn = grp < 7 ? m + 16 : m; pre1_load(xin, st0, mixp, mn, lane, ra); pre1_load(xin, st0, mixp, mn + 1, lane, rb); } }
            float sa = 0.f, sb = 0.f;
#pragma unroll
            for (int j = 0; j < 4; ++j) { sa += (va[j][0] + va[j][1]) + (va[j][2] + va[j][3]); sb += (vb[j][0] + vb[j][1]) + (vb[j][2] + vb[j][3]); }
            const float meana = wave_sum(sa) * (1.f / DM), meanb = wave_sum(sb) * (1.f / DM); float qa = 0.f, qb = 0.f;
#pragma unroll
            for (int j = 0; j < 4; ++j) { const f32x4 da = va[j] - meana, db = vb[j] - meanb; qa += ssq4(da); qb += ssq4(db); }
            const float rstda = 1.f / sqrtf(wave_sum(qa) * (1.f / DM) + LN_EPS), rstdb = 1.f / sqrtf(wave_sum(qb) * (1.f / DM) + LN_EPS);
            if (lane == 0) { *(f32x2*)(st1 + (size_t)m * 2) = (f32x2){meana, rstda}; *(f32x2*)(st1 + (size_t)(m + 1) * 2) = (f32x2){meanb, rstdb}; }
#pragma unroll
            for (int j = 0; j < 4; ++j) { const float* g1p = ka.in(17); const float* b1p = ka.in(18); asm volatile("" : "+s"(g1p), "+s"(b1p));
                const f32x4 gvj = ((const f32x4*)g1p)[lane + 64 * j], bvj = ((const f32x4*)b1p)[lane + 64 * j];
                va[j] = (va[j] - meana) * rstda * gvj + bvj; vb[j] = (vb[j] - meanb) * rstdb * gvj + bvj;
                *(unsigned*)(H1 + (size_t)m * DM + 4 * lane + 256 * j) = pk4_f8(va[j][0], va[j][1], va[j][2], va[j][3]);
                *(unsigned*)(H1 + (size_t)(m + 1) * DM + 4 * lane + 256 * j) = pk4_f8(vb[j][0], vb[j][1], vb[j][2], vb[j][3]);
                *(u32x2*)(H1b + (size_t)m * DM + 4 * lane + 256 * j) = pack4(va[j]); *(u32x2*)(H1b + (size_t)(m + 1) * DM + 4 * lane + 256 * j) = pack4(vb[j]);
                *(LAS f32x4*)(HT + (2 * wv) * HS + 4 * lane + 256 * j) = va[j]; *(LAS f32x4*)(HT + (2 * wv + 1) * HS + 4 * lane + 256 * j) = vb[j]; }
            __syncthreads();
            { f32x4 c0 = {0.f, 0.f, 0.f, 0.f}, c1 = {0.f, 0.f, 0.f, 0.f}; const LAS float* ap = HT + (lane & 15) * HS + 128 * wv + (lane >> 4);
#pragma unroll
              for (int s_ = 0; s_ < 32; ++s_) { const float a = ap[4 * s_]; c0 = __builtin_amdgcn_mfma_f32_16x16x4f32(a, wB[s_][0], c0, 0, 0, 0); c1 = __builtin_amdgcn_mfma_f32_16x16x4f32(a, wB[s_][1], c1, 0, 0, 0); }
              LAS float* pp = PART + (wv * 16 + 4 * (lane >> 4)) * 32 + (lane & 15);
#pragma unroll
              for (int r_ = 0; r_ < 4; ++r_) { pp[r_ * 32] = c0[r_]; pp[r_ * 32 + 16] = c1[r_]; } }
            __syncthreads();
#pragma unroll
            for (int rr = 0; rr < 2; ++rr) { float mylogit = brt;
#pragma unroll
                for (int w_ = 0; w_ < 8; ++w_) mylogit += PART[(w_ * 16 + 2 * wv + rr) * 32 + (lane >> 1)];
                float val[4]; int id[4];
#pragma unroll
                for (int k = 0; k < 4; ++k) { const float mx = wave_max(mylogit); const unsigned long long ball = __ballot(mylogit == mx); const int idx = ball ? ((int)__builtin_ctzll(ball) >> 1) : k;
                    val[k] = mx; id[k] = idx; if ((lane >> 1) == idx) mylogit = -INFINITY; }
                const float e1 = __expf(val[1] - val[0]), e2 = __expf(val[2] - val[0]), e3 = __expf(val[3] - val[0]); const float inv = 1.f / (1.f + e1 + e2 + e3);
                if (lane < 4) { const int myid = lane == 0 ? id[0] : (lane == 1 ? id[1] : (lane == 2 ? id[2] : id[3])); const float myw = (lane == 0 ? 1.f : (lane == 1 ? e1 : (lane == 2 ? e2 : e3))) * inv;
                    asg_e[(lrow + rr) * 4 + lane] = myid; asg_w[(lrow + rr) * 4 + lane] = myw; } }
        }
        __syncthreads();
        const int e = asg_e[tid] & 31; const float w = asg_w[tid];
        const int lr = __hip_atomic_fetch_add(hist + e, 1, __ATOMIC_RELAXED, __HIP_MEMORY_SCOPE_WORKGROUP);
        __syncthreads();
        if (tid < NEXP) base[tid] = (int)__hip_atomic_fetch_add(ka.ctl() + CW_CNT + tid, (unsigned)hist[tid], RLX_AGENT);
        __syncthreads();
        const int rank = base[e] + lr, m = chunk * 128 + (tid >> 2);
        if (rank >= 0 && rank < NTOK) { rtok[(size_t)e * NTOK + rank] = m; rw[(size_t)e * NTOK + rank] = w; }
        toker[(size_t)m * 4 + (tid & 3)] = (e << 16) | (rank & 0xffff);
        __syncthreads();
    }
}

__device__ __forceinline__ void p10_final(Frame& F, const KA& ka) {
    moe_tables(F, ka);
    const LAS int* TS = (const LAS int*)(F.lds + L_TS);
    const int lane = tid_now(F) & 63;
    const int gw = blockIdx.x * NWAVES + F.wave, NGW = F.G * NWAVES;
    const int* toker = wsp<int>(ka, WS_TOKER); const unsigned char* YS = wsp<unsigned char>(ka, WS_YS); const bf16_t* H1b = wsp<bf16_t>(ka, WS_H1B);
    f32x4 g2[4], b2[4];
#pragma unroll
    for (int j = 0; j < 4; ++j) { g2[j] = ((const f32x4*)ka.in(25))[lane + 64 * j]; b2[j] = ((const f32x4*)ka.in(26))[lane + 64 * j]; }
    int ern[2][4];
#pragma unroll
    for (int q = 0; q < 2; ++q)
#pragma unroll
        for (int k = 0; k < 4; ++k) ern[q][k] = toker[(size_t)(gw + q * NGW) * 4 + k];
    for (int m0 = gw; m0 < NTOK; m0 += 2 * NGW) {
        int er[2][4];
#pragma unroll
        for (int q = 0; q < 2; ++q)
#pragma unroll
            for (int k = 0; k < 4; ++k) er[q][k] = ern[q][k];
        { const int mn = m0 + 2 * NGW < NTOK ? m0 + 2 * NGW : m0;
#pragma unroll
          for (int q = 0; q < 2; ++q)
#pragma unroll
              for (int k = 0; k < 4; ++k) ern[q][k] = toker[(size_t)(mn + q * NGW) * 4 + k]; }
        f32x4 y[2][4]; unsigned yw[2][4][4];
#pragma unroll
        for (int q = 0; q < 2; ++q) { const int m = m0 + q * NGW;
#pragma unroll
            for (int j = 0; j < 4; ++j) y[q][j] = bf4_to_f32(*(const u32x2*)(H1b + (size_t)m * DM + 4 * lane + 256 * j));
#pragma unroll
            for (int k = 0; k < 4; ++k) { const int e = (er[q][k] >> 16) & 31, rank = er[q][k] & 0xffff; const size_t slot = (size_t)TS[e] * 256 + rank; const unsigned char* yr = YS + slot * DM + 4 * lane;
#pragma unroll
                for (int j = 0; j < 4; ++j) yw[q][k][j] = *(const unsigned*)(yr + 256 * j); } }
#pragma unroll
        for (int q = 0; q < 2; ++q) { const int m = m0 + q * NGW; float* orow = ka.out() + (size_t)m * DM; float s = 0.f;
#pragma unroll
            for (int j = 0; j < 4; ++j) { f32x4 f = (un4_f8(yw[q][0][j]) + un4_f8(yw[q][1][j])) + (un4_f8(yw[q][2][j]) + un4_f8(yw[q][3][j]));
                y[q][j] = y[q][j] * DN_ALPHA + f * (1.0f / F8_YSCALE); s += (y[q][j][0] + y[q][j][1]) + (y[q][j][2] + y[q][j][3]); }
            const float mean = wave_sum(s) * (1.f / DM); float s2 = 0.f;
#pragma unroll
            for (int j = 0; j < 4; ++j) { const f32x4 d = y[q][j] - mean; s2 += ssq4(d); }
            const float rstd = 1.f / sqrtf(wave_sum(s2) * (1.f / DM) + LN_EPS);
#pragma unroll
            for (int j = 0; j < 4; ++j) ((f32x4*)orow)[lane + 64 * j] = (y[q][j] - mean) * rstd * g2[j] + b2[j]; }
    }
}

__global__ void __launch_bounds__(NWAVES * 64, 2) mk_fwd(Args args) {
    extern __shared__ __attribute__((aligned(16))) unsigned char lds[];
    Frame F;
    F.lds = (LAS unsigned char*)lds;
    F.MISC = (volatile LAS unsigned*)(F.lds + MISC_OFF);
    F.wave = __builtin_amdgcn_readfirstlane((int)threadIdx.x >> 6);
    F.G = gridDim.x;
    for (int u = tid_now(F); u < (LDS_BYTES - LDSCTL_OFF) / 4; u += NWAVES * 64) ((LAS unsigned*)(F.lds + LDSCTL_OFF))[u] = 0u;
    __syncthreads();
    XcdBarrier bar; bar.bar = (unsigned*)((gu32*)(args.ws + WS_CTL) + CW_BAR) + args.li * XCD_BAR_WORDS; bar.x = 0; bar.st = nullptr;
    if constexpr (MK_BARMASK != 0) { if (args.ph_hi - args.ph_lo > 1) bar = xcd_barrier_post(bar.bar, F.MISC + 8, F.wave); }
#ifdef MK_CLKPROBE
    unsigned long long cp_c0 = __builtin_amdgcn_s_memtime(), cp_c1 = 0, cp_r0 = __builtin_amdgcn_s_memrealtime(), cp_r1 = 1;
#define GRID_BAR_K(k) do { if constexpr ((MK_BARMASK >> (k)) & 1) xcd_barrier(bar, F.wave); if ((k) + 1 == MK_CLKPROBE || (MK_CLKPROBE == 8 && (k) == 6)) { cp_c0 = __builtin_amdgcn_s_memtime(); cp_r0 = __builtin_amdgcn_s_memrealtime(); } if ((k) == MK_CLKPROBE) { cp_c1 = __builtin_amdgcn_s_memtime(); cp_r1 = __builtin_amdgcn_s_memrealtime(); } } while (0)
#elif defined(MK_TIMEPHASE)
    unsigned long long tp_start = __builtin_amdgcn_s_memrealtime(), tp_end = tp_start;
#define GRID_BAR_K(k) do { if constexpr ((MK_BARMASK >> (k)) & 1) xcd_barrier(bar, F.wave); { const unsigned long long now_ = __builtin_amdgcn_s_memrealtime(); if ((k) + 1 == MK_TIMEPHASE || (MK_TIMEPHASE == 8 && (k) == 6)) tp_start = now_; if ((k) == MK_TIMEPHASE) tp_end = now_; } } while (0)
#else
#ifdef MK_BARTWICE
#define GRID_BAR_K(k) do { if constexpr ((MK_BARMASK >> (k)) & 1) { xcd_barrier(bar, F.wave); for (int r_ = 0; r_ < MK_BARTWICE; ++r_) xcd_barrier(bar, F.wave); } } while (0)
#else
#define GRID_BAR_K(k) do { if constexpr ((MK_BARMASK >> (k)) & 1) xcd_barrier(bar, F.wave); } while (0)
#endif
#endif
    const int lo = args.ph_lo, hi = args.ph_hi;
#define IN(k) (lo <= (k) && (k) < hi)
#define BOTH(k) (IN(k) && IN((k) + 1))
    const int bx = blockIdx.x;

    if (IN(0)) { const KA ka = kargs(); p0_prologue(F, ka); if (BOTH(0)) GRID_BAR_K(0); }

    if (IN(1)) { const KA ka = kargs();
        DenseOrder S; S.init(NTOK, NPROJ, DM, F.G, bx, wsp<bf16_t>(ka, WS_H0), wsp<bf16_t>(ka, WS_WIN));
        EpiInProj E{wsp<bf16_t>(ka, WS_QA), wsp<bf16_t>(ka, WS_KA), wsp<bf16_t>(ka, WS_VA), wsp<bf16_t>(ka, WS_QLAT), wsp<bf16_t>(ka, WS_KVLAT), wsp<bf16_t>(ka, WS_KB), wsp<bf16_t>(ka, WS_QM), wsp<u32x2>(ka, WS_GATES),
                    wsp<float>(ka, WS_SSQ), ka.in(6), ka.in(7), ka.in(5), wsp<float>(ka, WS_ROPEA), wsp<float>(ka, WS_ROPEB)};
#ifdef MK_GEMMPROBE
        if (args.li > 0) pg8::gemm_phase<EpiInProj, DenseOrder, true, true, false, MK_GEMMPROBE>(F.lds + RING_OFF, DM, S, E, F.wave, (args.amask & 8) != 0); else
#endif
        pg8::gemm_phase<EpiInProj, DenseOrder, true, true>(F.lds + RING_OFF, DM, S, E, F.wave, (args.amask & 8) != 0);
        if (BOTH(1)) GRID_BAR_K(1);
    }

    if (IN(2)) { const KA ka = kargs();
        { DenseOrder S; S.init(NTOK, 768, QLAT, F.G, bx, wsp<bf16_t>(ka, WS_QLAT), wsp<bf16_t>(ka, WS_WQB));
          EpiQb E{wsp<bf16_t>(ka, WS_QB), wsp<float>(ka, WS_SSQ), wsp<float>(ka, WS_ROPEB)};
          pg8::gemm_phase<EpiQb, DenseOrder, true, true>(F.lds + RING_OFF, QLAT, S, E, F.wave, (args.amask & 8) != 0); }
        __syncthreads();
        { KvbOrder S; S.init(NTOK, 1024, KVLAT, F.G, bx, wsp<bf16_t>(ka, WS_KVLAT), wsp<bf16_t>(ka, WS_WKVB)); S.lo = (F.G == 256) ? 128 : -1000;
          EpiKVb E{wsp<bf16_t>(ka, WS_KB), wsp<bf16_t>(ka, WS_VB), wsp<float>(ka, WS_SSQ)};
          pg8::gemm_phase<EpiKVb, KvbOrder, true, true>(F.lds + RING_OFF, KVLAT, S, E, F.wave, (args.amask & 8) != 0); }
        __syncthreads();
        { DenseOrder S; S.init(NMEM, 1024, DM, F.G, (bx + 128) % F.G, wsp<bf16_t>(ka, WS_MEMB), wsp<bf16_t>(ka, WS_WMEM));
          EpiPlain E{wsp<bf16_t>(ka, WS_MKV), 1024};
          pg8::gemm_phase<EpiPlain, DenseOrder, true, true>(F.lds + RING_OFF, DM, S, E, F.wave, (args.amask & 8) != 0); }
        if (BOTH(2)) GRID_BAR_K(2);
    }

    if (IN(3)) { const KA ka = kargs();
        const int vcu = (F.G % 8 == 0) ? (bx % 8) * (F.G / 8) + bx / 8 : bx;
        char* al = (char*)lds + RING_OFF;
        const int NU = NB * 8 * 16;
        const int amask = args.amask;
        float gqa_offs; { const int l_ = tid_now(F) & 63; const float mq_ = wave_max(fabsf(ka.in(6)[l_])), mk_ = wave_max(fabsf(ka.in(7)[l_])); gqa_offs = 64.0f * 0.125f * LOG2E * mq_ * mk_; gqa_offs = __builtin_amdgcn_readfirstlane(gqa_offs); }
        if (amask & 1) for (int ui = vcu; ui < NU; ui += F.G) {
            const int b = ui >> 7, h = (ui >> 4) & 7, qb = ui & 15; const size_t row0 = (size_t)b * SEQ + qb * 256;
            bf16_t* Q = wsp<bf16_t>(ka, WS_QA) + row0 * 512 + h * 64;
            const bf16_t* K = wsp<bf16_t>(ka, WS_KA) + (size_t)b * SEQ * 128 + (h >> 2) * 64; const bf16_t* V = wsp<bf16_t>(ka, WS_VA) + (size_t)b * SEQ * 128 + (h >> 2) * 64;
            att::attn_body5<64, 64, 512, 128, 128, 512, true, 4, true, false>(Q, K, V, wsp<bf16_t>(ka, WS_OA) + row0 * 512 + h * 64, SEQ, gqa_offs, al, F.wave);
        }
        if (amask & 2) for (int ui = vcu; ui < NU; ui += F.G) {
            const int b = ui >> 7, h = (ui >> 4) & 7, qb = ui & 15; const size_t row0 = (size_t)b * SEQ + qb * 256;
            const bf16_t* Q = wsp<bf16_t>(ka, WS_QB) + row0 * 768 + h * 96;
            const bf16_t* K = wsp<bf16_t>(ka, WS_KB) + (size_t)b * SEQ * 768 + h * 96; const bf16_t* V = wsp<bf16_t>(ka, WS_VB) + (size_t)b * SEQ * 512 + h * 64;
            bf16_t* O = wsp<bf16_t>(ka, WS_OB2) + row0 * 512 + h * 64;
            att::attn_body5<96, 64, 768, 768, 512, 512, false, 2, true, false>(Q, K, V, O, SEQ, 0.f, al, F.wave);
        }
        if (amask & 4) for (int ui = vcu; ui < NB * 4 * 16; ui += F.G) {
            const int b = ui >> 6, h = (ui >> 4) & 3, qb = ui & 15; const size_t row0 = (size_t)b * SEQ + qb * 256;
            bf16_t* Q = wsp<bf16_t>(ka, WS_QM) + row0 * 512 + h * 128;
            const bf16_t* K = wsp<bf16_t>(ka, WS_MKV) + (size_t)b * MEMLEN * 1024 + h * 128; const bf16_t* V = K + 512;
            att::attn_body<128, 128, 512, 1024, 1024, 512>(Q, K, V, wsp<bf16_t>(ka, WS_OC) + row0 * 512 + h * 128, MEMLEN, 0.08838834764831845f * LOG2E, att::THR / 0.08838834764831845f, al, F.wave);
        }
        if (BOTH(3)) GRID_BAR_K(3);
    }

    if (IN(4)) { const KA ka = kargs();
        BranchOrder S; S.G = F.G; S.c = bx; S.tstep = (size_t)256 * 512 * 2; S.astride = WS_OB2 - WS_OA; S.bstride = (size_t)1024 * 512 * 2;
        static_assert(WS_OB2 - WS_OA == WS_OC - WS_OB2, "branch operands equally spaced");
        S.A = (const char*)wsp<bf16_t>(ka, WS_OA); S.B = (const char*)wsp<bf16_t>(ka, WS_WBR);
        EpiBranch E{wsp<u32x2>(ka, WS_GATES), wsp<bf16_t>(ka, WS_MERGED)};
        pg8::gemm_phase<EpiBranch, BranchOrder, true, true>(F.lds + RING_OFF, 512, S, E, F.wave, (args.amask & 8) != 0);
        if (BOTH(4)) GRID_BAR_K(4);
    }

    if (IN(5)) { const KA ka = kargs();
        DenseOrder S; S.init(NTOK, DM, DM, F.G, bx, wsp<bf16_t>(ka, WS_MERGED), wsp<bf16_t>(ka, WS_WOUT));
        EpiPlain E{wsp<bf16_t>(ka, WS_MIX), DM};
        pg8::gemm_phase<EpiPlain, DenseOrder, true, true>(F.lds + RING_OFF, DM, S, E, F.wave, (args.amask & 8) != 0);
        if (BOTH(5)) GRID_BAR_K(5);
    }

    if (IN(6)) { const KA ka = kargs(); p6_route(F, ka); if (BOTH(6)) GRID_BAR_K(6); }


    if (IN(8)) { const KA ka = kargs();
        moe_tables(F, ka);
        MoeGatherOrder S; S.G = F.G; S.c = bx; S.T = ((const LAS int*)(F.lds + L_TS))[NEXP]; S.NPN = 8; S.A = (const char*)wsp<unsigned char>(ka, WS_H1); S.B = (const char*)wsp<unsigned char>(ka, WS_W1); S.apitch = 1024u;
        S.tstep = (size_t)256 * 1024; S.tile_e = (const LAS int*)(F.lds + L_TE); S.ts = (const LAS int*)(F.lds + L_TS); S.cnt = (const LAS int*)(F.lds + L_CNT); S.rtok = wsp<int>(ka, WS_RTOK);
        EpiSwiglu E{ka.in(22), wsp<unsigned char>(ka, WS_ACT)};
        pg8::gemm_phase<EpiSwiglu, MoeGatherOrder, true, true, true>(F.lds + RING_OFF, DM / 2, S, E, F.wave, (args.amask & 8) != 0);
        if (BOTH(8)) GRID_BAR_K(8);
    }

    if (IN(9)) { const KA ka = kargs();
        moe_tables(F, ka);
        MoeOrder S; S.G = F.G; S.c = bx; S.T = ((const LAS int*)(F.lds + L_TS))[NEXP]; S.NPN = 4; S.A = (const char*)wsp<unsigned char>(ka, WS_ACT); S.B = (const char*)wsp<unsigned char>(ka, WS_W2); S.apitch = 0u;
        S.tstep = (size_t)256 * 1024; S.tile_e = (const LAS int*)(F.lds + L_TE); S.ts = (const LAS int*)(F.lds + L_TS); S.cnt = (const LAS int*)(F.lds + L_CNT); S.rtok = nullptr;
        EpiExpOut E{ka.in(24), wsp<float>(ka, WS_RW), (const LAS int*)(F.lds + L_TS), wsp<unsigned char>(ka, WS_YS)};
        pg8::gemm_phase<EpiExpOut, MoeOrder, true, true, true>(F.lds + RING_OFF, DM / 2, S, E, F.wave, (args.amask & 8) != 0);
        if (BOTH(9)) GRID_BAR_K(9);
    }

    if (IN(10)) { const KA ka = kargs(); p10_final(F, ka); }
#ifdef MK_P0PROBE
    { const unsigned long long want_ = 4ull * F.MISC[40], t0_ = __builtin_amdgcn_s_memrealtime();
      while (__builtin_amdgcn_s_memrealtime() - t0_ < want_) __builtin_amdgcn_s_sleep(16); }
#elif defined(MK_CLKPROBE)
    { const unsigned long long want_ = 2000ull * (cp_c1 - cp_c0) / (cp_r1 - cp_r0), t0_ = __builtin_amdgcn_s_memrealtime();
      while (__builtin_amdgcn_s_memrealtime() - t0_ < want_) __builtin_amdgcn_s_sleep(16); }
#elif defined(MK_TIMEPHASE)
    { if (MK_TIMEPHASE == 10) tp_end = __builtin_amdgcn_s_memrealtime();
      const unsigned long long want_ = 4ull * (tp_end - tp_start), t0_ = __builtin_amdgcn_s_memrealtime();
      while (__builtin_amdgcn_s_memrealtime() - t0_ < want_) __builtin_amdgcn_s_sleep(16); }
#endif
#undef IN
#undef BOTH
#undef GRID_BAR
}

extern "C" void kernel_launch(void* const* d_in, const int* in_sizes, int n_in, void* d_out, int out_size, void* d_ws, size_t ws_size, hipStream_t stream) {
    static int grid = 0;
    if (grid == 0) {
        if (n_in != 27 || in_sizes[0] != NTOK * DM || out_size != NTOK * DM || ws_size < WS_END) { fprintf(stderr, "kernel_launch: shape mismatch (n_in %d, in0 %d, out %d, ws %zu)\n", n_in, n_in > 0 ? in_sizes[0] : -1, out_size, ws_size); grid = -1; return; }
        int dev = 0, cus = 0, per_cu = 0;
        if (hipGetDevice(&dev) != hipSuccess || hipDeviceGetAttribute(&cus, hipDeviceAttributeMultiprocessorCount, dev) != hipSuccess) { fprintf(stderr, "kernel_launch: device query failed\n"); grid = -1; return; }
        if (hipFuncSetAttribute((const void*)mk_fwd, hipFuncAttributeMaxDynamicSharedMemorySize, LDS_BYTES) != hipSuccess) { fprintf(stderr, "kernel_launch: hipFuncSetAttribute failed\n"); grid = -1; return; }
        if (hipOccupancyMaxActiveBlocksPerMultiprocessor(&per_cu, (const void*)mk_fwd, NWAVES * 64, LDS_BYTES) != hipSuccess || per_cu < 1) fprintf(stderr, "kernel_launch: note: occupancy query reports %d\n", per_cu);
        (void)hipGetLastError();
        grid = cus - (cus % 8);
        if (grid < 8) { grid = -1; return; }
    }
    if (grid < 0) return;
    if (hipMemsetAsync((char*)d_ws + WS_CTL, 0, CTL_ZERO_BYTES, stream) != hipSuccess) { fprintf(stderr, "kernel_launch: memset failed\n"); return; }
    Args a{};
    for (int i = 0; i < 27; ++i) a.in[i] = (const float*)d_in[i];
    a.out = (float*)d_out; a.ws = (unsigned char*)d_ws;
    for (int li = 0; li < N_LAUNCHES; ++li) {
        a.ph_lo = LAUNCHES[li].lo; a.ph_hi = LAUNCHES[li].hi; a.li = li; a.amask = LAUNCHES[li].amask;
        hipLaunchKernelGGL(mk_fwd, dim3(grid), dim3(NWAVES * 64), LDS_BYTES, stream, a);
        const hipError_t le = hipPeekAtLastError();
        if (le != hipSuccess) { fprintf(stderr, "kernel_launch: launch %d failed: %s\n", li, hipGetErrorName(le)); break; }
    }
}
```

```cpp
#include <hip/hip_runtime.h>
#include <cstdio>
#include <cstdint>

namespace pg8 {
#define PG8_LAS __attribute__((address_space(3)))
typedef unsigned short bf16_t;
typedef short bf16x8 __attribute__((ext_vector_type(8)));
typedef float f32x4 __attribute__((ext_vector_type(4)));
typedef float f32x2 __attribute__((ext_vector_type(2)));
typedef unsigned u32x4 __attribute__((ext_vector_type(4)));
typedef unsigned u32x2 __attribute__((ext_vector_type(2)));
typedef int v4i32_t __attribute__((ext_vector_type(4)));
typedef int v8i32_t __attribute__((ext_vector_type(8)));
constexpr int BM = 256, BK = 64, HALF = 128, HTB = HALF * BK * 2  , STAGE_BYTES = 8 * HTB, NXCD = 8, WGM = 8;

__host__ __device__ __forceinline__ int lds_byte(int r, int c) { const int st = (r >> 4) * 2 + (c >> 5), rr = r & 15, cc = c & 31, ob = rr * 64 + cc * 2; return st * 1024 + (ob ^ (((ob >> 9) & 1) << 5)); }
__host__ __device__ __forceinline__ void stage_rc(int b, int& R, int& C) { const int st = b / 1024, sb = b % 1024, swz = sb ^ (((sb >> 9) & 1) << 5); R = (st >> 1) * 16 + swz / 64; C = (st & 1) * 32 + (swz % 64) / 2; }
__host__ __device__ __forceinline__ int perm32(int rho) { const int n = rho >> 4, i = rho & 15; return 8 * (i >> 2) + 4 * n + (i & 3); }

__device__ __forceinline__ int lane_now() { int l; asm volatile("v_mbcnt_lo_u32_b32 %0, -1, 0\n\tv_mbcnt_hi_u32_b32 %0, -1, %0" : "=v"(l)); return l; }
template <int MASK> __device__ __forceinline__ float swz_xor(float v) { return __uint_as_float((unsigned)__builtin_amdgcn_ds_swizzle((int)__float_as_uint(v), (MASK << 10) | 0x1f)); }
__device__ __forceinline__ float half_sum(float v) { const auto r = __builtin_amdgcn_permlane32_swap(__float_as_uint(v), __float_as_uint(v), false, false); return __uint_as_float(r[0]) + __uint_as_float(r[1]); }
__device__ __forceinline__ float half_max(float v) { const auto r = __builtin_amdgcn_permlane32_swap(__float_as_uint(v), __float_as_uint(v), false, false); return fmaxf(__uint_as_float(r[0]), __uint_as_float(r[1])); }
struct Unit { int pm, pn, aux; };

typedef __bf16 bf16x2_t __attribute__((ext_vector_type(2)));
__device__ __forceinline__ unsigned cvt_pk_bf16(float lo, float hi) { const f32x2 v = {lo, hi}; const bf16x2_t b = __builtin_convertvector(v, bf16x2_t); return __builtin_bit_cast(unsigned, b); }
__device__ __forceinline__ u32x2 pack4(f32x4 v) { u32x2 w; w.x = cvt_pk_bf16(v[0], v[1]); w.y = cvt_pk_bf16(v[2], v[3]); return w; }

template <class Epi, class Sched, bool ALIGN_EPI = false, bool SP2 = false, bool F8 = false, int PROBE = 0>
__device__ __forceinline__ void gemm_phase(PG8_LAS unsigned char* lds, const int Kdim, const Sched& S, const Epi& E, const int wave_id, const bool probe_skip_epi = false) {
    int l_ = lane_now(); asm volatile("" : "+v"(l_));
    const int wid = wave_id, lane = l_, tid = wave_id * 64 + lane, wr = wid >> 2, wc = wid & 3, fr = lane & 15, fq = lane >> 4;
    const int K = Kdim, nt = K / BK;
    unsigned voffA[2], voffB[2];
#pragma unroll
    for (int i = 0; i < 2; ++i) { int R, C; stage_rc(tid * 16 + i * 8192, R, C); const int Rb = Epi::PERM ? ((R & ~31) + perm32(R & 31)) : R;
        voffA[i] = (unsigned)(R * K + C) * 2u; voffB[i] = (unsigned)(Rb * K + C) * 2u; }
    const size_t kstep = (size_t)(BK * 2);
    const size_t hstep = (size_t)HALF * K * 2;
    const size_t tstep = 2 * hstep;
    const unsigned ldsw = (unsigned)wid * 1024u;
    const int aoff = lds_byte(wr * 64 + fr, fq * 8), boff = lds_byte(wc * 32 + fr, fq * 8);
#define PG8_SA(b, h) (((b) * 2 + (h)) * HTB)
#define PG8_SB(b, h) ((4 + (b) * 2 + (h)) * HTB)
#define PG8_STAGE(bufoff, gbase, voff) do { _Pragma("unroll") for (int _i = 0; _i < 2; ++_i) \
        __builtin_amdgcn_global_load_lds((const unsigned*)((const char*)(gbase) + (voff)[_i]), (PG8_LAS unsigned*)(lds + (bufoff) + ldsw + _i * 8192), 16, 0, 0); } while (0)
#define PG8_STAGEA(bufoff, gbase, h, isnext) do { if constexpr (Sched::GATHER) { const unsigned vs_[2] = {(isnext) ? voN[h][0] : voC[h][0], (isnext) ? voN[h][1] : voC[h][1]}; PG8_STAGE(bufoff, gbase, vs_); } \
        else { PG8_STAGE(bufoff, (gbase) + (h) * hstep, voffA); } } while (0)
#define PG8_LDA(dst, b, h) do { _Pragma("unroll") for (int m = 0; m < 4; ++m) { if constexpr (F8) dst##8[m] = PG8_CAT(*(const PG8_LAS bf16x8*)(lds + PG8_SA(b, h) + aoff + m * 2048), *(const PG8_LAS bf16x8*)(lds + PG8_SA(b, h) + aoff + m * 2048 + 1024)); \
        else { _Pragma("unroll") for (int k = 0; k < 2; ++k) dst[m][k] = *(const PG8_LAS bf16x8*)(lds + PG8_SA(b, h) + aoff + m * 2048 + k * 1024); } } } while (0)
#define PG8_LDB(dst, b, h) do { _Pragma("unroll") for (int n = 0; n < 2; ++n) { if constexpr (F8) dst##8[n] = PG8_CAT(*(const PG8_LAS bf16x8*)(lds + PG8_SB(b, h) + boff + n * 2048), *(const PG8_LAS bf16x8*)(lds + PG8_SB(b, h) + boff + n * 2048 + 1024)); \
        else { _Pragma("unroll") for (int k = 0; k < 2; ++k) dst[n][k] = *(const PG8_LAS bf16x8*)(lds + PG8_SB(b, h) + boff + n * 2048 + k * 1024); } } } while (0)
#define PG8_CAT(x0, x1) __builtin_shufflevector(__builtin_bit_cast(v4i32_t, x0), __builtin_bit_cast(v4i32_t, x1), 0, 1, 2, 3, 4, 5, 6, 7)
#define PG8_MMA(ai, bj, At, Bt) do { __builtin_amdgcn_s_setprio(1); \
    if constexpr (F8) { _Pragma("unroll") for (int m = 0; m < 4; ++m) _Pragma("unroll") for (int n = 0; n < 2; ++n) \
        asm volatile("v_mfma_scale_f32_16x16x128_f8f6f4 %0, %1, %2, %0, %3, %3 op_sel_hi:[0,0,0]" : "+v"(acc[ai][bj][m][n]) : "v"(Bt##8[n]), "v"(At##8[m]), "v"(f8_scale)); } \
    else { _Pragma("unroll") for (int m = 0; m < 4; ++m) _Pragma("unroll") for (int n = 0; n < 2; ++n) _Pragma("unroll") for (int k = 0; k < 2; ++k) \
        acc[ai][bj][m][n] = __builtin_amdgcn_mfma_f32_16x16x32_bf16(Bt[n][k], At[m][k], acc[ai][bj][m][n], 0, 0, 0); } \
    __builtin_amdgcn_s_setprio(0); } while (0)
#define PG8_PLDB(d, b, h) do { if constexpr (!(PROBE & 4)) PG8_LDB(d, b, h); } while (0)
#define PG8_PLDA(d, b, h) do { if constexpr (!(PROBE & 4)) PG8_LDA(d, b, h); } while (0)
#define PG8_PSTAGE(bo, g, v) do { if constexpr (!(PROBE & 24)) PG8_STAGE(bo, g, v); } while (0)
#define PG8_PSTAGEA(bo, g, h, n) do { if constexpr (!(PROBE & 8)) PG8_STAGEA(bo, g, h, n); } while (0)
#define PG8_PWAIT_V8() do { if constexpr (PROBE & 16) PG8_WAIT_V(4); else if constexpr (!(PROBE & 8)) PG8_WAIT_V(8); } while (0)
#define PG8_PMMA0(At, B0, B1) do { if constexpr (!(PROBE & 2)) { PG8_MMA(0, 0, At, B0); PG8_MMA(0, 1, At, B1); } } while (0)
#define PG8_PMMA1(At, B0, B1) do { if constexpr (!(PROBE & 3)) { PG8_MMA(1, 0, At, B0); PG8_MMA(1, 1, At, B1); } } while (0)
#define PG8_WAIT_V(n) asm volatile("s_waitcnt vmcnt(" #n ")" ::: "memory")
#define PG8_WAIT_L(n) asm volatile("s_waitcnt lgkmcnt(" #n ")" ::: "memory")
#define PG8_BAR __builtin_amdgcn_s_barrier()
#define PG8_SCHED __builtin_amdgcn_sched_barrier(0)
    Unit cur, nxt; int ui = 0;
    if (!S.next(0, cur)) return;
    unsigned voC[2][2], voN[2][2];
    if constexpr (Sched::GATHER) {
#pragma unroll
        for (int h = 0; h < 2; ++h)
#pragma unroll
            for (int i = 0; i < 2; ++i) { int R, C; stage_rc(tid * 16 + i * 8192, R, C); voC[h][i] = S.a_off(cur, h * HALF + R, C); voN[h][i] = voC[h][i]; }
    }
    f32x4 acc[2][2][4][2];
#pragma unroll
    for (int a = 0; a < 2; ++a)
#pragma unroll
        for (int b = 0; b < 2; ++b)
#pragma unroll
            for (int m = 0; m < 4; ++m)
#pragma unroll
                for (int n = 0; n < 2; ++n) acc[a][b][m][n] = (f32x4){0.f, 0.f, 0.f, 0.f};
    int f8_scale = 0x7F7F7F7F; asm volatile("" : "+v"(f8_scale));
    bf16x8 At[4][2], B0[2][2], B1[2][2]; v8i32_t At8[4], B08[2], B18[2];
    const char* cA = S.a_ptr(cur); const char* cB = S.b_ptr(cur);
    S.a_ready(cur);
    if constexpr (SP2) {
        PG8_STAGE(PG8_SB(0, 0), cB, voffB); PG8_STAGE(PG8_SB(0, 1), cB + hstep, voffB); PG8_STAGEA(PG8_SA(0, 0), cA, 0, false); PG8_STAGEA(PG8_SA(0, 1), cA, 1, false);
        if (wr == 1) PG8_BAR;
        PG8_WAIT_V(2); PG8_BAR;
        PG8_STAGE(PG8_SB(1, 0), cB + kstep, voffB); PG8_STAGEA(PG8_SA(1, 0), cA + kstep, 0, false); PG8_STAGE(PG8_SB(1, 1), cB + hstep + kstep, voffB);
        PG8_WAIT_V(6); PG8_BAR;
    } else {
        PG8_STAGE(PG8_SB(0, 0), cB, voffB); PG8_STAGEA(PG8_SA(0, 0), cA, 0, false); PG8_STAGE(PG8_SB(0, 1), cB + hstep, voffB); PG8_STAGEA(PG8_SA(0, 1), cA, 1, false);
        if (wr == 1) PG8_BAR;
        PG8_WAIT_V(4); PG8_BAR;
        PG8_STAGE(PG8_SB(1, 0), cB + kstep, voffB); PG8_STAGEA(PG8_SA(1, 0), cA + kstep, 0, false); PG8_STAGE(PG8_SB(1, 1), cB + hstep + kstep, voffB);
        PG8_WAIT_V(6); PG8_BAR;
    }
    for (;;) {
        const bool has_next = S.next(ui + 1, nxt);
        const char* nA = has_next ? S.a_ptr(nxt) : cA; const char* nB = has_next ? S.b_ptr(nxt) : cB;
        if constexpr (Sched::GATHER) { if (has_next) {
#pragma unroll
            for (int h = 0; h < 2; ++h)
#pragma unroll
                for (int i = 0; i < 2; ++i) { int R, C; stage_rc(tid * 16 + i * 8192, R, C); voN[h][i] = S.a_off(nxt, h * HALF + R, C); } } }
#pragma nounroll
        for (int t = 0; t < nt; t += 2) {
            const bool last = (t == nt - 2);
            const char* a1 = cA + (size_t)(t + 1) * kstep;
            const char* a2 = last ? nA : cA + (size_t)(t + 2) * kstep; const char* b2 = last ? nB : cB + (size_t)(t + 2) * kstep;
            const char* a3 = a2 + kstep; const char* b3 = b2 + kstep;
            if (last && has_next) S.a_ready(nxt);
            if constexpr (SP2) {
            PG8_PLDB(B0, 0, 0); PG8_PLDB(B1, 0, 1); PG8_SCHED; PG8_PLDA(At, 0, 0); PG8_PSTAGEA(PG8_SA(1, 1), a1, 1, false);
            PG8_PWAIT_V8(); PG8_WAIT_L(0); PG8_BAR; PG8_PMMA0(At, B0, B1); PG8_BAR; PG8_SCHED;
            PG8_PLDA(At, 0, 1); PG8_PSTAGE(PG8_SB(0, 0), b2, voffB); PG8_PSTAGE(PG8_SB(0, 1), b2 + hstep, voffB); PG8_PSTAGEA(PG8_SA(0, 0), a2, 0, last);
            PG8_PWAIT_V8(); PG8_WAIT_L(0); PG8_BAR; PG8_PMMA1(At, B0, B1); PG8_BAR; PG8_SCHED;
            PG8_PLDB(B0, 1, 0); PG8_PLDB(B1, 1, 1); PG8_SCHED; PG8_PLDA(At, 1, 0); PG8_PSTAGEA(PG8_SA(0, 1), a2, 1, last);
            PG8_PWAIT_V8(); PG8_WAIT_L(0); PG8_BAR; PG8_PMMA0(At, B0, B1); PG8_BAR; PG8_SCHED;
            PG8_PLDA(At, 1, 1); PG8_PSTAGE(PG8_SB(1, 0), b3, voffB); PG8_PSTAGE(PG8_SB(1, 1), b3 + hstep, voffB); PG8_PSTAGEA(PG8_SA(1, 0), a3, 0, last);
            PG8_PWAIT_V8(); PG8_WAIT_L(0); PG8_BAR; PG8_PMMA1(At, B0, B1); PG8_BAR; PG8_SCHED;
            } else {
            PG8_LDB(B0, 0, 0); PG8_SCHED; PG8_LDA(At, 0, 0); PG8_STAGEA(PG8_SA(1, 1), a1, 1, false);
            PG8_WAIT_L(8); PG8_BAR; PG8_WAIT_L(0); PG8_MMA(0, 0, At, B0); PG8_BAR; PG8_SCHED;
            PG8_LDB(B1, 0, 1); PG8_STAGE(PG8_SB(0, 0), b2, voffB);
            PG8_BAR; PG8_WAIT_L(0); PG8_MMA(0, 1, At, B1); PG8_BAR;
            PG8_LDA(At, 0, 1); PG8_STAGEA(PG8_SA(0, 0), a2, 0, last);
            PG8_BAR; PG8_WAIT_L(0); PG8_MMA(1, 0, At, B0); PG8_BAR; PG8_SCHED;
            PG8_STAGE(PG8_SB(0, 1), b2 + hstep, voffB);
            PG8_WAIT_V(6); PG8_BAR; PG8_MMA(1, 1, At, B1); PG8_BAR;
            PG8_LDB(B0, 1, 0); PG8_SCHED; PG8_LDA(At, 1, 0); PG8_STAGEA(PG8_SA(0, 1), a2, 1, last);
            PG8_WAIT_L(8); PG8_BAR; PG8_WAIT_L(0); PG8_MMA(0, 0, At, B0); PG8_BAR; PG8_SCHED;
            PG8_LDB(B1, 1, 1); PG8_STAGE(PG8_SB(1, 0), b3, voffB);
            PG8_BAR; PG8_WAIT_L(0); PG8_MMA(0, 1, At, B1); PG8_BAR;
            PG8_LDA(At, 1, 1); PG8_STAGEA(PG8_SA(1, 0), a3, 0, last);
            PG8_BAR; PG8_WAIT_L(0); PG8_MMA(1, 0, At, B0); PG8_BAR; PG8_SCHED;
            PG8_STAGE(PG8_SB(1, 1), b3 + hstep, voffB);
            PG8_WAIT_V(6); PG8_BAR; PG8_MMA(1, 1, At, B1); PG8_BAR;
            }
        }
        if constexpr (ALIGN_EPI) { if (wr == 0) PG8_BAR; }
        if constexpr (F8) asm volatile("s_nop 15\n\ts_nop 7" ::: "memory");
        if constexpr (!Epi::AFTER_DRAIN) if (!probe_skip_epi) { int t2_ = lane_now(); asm volatile("" : "+v"(t2_)); const int fr_ = t2_ & 15, fq_ = (t2_ >> 4) & 3; E(acc, cur, wr, wc, fr_, fq_); S.done(cur); }
        if (!has_next) break;
        bool keep_acc_ = false; if constexpr (Epi::KEEPS) keep_acc_ = E.keep(cur);
        if (!keep_acc_) {
#pragma unroll
        for (int a = 0; a < 2; ++a)
#pragma unroll
            for (int b = 0; b < 2; ++b)
#pragma unroll
                for (int m = 0; m < 4; ++m)
#pragma unroll
                    for (int n = 0; n < 2; ++n) acc[a][b][m][n] = (f32x4){0.f, 0.f, 0.f, 0.f};
        }
        cur = nxt; cA = nA; cB = nB; ++ui;
        if constexpr (Sched::GATHER) {
#pragma unroll
            for (int h = 0; h < 2; ++h)
#pragma unroll
                for (int i = 0; i < 2; ++i) voC[h][i] = voN[h][i]; }
        if constexpr (ALIGN_EPI) { if (wr == 1) PG8_BAR; }
    }
    PG8_WAIT_V(0);
    if constexpr (!ALIGN_EPI) { if (wr == 0) PG8_BAR; }
    PG8_BAR;
    if constexpr (Epi::AFTER_DRAIN) { E.fused(acc, cur, wr, wc, fr, fq, lds, wid, lane); S.done(cur); }
#undef PG8_SA
#undef PG8_SB
#undef PG8_STAGE
#undef PG8_STAGEA
#undef PG8_LDA
#undef PG8_LDB
#undef PG8_MMA
#undef PG8_PMMA0
#undef PG8_PLDB
#undef PG8_PLDA
#undef PG8_PSTAGE
#undef PG8_PSTAGEA
#undef PG8_PWAIT_V8
#undef PG8_PMMA1
#undef PG8_CAT
#undef PG8_WAIT_V
#undef PG8_WAIT_L
#undef PG8_BAR
#undef PG8_SCHED
}
}

constexpr int NB = 8, SEQ = 4096, DM = 1024, NTOK = NB * SEQ;
constexpr int MEMLEN = 256, NMEM = NB * MEMLEN;
constexpr int IN_PROJ_W = 5024, NPROJ = 5120;
constexpr int QLAT = 384, KVLAT = 256;
constexpr int NEXP = 32, TOPK = 4, DEXP = 1024;
constexpr int MAXTILES = 544;
constexpr float LN_EPS = 1e-5f, RMS_EPS = 1e-6f;
constexpr float DN_ALPHA = 1.189207115002721f;
constexpr float LOG2E = 1.4426950408889634f;

typedef pg8::bf16_t bf16_t;
typedef pg8::f32x4 f32x4;
typedef pg8::f32x2 f32x2;
typedef pg8::u32x2 u32x2;
typedef pg8::u32x4 u32x4;
using pg8::pack4;
using pg8::Unit;
#define LAS __attribute__((address_space(3)))
#define GAS __attribute__((address_space(1)))

__device__ __forceinline__ void tile_of(int L, int nM, int nN, int& pm, int& pn) {
    const int nwg = nM * nN; int wgid = L;
    { const int q = nwg / pg8::NXCD, r = nwg % pg8::NXCD, xcd = wgid % pg8::NXCD, off = wgid / pg8::NXCD; wgid = (xcd < r ? xcd * (q + 1) : r * (q + 1) + (xcd - r) * q) + off; }
    const int nig = pg8::WGM * nN, gid = wgid / nig, fm = gid * pg8::WGM, gsz = (nM - fm) < pg8::WGM ? (nM - fm) : pg8::WGM;
    pm = fm + ((wgid % nig) % gsz); pn = (wgid % nig) / gsz;
}
struct DenseOrder {
    static constexpr bool GATHER = false;
    int nM, nN, nwg, G, c; const char* A; const char* B; size_t tstep;
    __device__ __forceinline__ void init(int M, int N, int K, int G_, int c_, const void* A_, const void* B_) { nM = M / 256; nN = N / 256; nwg = nM * nN; G = G_; c = c_; A = (const char*)A_; B = (const char*)B_; tstep = (size_t)256 * K * 2; }
    __device__ __forceinline__ bool next(int i, Unit& u) const { const long L = (long)i * G + c; if (L >= nwg) return false; tile_of((int)L, nM, nN, u.pm, u.pn); u.aux = 0; return true; }
    __device__ __forceinline__ const char* a_ptr(const Unit& u) const { return A + (size_t)u.pm * tstep; }
    __device__ __forceinline__ const char* b_ptr(const Unit& u) const { return B + (size_t)u.pn * tstep; }
    __device__ __forceinline__ void a_ready(const Unit&) const {}
    __device__ __forceinline__ void done(const Unit&) const {}
};
struct KvbOrder {
    static constexpr bool GATHER = false, ATILE = false;
    int nM, nN, L0, L1, L2; const char* A; const char* B; size_t tstep;
    __device__ __forceinline__ bool next(int i, Unit& u) const { const int L = i == 0 ? L0 : (i == 1 ? L1 : (i == 2 ? L2 : -1)); if (L < 0) return false; tile_of(L, nM, nN, u.pm, u.pn); u.aux = 0; return true; }
    __device__ __forceinline__ const char* a_ptr(const Unit& u) const { return A + (size_t)u.pm * tstep; }
    __device__ __forceinline__ const char* b_ptr(const Unit& u) const { return B + (size_t)u.pn * tstep; }
    __device__ __forceinline__ void a_ready(const Unit&) const {}
    __device__ __forceinline__ void done(const Unit&) const {}
};
struct QbOrder : DenseOrder {
    int lo;
    __device__ __forceinline__ bool next(int i, Unit& u) const {
        const int d = c - lo; long L;
        if (d >= 0 && d < 32) return false;
        if (d >= 64 && d < 96) { if (i > 1) return false; L = i == 0 ? (long)c : (long)(lo + (d - 64)); }
        else L = (long)i * G + c;
        if (L >= nwg) return false; tile_of((int)L, nM, nN, u.pm, u.pn); u.aux = 0; return true; }
};
struct BranchOrder {
    static constexpr bool GATHER = false;
    int G, c; const char *A, *B; size_t tstep, astride, bstride;
    __device__ __forceinline__ bool next(int i, Unit& u) const { const int ti = i / 3, br = i - 3 * ti; const long L = (long)ti * G + c; if (L >= 128 * 4) return false; tile_of((int)L, 128, 4, u.pm, u.pn); u.aux = br; return true; }
    __device__ __forceinline__ const char* a_ptr(const Unit& u) const { return A + (size_t)u.aux * astride + (size_t)u.pm * tstep; }
    __device__ __forceinline__ const char* b_ptr(const Unit& u) const { return B + (size_t)u.aux * bstride + (size_t)u.pn * tstep; }
    __device__ __forceinline__ void a_ready(const Unit&) const {}
    __device__ __forceinline__ void done(const Unit&) const {}
};
template <bool GATHER_> struct MoeOrderT {
    static constexpr bool GATHER = GATHER_;
    int G, c, T, NPN; const char* A; const char* B; size_t tstep; const LAS int* tile_e; const LAS int* ts; const LAS int* cnt; const int* rtok; unsigned apitch;
    __device__ __forceinline__ bool next(int i, Unit& u) const {
        const int L = i * G + c, x = L & 7, y = L >> 3, tp = y / NPN, pn = y - tp * NPN, t = 8 * tp + x;
        if (t >= T) return false;
        u.pm = t; u.pn = pn; u.aux = __builtin_amdgcn_readfirstlane(tile_e[t]); return true;
    }
    __device__ __forceinline__ const char* a_ptr(const Unit& u) const { return GATHER ? A : A + (size_t)u.pm * tstep; }
    __device__ __forceinline__ const char* b_ptr(const Unit& u) const { return B + (size_t)(u.aux * NPN + u.pn) * tstep; }
    __device__ __forceinline__ unsigned a_off(const Unit& u, int r, int c) const {
        const int e = u.aux, rank = (u.pm - __builtin_amdgcn_readfirstlane(ts[e])) * 256 + r; int tok = 0;
        if (rank < __builtin_amdgcn_readfirstlane(cnt[e])) tok = rtok[(unsigned)(e * NTOK + rank)];
        tok = (tok < 0 || tok >= NTOK) ? 0 : tok;
        return (unsigned)tok * apitch + (unsigned)c * 2u;
    }
    __device__ __forceinline__ void a_ready(const Unit&) const {}
    __device__ __forceinline__ void done(const Unit&) const {}
};
typedef MoeOrderT<false> MoeOrder;
typedef MoeOrderT<true> MoeGatherOrder;

typedef const pg8::f32x4 (&AccRef)[2][2][4][2];
__device__ __forceinline__ float fast_sigmoid(float x) { return __builtin_amdgcn_rcpf(1.f + __builtin_amdgcn_exp2f(-x * LOG2E)); }
__device__ __forceinline__ f32x4 sigmoid4(f32x4 v) { f32x4 r; r[0] = fast_sigmoid(v[0]); r[1] = fast_sigmoid(v[1]); r[2] = fast_sigmoid(v[2]); r[3] = fast_sigmoid(v[3]); return r; }
__device__ __forceinline__ float sconst(float v) { return v; }
__device__ __forceinline__ u32x4 pair16(u32x2 a, u32x2 b) { const auto rx = __builtin_amdgcn_permlane16_swap(a.x, b.x, false, false), ry = __builtin_amdgcn_permlane16_swap(a.y, b.y, false, false); return (u32x4){rx[0], ry[0], rx[1], ry[1]}; }
__device__ __forceinline__ f32x4 pick4(bool first, f32x4 x, f32x4 y) { const unsigned m = first ? 0xffffffffu : 0u; f32x4 r;
#pragma unroll
    for (int j = 0; j < 4; ++j) r[j] = __uint_as_float((__float_as_uint(x[j]) & m) | (__float_as_uint(y[j]) & ~m)); return r; }
__device__ __forceinline__ float ssq4(f32x4 v) { return (v[0] * v[0] + v[1] * v[1]) + (v[2] * v[2] + v[3] * v[3]); }
__device__ __forceinline__ float quad_sum(float s) { const auto r = __builtin_amdgcn_permlane16_swap(__float_as_uint(s), __float_as_uint(s), false, false); return pg8::half_sum(__uint_as_float(r[0]) + __uint_as_float(r[1])); }
constexpr long SSQ_TO_CTL = -(2L << 20); constexpr int CW_QMX_ = 80000, CW_KMX_ = 80512, CW_KRX_ = 81024;
__device__ __forceinline__ float wave_max(float v);
__device__ __forceinline__ void publish_max(float lane_max, GAS unsigned* slot, int lane) { const float t = wave_max(quad_sum(lane_max)); if (lane == 0) (void)__hip_atomic_fetch_max(slot, __float_as_uint(t), __ATOMIC_RELAXED, __HIP_MEMORY_SCOPE_AGENT); }

__device__ __forceinline__ u32x4 pack8(f32x4 a, f32x4 b) { u32x4 w; w.x = pg8::cvt_pk_bf16(a[0], a[1]); w.y = pg8::cvt_pk_bf16(a[2], a[3]); w.z = pg8::cvt_pk_bf16(b[0], b[1]); w.w = pg8::cvt_pk_bf16(b[2], b[3]); return w; }
__device__ __forceinline__ void unpack8(u32x4 w, f32x4& a, f32x4& b) { a[0] = __uint_as_float(w.x << 16); a[1] = __uint_as_float(w.x & 0xffff0000u); a[2] = __uint_as_float(w.y << 16); a[3] = __uint_as_float(w.y & 0xffff0000u);
    b[0] = __uint_as_float(w.z << 16); b[1] = __uint_as_float(w.z & 0xffff0000u); b[2] = __uint_as_float(w.w << 16); b[3] = __uint_as_float(w.w & 0xffff0000u); }
__device__ __forceinline__ unsigned pk4_u8(f32x4 g) { unsigned w = 0; w = __builtin_amdgcn_cvt_pk_u8_f32(fmaxf(g[0] * 255.0f, 1.0f), 0, w); w = __builtin_amdgcn_cvt_pk_u8_f32(fmaxf(g[1] * 255.0f, 1.0f), 1, w);
    w = __builtin_amdgcn_cvt_pk_u8_f32(fmaxf(g[2] * 255.0f, 1.0f), 2, w); w = __builtin_amdgcn_cvt_pk_u8_f32(fmaxf(g[3] * 255.0f, 1.0f), 3, w); return w; }
__device__ __forceinline__ f32x4 un4_u8(unsigned w) { f32x4 g; g[0] = (float)(w & 0xffu); g[1] = (float)((w >> 8) & 0xffu); g[2] = (float)((w >> 16) & 0xffu); g[3] = (float)(w >> 24); return g; }
__device__ __forceinline__ f32x4 gate255(f32x4 x, f32x4 bp) { f32x4 r;
#pragma unroll
    for (int jp = 0; jp < 4; jp += 2) { const f32x2 xx = {x[jp], x[jp + 1]}, bb = {bp[jp], bp[jp + 1]}; const f32x2 a = xx * (f32x2){-LOG2E, -LOG2E} + bb;
        const f32x2 e = (f32x2){__builtin_amdgcn_exp2f(a[0]), __builtin_amdgcn_exp2f(a[1])} + (f32x2){1.0f / 255.0f, 1.0f / 255.0f};
        r[jp] = __builtin_amdgcn_rcpf(e[0]); r[jp + 1] = __builtin_amdgcn_rcpf(e[1]); }
    return r; }
__device__ __forceinline__ unsigned pk4_u8s(f32x4 g) { unsigned w = 0; w = __builtin_amdgcn_cvt_pk_u8_f32(g[0], 0, w); w = __builtin_amdgcn_cvt_pk_u8_f32(g[1], 1, w);
    w = __builtin_amdgcn_cvt_pk_u8_f32(g[2], 2, w); w = __builtin_amdgcn_cvt_pk_u8_f32(g[3], 3, w); return w; }
__device__ __forceinline__ f32x4 max1(f32x4 v) { return (f32x4){fmaxf(v[0], 1.0f), fmaxf(v[1], 1.0f), fmaxf(v[2], 1.0f), fmaxf(v[3], 1.0f)}; }
__device__ __forceinline__ unsigned gate_rec(int pm, int br, int pn, int wave, int ai, int bj, int m, int lane) { return ((((unsigned)(pm * 3 + br) * 4 + pn) * 8 + wave) * 16 + (ai * 8 + bj * 4 + m)) * 64 + lane; }

__device__ __forceinline__ unsigned pk4_f8(float a, float b, float c, float d) { int w = 0; w = __builtin_amdgcn_cvt_pk_fp8_f32(a, b, w, false); w = __builtin_amdgcn_cvt_pk_fp8_f32(c, d, w, true); return (unsigned)w; }
constexpr float F8_WSCALE = 32.0f, F8_ASCALE = 4.0f, F8_YSCALE = 16.0f;
__device__ __forceinline__ f32x4 un4_f8(unsigned w) { const f32x2 a = __builtin_amdgcn_cvt_pk_f32_fp8((int)w, false), b = __builtin_amdgcn_cvt_pk_f32_fp8((int)w, true); return (f32x4){a[0], a[1], b[0], b[1]}; }

struct EpiInProj {
    static constexpr bool PERM = true, AFTER_DRAIN = false, KEEPS = false;
    bf16_t *Qa, *Ka, *Va, *Qlat, *KVlat, *Kb, *Qm; u32x2* Gates; float* ssq;
    const float *qn, *kn, *bgate, *ropeA, *ropeB;
    __device__ __forceinline__ void operator()(AccRef acc, const Unit& u, int wr, int wc, int fr, int fq) const {
        const int pn = u.pn, rowb = u.pm * 256 + wr * 64 + fr;
        if (pn <= 2) {
            if (pn == 2 && wc >= 2) {
#pragma unroll
                for (int ai = 0; ai < 2; ++ai)
#pragma unroll
                    for (int mp = 0; mp < 4; mp += 2) { const int row = rowb + ai * 128 + (mp + (fq & 1)) * 16; bf16_t* d = Va + (unsigned)row * 128 + (wc - 2) * 64 + 4 * (fq & 2);
#pragma unroll
                        for (int bj = 0; bj < 2; ++bj)
#pragma unroll
                            for (int n = 0; n < 2; ++n) *(u32x4*)(d + 32 * bj + 16 * n) = pair16(pack4(acc[ai][bj][mp][n]), pack4(acc[ai][bj][mp + 1][n])); }
            } else {
                const float* gain = pn < 2 ? qn : kn; const int pitch = pn < 2 ? 512 : 128;
                bf16_t* dst = pn < 2 ? Qa + (4 * pn + wc) * 64 : Ka + wc * 64;
                f32x4 g[2][2];
#pragma unroll
                for (int bj = 0; bj < 2; ++bj)
#pragma unroll
                    for (int n = 0; n < 2; ++n) g[bj][n] = *(const f32x4*)(gain + 32 * bj + 16 * n + 4 * fq);
                f32x4 cR[2], sR[2], cC[4], sC[4];
#pragma unroll
                for (int ai = 0; ai < 2; ++ai) { const int rp = ((rowb + ai * 128) & (SEQ - 1)) >> 6; cR[ai] = *(const f32x4*)(ropeA + rp * 16 + 4 * fq); sR[ai] = *(const f32x4*)(ropeA + 1024 + rp * 16 + 4 * fq); }
#pragma unroll
                for (int m = 0; m < 4; ++m) { const int cp = (rowb + m * 16) & 63; cC[m] = *(const f32x4*)(ropeA + cp * 16 + 4 * fq); sC[m] = *(const f32x4*)(ropeA + 1024 + cp * 16 + 4 * fq); }
#pragma unroll
                for (int ai = 0; ai < 2; ++ai)
#pragma unroll
                    for (int mp = 0; mp < 4; mp += 2) { u32x2 pc[2][2][2];
#pragma unroll
                        for (int q = 0; q < 2; ++q) { const int m = mp + q;
                            float ss = (ssq4(acc[ai][0][m][0]) + ssq4(acc[ai][0][m][1])) + (ssq4(acc[ai][1][m][0]) + ssq4(acc[ai][1][m][1]));
                            ss = quad_sum(ss);
                            const float rinv = __builtin_amdgcn_rsqf(ss * (1.0f / 64.0f) + sconst(RMS_EPS)) * (pn < 2 ? 0.125f * LOG2E : 1.0f);
#pragma unroll
                            for (int bj = 0; bj < 2; ++bj) { const f32x4 c4 = bj ? cC[m] : cR[ai], s4 = bj ? sC[m] : sR[ai];
                                const f32x4 x1 = acc[ai][bj][m][0] * rinv * g[bj][0], x2 = acc[ai][bj][m][1] * rinv * g[bj][1];
                                pc[q][bj][0] = pack4(x1 * c4 - x2 * s4); pc[q][bj][1] = pack4(x2 * c4 + x1 * s4); } }
                        bf16_t* d = dst + (unsigned)(rowb + ai * 128 + (mp + (fq & 1)) * 16) * pitch + 4 * (fq & 2);
#pragma unroll
                        for (int bj = 0; bj < 2; ++bj) { *(u32x4*)(d + 32 * bj) = pair16(pc[0][bj][0], pc[1][bj][0]); *(u32x4*)(d + 32 * bj + 16) = pair16(pc[0][bj][1], pc[1][bj][1]); }
                    }
            }
        } else if (pn == 3 || pn == 5) {
            bf16_t* dst = pn == 3 ? Qlat : KVlat; const int pitch = pn == 3 ? QLAT : KVLAT, slot = (pn == 3 ? 0 : 8) + wc;
#pragma unroll
            for (int ai = 0; ai < 2; ++ai)
#pragma unroll
                for (int m = 0; m < 4; ++m) { const int row = rowb + ai * 128 + m * 16; bf16_t* d = dst + (unsigned)row * pitch + 32 * wc + 8 * fq;
                    float ss = (ssq4(acc[ai][0][m][0]) + ssq4(acc[ai][0][m][1])) + (ssq4(acc[ai][1][m][0]) + ssq4(acc[ai][1][m][1]));
                    ss = quad_sum(ss); if (fq == 0) ssq[(unsigned)row * 12 + slot] = ss;
#pragma unroll
                    for (int bj = 0; bj < 2; ++bj) *(u32x4*)(d + 128 * bj) = pack8(acc[ai][bj][m][0], acc[ai][bj][m][1]); }
        } else if (pn == 4) {
            const int a_ = fq >> 1, i0_ = 4 * (fq & 1); f32x4 ec[4], es[4]; float krmx = 0.f;
            if (wc == 0) {
#pragma unroll
                for (int k = 0; k < 4; ++k) { const int pos = a_ ? ((rowb + k * 16) & 63) : (((rowb + (k & 1) * 128) & (SEQ - 1)) >> 6);
                    ec[k] = *(const f32x4*)(ropeB + pos * 8 + i0_); es[k] = *(const f32x4*)(ropeB + 512 + pos * 8 + i0_); } }
#pragma unroll
            for (int ai = 0; ai < 2; ++ai) { u32x2 o1[4], o2[4];
#pragma unroll
                for (int m = 0; m < 4; ++m) { const int row = rowb + ai * 128 + m * 16;
                    float ss = ssq4(acc[ai][0][m][0]) + ssq4(acc[ai][0][m][1]);
                    ss = quad_sum(ss); if (fq == 0) ssq[(unsigned)row * 12 + 4 + wc] = ss;
                    *(u32x4*)(Qlat + (unsigned)row * QLAT + 256 + 32 * wc + 8 * fq) = pack8(acc[ai][0][m][0], acc[ai][0][m][1]);
                    if (wc == 0) { const f32x4 c4 = pick4(a_ != 0, ec[m], ec[ai]), s4 = pick4(a_ != 0, es[m], es[ai]);
                        const f32x4 x1 = acc[ai][1][m][0], x2 = acc[ai][1][m][1]; krmx = fmaxf(krmx, ssq4(x1) + ssq4(x2));
                        o1[m] = pack4(x1 * c4 - x2 * s4); o2[m] = pack4(x2 * c4 + x1 * s4); } }
                if (wc == 0) {
#pragma unroll
                    for (int mp = 0; mp < 4; mp += 2) { const u32x4 w1 = pair16(o1[mp], o1[mp + 1]), w2 = pair16(o2[mp], o2[mp + 1]);
                        bf16_t* kd = Kb + (unsigned)(rowb + ai * 128 + (mp + (fq & 1)) * 16) * 768 + 64 + 16 * a_;
#pragma unroll
                        for (int h = 0; h < 8; ++h) { *(u32x4*)(kd + h * 96) = w1; *(u32x4*)(kd + h * 96 + 8) = w2; } } }
            }
            { GAS unsigned* krx = (GAS unsigned*)((const GAS char*)ssq + SSQ_TO_CTL) + CW_KRX_; publish_max(krmx, krx + (wc == 0 ? (u.pm >> 4) : 8 + wc), fq * 16 + fr); }
        } else if (pn <= 7) {
#pragma unroll
            for (int ai = 0; ai < 2; ++ai)
#pragma unroll
                for (int m = 0; m < 4; ++m) { const int row = rowb + ai * 128 + m * 16; bf16_t* d = Qm + (unsigned)row * 512 + (pn - 6) * 256 + 32 * wc + 8 * fq;
#pragma unroll
                    for (int bj = 0; bj < 2; ++bj) *(u32x4*)(d + 128 * bj) = pack8(acc[ai][bj][m][0], acc[ai][bj][m][1]); }
        } else {
            const int br = (pn - 8) >> 2, pt = (pn - 8) & 3, col0 = (pn - 8) * 256 + 32 * wc + 8 * fq, lane = fq * 16 + fr, wave = wr * 4 + wc; f32x4 bv[2][2];
#pragma unroll
            for (int bj = 0; bj < 2; ++bj)
#pragma unroll
                for (int n = 0; n < 2; ++n) bv[bj][n] = *(const f32x4*)(bgate + col0 + 128 * bj + 4 * n) * (-LOG2E) - 7.994353436858858f;
#pragma unroll
            for (int ai = 0; ai < 2; ++ai)
#pragma unroll
                for (int m = 0; m < 4; ++m)
#pragma unroll
                    for (int bj = 0; bj < 2; ++bj)
                        { u32x2 w; w.x = pk4_u8s(gate255(acc[ai][bj][m][0], bv[bj][0])); w.y = pk4_u8s(gate255(acc[ai][bj][m][1], bv[bj][1])); Gates[gate_rec(u.pm, br, pt, wave, ai, bj, m, lane)] = w; }
        }
    }
};
struct EpiQb {
    static constexpr bool PERM = true, AFTER_DRAIN = false, KEEPS = false;
    bf16_t* Qb; const float* ssq; const float* ropeB;
    __device__ __forceinline__ void operator()(AccRef acc, const Unit& u, int wr, int wc, int fr, int fq) const {
        const int pn = u.pn, rowb = u.pm * 256 + wr * 64 + fr; const float eps = sconst(RMS_EPS), invn = sconst(1.0f / (float)QLAT); float lm0 = 0.f, lm1 = 0.f;
        float rinv[2][4];
#pragma unroll
        for (int ai = 0; ai < 2; ++ai) { f32x4 s0[4], s1[4];
#pragma unroll
            for (int m = 0; m < 4; ++m) { const int row = rowb + ai * 128 + m * 16; s0[m] = *(const f32x4*)(ssq + (unsigned)row * 12); s1[m] = *(const f32x4*)(ssq + (unsigned)row * 12 + 4); }
#pragma unroll
            for (int m = 0; m < 4; ++m) { const float tot = ((s0[m][0] + s0[m][1]) + (s0[m][2] + s0[m][3])) + ((s1[m][0] + s1[m][1]) + (s1[m][2] + s1[m][3]));
                rinv[ai][m] = __builtin_amdgcn_rsqf(tot * invn + eps) * (0.10206207261596575f * LOG2E); } }
        if (pn < 2) {
#pragma unroll
            for (int ai = 0; ai < 2; ++ai)
#pragma unroll
                for (int m = 0; m < 4; ++m) { const int row = rowb + ai * 128 + m * 16; const float ri = rinv[ai][m];
#pragma unroll
                    for (int bj = 0; bj < 2; ++bj) { const int c = 128 * bj + 32 * wc + 8 * fq, head = 4 * pn + (c >> 6), d = c & 63; const f32x4 y0 = acc[ai][bj][m][0] * ri, y1 = acc[ai][bj][m][1] * ri;
                        *(u32x4*)(Qb + (unsigned)row * 768 + head * 96 + d) = pack8(y0, y1); { const float t_ = ssq4(y0) + ssq4(y1); if (bj == 0) lm0 = fmaxf(lm0, t_); else lm1 = fmaxf(lm1, t_); } } }
            { GAS unsigned* qmx = (GAS unsigned*)((const GAS char*)ssq + SSQ_TO_CTL) + CW_QMX_; const int bq = u.pm >> 4;
              publish_max(lm0, qmx + ((bq * 8 + 4 * pn + (wc >> 1)) * 4 + (wc & 1)), fq * 16 + fr); publish_max(lm1, qmx + ((bq * 8 + 4 * pn + 2 + (wc >> 1)) * 4 + (wc & 1)), fq * 16 + fr); }
        } else { const int a = fq >> 1, i0 = 4 * (fq & 1); f32x4 ec[4], es[4];
#pragma unroll
            for (int k = 0; k < 4; ++k) { const int pos = a ? ((rowb + k * 16) & 63) : (((rowb + (k & 1) * 128) & (SEQ - 1)) >> 6);
                ec[k] = *(const f32x4*)(ropeB + pos * 8 + i0); es[k] = *(const f32x4*)(ropeB + 512 + pos * 8 + i0); }
#pragma unroll
            for (int ai = 0; ai < 2; ++ai)
#pragma unroll
                for (int mp = 0; mp < 4; mp += 2) { u32x2 pc[2][2][2];
#pragma unroll
                    for (int q = 0; q < 2; ++q) { const int m = mp + q; const float ri = rinv[ai][m];
                        const f32x4 c4 = pick4(a != 0, ec[m], ec[ai]), s4 = pick4(a != 0, es[m], es[ai]);
#pragma unroll
                        for (int bj = 0; bj < 2; ++bj) { const f32x4 x1 = acc[ai][bj][m][0] * ri, x2 = acc[ai][bj][m][1] * ri; { const float t_ = ssq4(x1) + ssq4(x2); if (bj == 0) lm0 = fmaxf(lm0, t_); else lm1 = fmaxf(lm1, t_); }
                            pc[q][bj][0] = pack4(x1 * c4 - x2 * s4); pc[q][bj][1] = pack4(x2 * c4 + x1 * s4); } }
                    bf16_t* qd = Qb + (unsigned)(rowb + ai * 128 + (mp + (fq & 1)) * 16) * 768 + wc * 96 + 64 + 16 * a;
#pragma unroll
                    for (int bj = 0; bj < 2; ++bj) { *(u32x4*)(qd + 4 * bj * 96) = pair16(pc[0][bj][0], pc[1][bj][0]); *(u32x4*)(qd + 4 * bj * 96 + 8) = pair16(pc[0][bj][1], pc[1][bj][1]); } }
            { GAS unsigned* qmx = (GAS unsigned*)((const GAS char*)ssq + SSQ_TO_CTL) + CW_QMX_; const int bq = u.pm >> 4;
              publish_max(lm0, qmx + ((bq * 8 + wc) * 4 + 2), fq * 16 + fr); publish_max(lm1, qmx + ((bq * 8 + 4 + wc) * 4 + 2), fq * 16 + fr); }
        }
    }
};
struct EpiKVb {
    static constexpr bool PERM = true, AFTER_DRAIN = false, KEEPS = false;
    bf16_t *Kb, *Vb; const float* ssq;
    __device__ __forceinline__ void operator()(AccRef acc, const Unit& u, int wr, int wc, int fr, int fq) const {
        const int pn = u.pn, rowb = u.pm * 256 + wr * 64 + fr;
        float lm0 = 0.f, lm1 = 0.f;
        f32x4 s0[2][4];
#pragma unroll
        for (int ai = 0; ai < 2; ++ai)
#pragma unroll
            for (int m = 0; m < 4; ++m) s0[ai][m] = *(const f32x4*)(ssq + (unsigned)(rowb + ai * 128 + m * 16) * 12 + 8);
#pragma unroll
        for (int ai = 0; ai < 2; ++ai)
#pragma unroll
            for (int m = 0; m < 4; ++m) { const int row = rowb + ai * 128 + m * 16;
                const float rinv = __builtin_amdgcn_rsqf(((s0[ai][m][0] + s0[ai][m][1]) + (s0[ai][m][2] + s0[ai][m][3])) * sconst(1.0f / (float)KVLAT) + sconst(RMS_EPS));
#pragma unroll
                for (int bj = 0; bj < 2; ++bj) { const int h = 2 * pn + bj, dd = 32 * wc + 8 * fq; const f32x4 y0 = acc[ai][bj][m][0] * rinv, y1 = acc[ai][bj][m][1] * rinv;
                    bf16_t* d = (wc < 2) ? Kb + (unsigned)row * 768 + h * 96 + dd : Vb + (unsigned)row * 512 + h * 64 + (dd - 64);
                    *(u32x4*)d = pack8(y0, y1); { const float t_ = ssq4(y0) + ssq4(y1); if (bj == 0) lm0 = fmaxf(lm0, t_); else lm1 = fmaxf(lm1, t_); } }
            }
        { const int b = u.pm >> 4, pc = wc < 2 ? wc : 3; GAS unsigned* kmx = (GAS unsigned*)((const GAS char*)ssq + SSQ_TO_CTL) + CW_KMX_;
          publish_max(lm0, kmx + ((b * 8 + 2 * pn) * 4 + pc), fq * 16 + fr); publish_max(lm1, kmx + ((b * 8 + 2 * pn + 1) * 4 + pc), fq * 16 + fr); }
    }
};
struct EpiPlain {
    static constexpr bool PERM = true, AFTER_DRAIN = false, KEEPS = false;
    bf16_t* O; int ldc;
    __device__ __forceinline__ void operator()(AccRef acc, const Unit& u, int wr, int wc, int fr, int fq) const {
        const int rowb = u.pm * 256 + wr * 64 + fr, col0 = u.pn * 256 + 32 * wc + 8 * fq;
#pragma unroll
        for (int ai = 0; ai < 2; ++ai)
#pragma unroll
            for (int m = 0; m < 4; ++m) { bf16_t* d = O + (unsigned)(rowb + ai * 128 + m * 16) * (unsigned)ldc + col0;
#pragma unroll
                for (int bj = 0; bj < 2; ++bj) *(u32x4*)(d + 128 * bj) = pack8(acc[ai][bj][m][0], acc[ai][bj][m][1]); }
    }
};
struct EpiBranch {
    static constexpr bool PERM = true, AFTER_DRAIN = false, KEEPS = true;
    const u32x2* Gates; bf16_t* Merged;
    __device__ __forceinline__ bool keep(const Unit& u) const { return u.aux < 2; }
    __device__ __forceinline__ void operator()(pg8::f32x4 (&acc)[2][2][4][2], const Unit& u, int wr, int wc, int fr, int fq) const {
        const int br = u.aux, rowb = u.pm * 256 + wr * 64 + fr, col0 = u.pn * 256 + 32 * wc + 8 * fq, lane = fq * 16 + fr, wave = wr * 4 + wc;
        if (br < 2) {
#pragma unroll
            for (int ai = 0; ai < 2; ++ai) { u32x2 ga[4][2], gb[4][2];
#pragma unroll
                for (int m = 0; m < 4; ++m)
#pragma unroll
                    for (int bj = 0; bj < 2; ++bj) { ga[m][bj] = Gates[gate_rec(u.pm, br, u.pn, wave, ai, bj, m, lane)]; gb[m][bj] = Gates[gate_rec(u.pm, br + 1, u.pn, wave, ai, bj, m, lane)]; }
#pragma unroll
                for (int m = 0; m < 4; ++m)
#pragma unroll
                    for (int bj = 0; bj < 2; ++bj) { const f32x4 a0 = un4_u8(ga[m][bj].x), a1 = un4_u8(ga[m][bj].y), b0 = max1(un4_u8(gb[m][bj].x)), b1 = max1(un4_u8(gb[m][bj].y));
#pragma unroll
                        for (int j = 0; j < 4; ++j) { acc[ai][bj][m][0][j] *= a0[j] * __builtin_amdgcn_rcpf(b0[j]); acc[ai][bj][m][1][j] *= a1[j] * __builtin_amdgcn_rcpf(b1[j]); } } }
        } else {
#pragma unroll
            for (int ai = 0; ai < 2; ++ai) { u32x2 gw[4][2];
#pragma unroll
                for (int m = 0; m < 4; ++m)
#pragma unroll
                    for (int bj = 0; bj < 2; ++bj) gw[m][bj] = Gates[gate_rec(u.pm, 2, u.pn, wave, ai, bj, m, lane)];
#pragma unroll
                for (int m = 0; m < 4; ++m) { const int row = rowb + ai * 128 + m * 16;
#pragma unroll
                    for (int bj = 0; bj < 2; ++bj) { const f32x4 g0 = un4_u8(gw[m][bj].x) * (1.0f / 255.0f), g1 = un4_u8(gw[m][bj].y) * (1.0f / 255.0f);
                        *(u32x4*)(Merged + (unsigned)row * 1024 + col0 + 128 * bj) = pack8(acc[ai][bj][m][0] * g0, acc[ai][bj][m][1] * g1); } } }
        }
    }
};
struct EpiOutProj {
    static constexpr bool PERM = true, AFTER_DRAIN = false, KEEPS = false;
    const float* x; const float* stats0; const float* g; const float* b; float* pre;
    __device__ __forceinline__ void operator()(AccRef acc, const Unit& u, int wr, int wc, int fr, int fq) const {
        const int rowb = u.pm * 256 + wr * 64 + fr, col0 = u.pn * 256 + 32 * wc + 8 * fq; f32x4 gv[2][2], bv[2][2];
#pragma unroll
        for (int bj = 0; bj < 2; ++bj)
#pragma unroll
            for (int n = 0; n < 2; ++n) { gv[bj][n] = *(const f32x4*)(g + col0 + 128 * bj + 4 * n); bv[bj][n] = *(const f32x4*)(b + col0 + 128 * bj + 4 * n); }
#pragma unroll
        for (int ai = 0; ai < 2; ++ai)
#pragma unroll
            for (int m = 0; m < 4; ++m) { const int row = rowb + ai * 128 + m * 16; const f32x2 st = *(const f32x2*)(stats0 + (unsigned)row * 2);
#pragma unroll
                for (int bj = 0; bj < 2; ++bj)
#pragma unroll
                    for (int n = 0; n < 2; ++n) { const unsigned off = (unsigned)row * 1024 + col0 + 128 * bj + 4 * n;
                        const f32x4 xv = *(const f32x4*)(x + off); const f32x4 h0 = (xv - st.x) * st.y * gv[bj][n] + bv[bj][n];
                        *(f32x4*)(pre + off) = h0 * DN_ALPHA + acc[ai][bj][m][n]; }
            }
    }
};
struct EpiSwiglu {
    static constexpr bool PERM = true, AFTER_DRAIN = false, KEEPS = false;
    const float* bin; unsigned char* Act;
    __device__ __forceinline__ void operator()(AccRef acc, const Unit& u, int wr, int wc, int fr, int fq) const {
        const int e = u.aux, rowb = u.pm * 256 + wr * 64 + fr, col0 = u.pn * 128 + 32 * wc + 8 * fq; f32x4 bg[2], bl[2];
#pragma unroll
        for (int n = 0; n < 2; ++n) { bg[n] = *(const f32x4*)(bin + (size_t)e * 2048 + col0 + 4 * n); bl[n] = *(const f32x4*)(bin + (size_t)e * 2048 + 1024 + col0 + 4 * n); }
#pragma unroll
        for (int ai = 0; ai < 2; ++ai) { u32x2 w[4];
#pragma unroll
            for (int m = 0; m < 4; ++m) { f32x4 o[2];
#pragma unroll
                for (int n = 0; n < 2; ++n) { const f32x4 hg = acc[ai][0][m][n] * (1.0f / F8_WSCALE) + bg[n], hl = acc[ai][1][m][n] * (1.0f / F8_WSCALE) + bl[n];
#pragma unroll
                    for (int jp = 0; jp < 4; jp += 2) { const f32x2 xg = {fminf(hg[jp], 7.0f), fminf(hg[jp + 1], 7.0f)}, xl = {fminf(fmaxf(hl[jp], -7.0f), 7.0f), fminf(fmaxf(hl[jp + 1], -7.0f), 7.0f)};
                        const f32x2 num = xg * (xl * F8_ASCALE + F8_ASCALE), ea = xg * (-1.702f * LOG2E);
                        const f32x2 den = (f32x2){__builtin_amdgcn_exp2f(ea[0]), __builtin_amdgcn_exp2f(ea[1])} + 1.0f;
                        const f32x2 r = num * (f32x2){__builtin_amdgcn_rcpf(den[0]), __builtin_amdgcn_rcpf(den[1])};
                        o[n][jp] = r[0]; o[n][jp + 1] = r[1]; } }
                w[m].x = pk4_f8(o[0][0], o[0][1], o[0][2], o[0][3]); w[m].y = pk4_f8(o[1][0], o[1][1], o[1][2], o[1][3]); }
#pragma unroll
            for (int mp = 0; mp < 4; mp += 2) {
                const auto rx = __builtin_amdgcn_permlane16_swap(w[mp].x, w[mp + 1].x, false, false), ry = __builtin_amdgcn_permlane16_swap(w[mp].y, w[mp + 1].y, false, false);
                const u32x4 o4 = {rx[0], ry[0], rx[1], ry[1]}; const int row = rowb + ai * 128 + (mp + (fq & 1)) * 16;
                *(u32x4*)(Act + (unsigned)row * 1024 + u.pn * 128 + 32 * wc + 8 * (fq & 2)) = o4; }
        }
    }
};
struct EpiExpOut {
    static constexpr bool PERM = true, AFTER_DRAIN = false, KEEPS = false;
    const float* bout; const float* rank_w; const LAS int* tstart; unsigned char* Ys;
    __device__ __forceinline__ void operator()(AccRef acc, const Unit& u, int wr, int wc, int fr, int fq) const {
        const int e = u.aux, rl = wr * 64 + fr, rowb = u.pm * 256 + rl, col0 = u.pn * 256 + 64 * wc + 16 * fq; f32x4 bv[2][2];
        const int rank0 = (u.pm - __builtin_amdgcn_readfirstlane(tstart[e])) * 256 + rl;
#pragma unroll
        for (int bj = 0; bj < 2; ++bj)
#pragma unroll
            for (int n = 0; n < 2; ++n) bv[bj][n] = *(const f32x4*)(bout + (size_t)e * 1024 + col0 + 8 * bj + 4 * n);
        float wv[2][4];
#pragma unroll
        for (int ai = 0; ai < 2; ++ai)
#pragma unroll
            for (int m = 0; m < 4; ++m) wv[ai][m] = rank_w[(size_t)e * NTOK + rank0 + ai * 128 + m * 16];
#pragma unroll
        for (int ai = 0; ai < 2; ++ai)
#pragma unroll
            for (int m = 0; m < 4; ++m) { const int row = rowb + ai * 128 + m * 16; const float w = wv[ai][m] * F8_YSCALE; u32x4 o;
#pragma unroll
                for (int bj = 0; bj < 2; ++bj) { const f32x4 y0 = (acc[ai][bj][m][0] * (1.0f / (F8_WSCALE * F8_ASCALE)) + bv[bj][0]) * w, y1 = (acc[ai][bj][m][1] * (1.0f / (F8_WSCALE * F8_ASCALE)) + bv[bj][1]) * w;
                    o[2 * bj] = pk4_f8(y0[0], y0[1], y0[2], y0[3]); o[2 * bj + 1] = pk4_f8(y1[0], y1[1], y1[2], y1[3]); }
                *(u32x4*)(Ys + (unsigned)row * 1024 + col0) = o; }
    }
};

namespace att {
using bf16x8 = __attribute__((ext_vector_type(8))) short;
using s16x4  = __attribute__((ext_vector_type(4))) short;
using f32x16 = __attribute__((ext_vector_type(16))) float;
#define ASBAR() __builtin_amdgcn_sched_barrier(0)
__device__ __forceinline__ int crow(int r, int hi) { return (r & 3) + 8 * (r >> 2) + 4 * hi; }
__device__ __forceinline__ unsigned cvtpk(float lo, float hi) { return pg8::cvt_pk_bf16(lo, hi); }
constexpr float THR = 8.f;
__device__ __forceinline__ void partialSM(f32x16& p0, f32x16& p1, float& m_reg, float& mn, float& alpha, float C, float thr_raw) {
  float pmax = p0[0];
#pragma unroll
  for (int r = 1; r < 16; ++r) pmax = fmaxf(pmax, p0[r]);
#pragma unroll
  for (int r = 0; r < 16; ++r) pmax = fmaxf(pmax, p1[r]);
  { auto rr = __builtin_amdgcn_permlane32_swap(__float_as_uint(pmax), __float_as_uint(pmax), false, false);
    pmax = fmaxf(__uint_as_float(rr[0]), __uint_as_float(rr[1])); }
  if (__builtin_expect(__all(pmax - m_reg <= thr_raw), 1)) { mn = m_reg; alpha = 1.f; }
  else { mn = fmaxf(m_reg, pmax); alpha = __builtin_amdgcn_exp2f((m_reg - mn) * C); m_reg = mn; }
  const float mnC = -mn * C;
#pragma unroll
  for (int r = 0; r < 16; ++r) p0[r] = fmaf(p0[r], C, mnC);
#pragma unroll
  for (int r = 0; r < 16; ++r) p1[r] = fmaf(p1[r], C, mnC);
#pragma unroll
  for (int r = 0; r < 16; ++r) p0[r] = __builtin_amdgcn_exp2f(p0[r]);
}
__device__ __forceinline__ void finishSM(f32x16& p0, f32x16& p1, float alpha, float& l_reg, bf16x8& pa0, bf16x8& pa1, bf16x8& pa2, bf16x8& pa3) {
#pragma unroll
  for (int r = 0; r < 16; ++r) p1[r] = __builtin_amdgcn_exp2f(p1[r]);
  float ps = 0;
#pragma unroll
  for (int r = 0; r < 16; ++r) ps += p0[r];
#pragma unroll
  for (int r = 0; r < 16; ++r) ps += p1[r];
  { auto rr = __builtin_amdgcn_permlane32_swap(__float_as_uint(ps), __float_as_uint(ps), false, false);
    ps = __uint_as_float(rr[0]) + __uint_as_float(rr[1]); }
  l_reg = l_reg * alpha + ps;
#define ATT_PK4(P, BASE, OUT) do { unsigned a0 = cvtpk(P[BASE + 0], P[BASE + 1]), a1 = cvtpk(P[BASE + 2], P[BASE + 3]);   \
    unsigned b0 = cvtpk(P[BASE + 4], P[BASE + 5]), b1 = cvtpk(P[BASE + 6], P[BASE + 7]);                              \
    auto r0 = __builtin_amdgcn_permlane32_swap(a0, b0, false, false); auto r1 = __builtin_amdgcn_permlane32_swap(a1, b1, false, false); \
    u32x4 w = {r0[0], r1[0], r0[1], r1[1]}; OUT = *reinterpret_cast<bf16x8*>(&w); } while (0)
  ATT_PK4(p0, 0, pa0); ATT_PK4(p0, 8, pa1); ATT_PK4(p1, 0, pa2); ATT_PK4(p1, 8, pa3);
#undef ATT_PK4
}
template <int DQK> __device__ __forceinline__ void qkt(f32x16& p0, f32x16& p1, const char* Ks, const bf16x8* qr, int r32, int hi) {
  constexpr int KROW = DQK * 2 + 16;
  p0 = f32x16{}; p1 = f32x16{};
#pragma unroll
  for (int d0 = 0; d0 < DQK / 16; ++d0) { const int cb = (d0 * 16 + hi * 8) * 2;
    const bf16x8 b0 = *reinterpret_cast<const bf16x8*>(Ks + r32 * KROW + cb);
    const bf16x8 b1 = *reinterpret_cast<const bf16x8*>(Ks + (32 + r32) * KROW + cb);
    p0 = __builtin_amdgcn_mfma_f32_32x32x16_bf16(b0, qr[d0], p0, 0, 0, 0);
    p1 = __builtin_amdgcn_mfma_f32_32x32x16_bf16(b1, qr[d0], p1, 0, 0, 0); }
}
template <int NCG, bool SW23 = true> __device__ __forceinline__ int v_st(int k, int c) { const int kk = SW23 ? ((k & ~0xC) | ((k & 4) << 1) | ((k & 8) >> 1)) : k; return ((kk >> 3) * NCG + (c >> 5)) * 512 + ((kk & 7) * 32 + (c & 31)) * 2; }
__device__ __forceinline__ int v_rd_base(int lane) { return ((lane & 3) << 3) | (((lane >> 2) & 3) << 6) | (((lane >> 4) & 1) << 5) | (((lane >> 5) & 1) << 8); }
template <int OFF> __device__ __forceinline__ s16x4 tr_read(int vb) { s16x4 r; asm volatile("ds_read_b64_tr_b16 %0, %1 offset:%2" : "=&v"(r) : "v"(vb), "i"(OFF) : "memory"); return r; }
template <int D0, int NCG> __device__ __forceinline__ void pv_one(f32x16& od, int vb, bf16x8 pa0, bf16x8 pa1, bf16x8 pa2, bf16x8 pa3) {
  constexpr int KS = 2 * NCG * 512, HF = NCG * 512, B = D0 * 512;
  const s16x4 l0 = tr_read<B + 0 * KS>(vb), h0 = tr_read<B + 0 * KS + HF>(vb), l1 = tr_read<B + 1 * KS>(vb), h1 = tr_read<B + 1 * KS + HF>(vb);
  const s16x4 l2 = tr_read<B + 2 * KS>(vb), h2 = tr_read<B + 2 * KS + HF>(vb), l3 = tr_read<B + 3 * KS>(vb), h3 = tr_read<B + 3 * KS + HF>(vb);
  asm volatile("s_waitcnt lgkmcnt(0)" ::: "memory"); ASBAR();
#define ATT_PK(L, H) (bf16x8){L[0], L[1], L[2], L[3], H[0], H[1], H[2], H[3]}
  od = __builtin_amdgcn_mfma_f32_32x32x16_bf16(pa0, ATT_PK(l0, h0), od, 0, 0, 0);
  od = __builtin_amdgcn_mfma_f32_32x32x16_bf16(pa1, ATT_PK(l1, h1), od, 0, 0, 0);
  od = __builtin_amdgcn_mfma_f32_32x32x16_bf16(pa2, ATT_PK(l2, h2), od, 0, 0, 0);
  od = __builtin_amdgcn_mfma_f32_32x32x16_bf16(pa3, ATT_PK(l3, h3), od, 0, 0, 0);
#undef ATT_PK
}
template <int NCG> __device__ __forceinline__ void pv_all(f32x16* o, int vb, bf16x8 pa0, bf16x8 pa1, bf16x8 pa2, bf16x8 pa3) {
  pv_one<0, NCG>(o[0], vb, pa0, pa1, pa2, pa3); pv_one<1, NCG>(o[1], vb, pa0, pa1, pa2, pa3);
  if constexpr (NCG == 4) { pv_one<2, NCG>(o[2], vb, pa0, pa1, pa2, pa3); pv_one<3, NCG>(o[3], vb, pa0, pa1, pa2, pa3); }
}
template <int OFF> __device__ __forceinline__ bf16x8 lds_read128(int addr) { bf16x8 r; asm volatile("ds_read_b128 %0, %1 offset:%2" : "=&v"(r) : "v"(addr), "i"(OFF) : "memory"); return r; }
template <int N> __device__ __forceinline__ void lgkm_wait() { asm volatile("s_waitcnt lgkmcnt(%0)" :: "n"(N) : "memory"); __builtin_amdgcn_sched_barrier(0); }
template <int D0, int NCG> __device__ __forceinline__ void v_reads(s16x4 (&vl)[4], s16x4 (&vh)[4], int vb) {
  constexpr int KS = 2 * NCG * 512, HF = NCG * 512, B = D0 * 512;
  vl[0] = tr_read<B + 0 * KS>(vb); vh[0] = tr_read<B + 0 * KS + HF>(vb); vl[1] = tr_read<B + 1 * KS>(vb); vh[1] = tr_read<B + 1 * KS + HF>(vb);
  vl[2] = tr_read<B + 2 * KS>(vb); vh[2] = tr_read<B + 2 * KS + HF>(vb); vl[3] = tr_read<B + 3 * KS>(vb); vh[3] = tr_read<B + 3 * KS + HF>(vb);
}
__device__ __forceinline__ void pv_mma(f32x16& od, const s16x4 (&vl)[4], const s16x4 (&vh)[4], bf16x8 pa0, bf16x8 pa1, bf16x8 pa2, bf16x8 pa3) {
#define ATT_PK(L, H) (bf16x8){L[0], L[1], L[2], L[3], H[0], H[1], H[2], H[3]}
  od = __builtin_amdgcn_mfma_f32_32x32x16_bf16(pa0, ATT_PK(vl[0], vh[0]), od, 0, 0, 0);
  od = __builtin_amdgcn_mfma_f32_32x32x16_bf16(pa1, ATT_PK(vl[1], vh[1]), od, 0, 0, 0);
  od = __builtin_amdgcn_mfma_f32_32x32x16_bf16(pa2, ATT_PK(vl[2], vh[2]), od, 0, 0, 0);
  od = __builtin_amdgcn_mfma_f32_32x32x16_bf16(pa3, ATT_PK(vl[3], vh[3]), od, 0, 0, 0);
#undef ATT_PK
}
template <int DQK, int NCG, bool PV> __device__ __forceinline__ void m_segment(f32x16& p0, f32x16& p1, f32x16* o, const char* Ks, int vb, const bf16x8* qr, bf16x8 pa0, bf16x8 pa1, bf16x8 pa2, bf16x8 pa3, int r32, int hi) {
  constexpr int KROW = DQK * 2 + 16, ND0 = DQK / 16;
  const int ka = (int)(uintptr_t)Ks + r32 * KROW + hi * 16;
  bf16x8 kf[2 * ND0];
  kf[0] = lds_read128<0>(ka); kf[1] = lds_read128<32 * KROW>(ka); kf[2] = lds_read128<32>(ka); kf[3] = lds_read128<32 + 32 * KROW>(ka);
  kf[4] = lds_read128<64>(ka); kf[5] = lds_read128<64 + 32 * KROW>(ka); kf[6] = lds_read128<96>(ka); kf[7] = lds_read128<96 + 32 * KROW>(ka);
  if constexpr (ND0 > 4) { kf[8] = lds_read128<128>(ka); kf[9] = lds_read128<128 + 32 * KROW>(ka); kf[10] = lds_read128<160>(ka); kf[11] = lds_read128<160 + 32 * KROW>(ka); }
  if constexpr (ND0 > 6) { kf[12] = lds_read128<192>(ka); kf[13] = lds_read128<192 + 32 * KROW>(ka); kf[14] = lds_read128<224>(ka); kf[15] = lds_read128<224 + 32 * KROW>(ka); }
  s16x4 vlA[4], vhA[4], vlB[4], vhB[4];
  if constexpr (PV) { v_reads<0, NCG>(vlA, vhA, vb); lgkm_wait<8>(); } else lgkm_wait<0>();
  p0 = f32x16{}; p1 = f32x16{};
#pragma unroll
  for (int d0 = 0; d0 < ND0; ++d0) { p0 = __builtin_amdgcn_mfma_f32_32x32x16_bf16(kf[2 * d0], qr[d0], p0, 0, 0, 0); p1 = __builtin_amdgcn_mfma_f32_32x32x16_bf16(kf[2 * d0 + 1], qr[d0], p1, 0, 0, 0); }
  if constexpr (PV) {
    __builtin_amdgcn_sched_barrier(0);
    v_reads<1, NCG>(vlB, vhB, vb); lgkm_wait<8>(); pv_mma(o[0], vlA, vhA, pa0, pa1, pa2, pa3);
    if constexpr (NCG == 2) { lgkm_wait<0>(); pv_mma(o[1], vlB, vhB, pa0, pa1, pa2, pa3); }
    else { __builtin_amdgcn_sched_barrier(0); v_reads<2, NCG>(vlA, vhA, vb); lgkm_wait<8>(); pv_mma(o[1], vlB, vhB, pa0, pa1, pa2, pa3);
           __builtin_amdgcn_sched_barrier(0); v_reads<3, NCG>(vlB, vhB, vb); lgkm_wait<8>(); pv_mma(o[2], vlA, vhA, pa0, pa1, pa2, pa3);
           lgkm_wait<0>(); pv_mma(o[3], vlB, vhB, pa0, pa1, pa2, pa3); }
  }
}
template <int DQK, int DV> struct Cfg {
  static constexpr int KROW = DQK * 2 + 16, SHM_K = 64 * KROW, SHM_V = 64 * DV * 2, NCG = DV / 32, KCH = DQK / 8, VCH = DV / 8;
  static constexpr int KPT = (64 * KCH + 511) / 512, VPT = (64 * VCH + 511) / 512, LDS = 2 * SHM_V + 2 * SHM_K + 8 * 64 * 4, LDS2 = LDS + 8 * 32 * 64 * 2;
};
template <int DQK, int DV, int LDQ, int LDK, int LDV, int LDO>
__device__ __forceinline__ void attn_body(const bf16_t* Qb, const bf16_t* __restrict__ Kh, const bf16_t* __restrict__ Vh, bf16_t* Ob, int seq, float C, float thr_raw, char* lds, const int wave_id) {
  using CF = Cfg<DQK, DV>;
  constexpr int KROW = CF::KROW, SHM_K = CF::SHM_K, SHM_V = CF::SHM_V, NCG = CF::NCG, KCH = CF::KCH, VCH = CF::VCH, KPT = CF::KPT, VPT = CF::VPT, ND0 = DQK / 16, NDB = DV / 32, SDEPTH = 2;
  int lane_ = pg8::lane_now(); asm volatile("" : "+v"(lane_));
  const int lane = lane_, wid = wave_id, tid = wave_id * 64 + lane, r32 = lane & 31, hi = lane >> 5;
  char* V_lds = lds; char* K_lds = lds + 2 * SHM_V;
  float* ws = (float*)(lds + 2 * SHM_V + 2 * SHM_K) + wid * 64; float* li_l = ws; float* al_l = ws + 32;
  float m_reg = -1e30f, l_reg = 0; f32x16 o[NDB]; bf16x8 qr[ND0];
#pragma unroll
  for (int d = 0; d < NDB; ++d) o[d] = f32x16{};
  const bf16_t* Qw = Qb + (long)(wid * 32 + r32) * LDQ + hi * 8;
#pragma unroll
  for (int d0 = 0; d0 < ND0; ++d0) qr[d0] = *reinterpret_cast<const bf16x8*>(Qw + d0 * 16);
  int kgo[KPT], klo[KPT], vgo[VPT], vlo[VPT]; bool kval[KPT];
#pragma unroll
  for (int j = 0; j < KPT; ++j) { const int p = tid + 512 * j, row = p / KCH, ch = p - row * KCH; kval[j] = p < 64 * KCH; kgo[j] = row * LDK + ch * 8; klo[j] = row * KROW + ch * 16; }
#pragma unroll
  for (int j = 0; j < VPT; ++j) { const int p = tid + 512 * j, key = p / VCH, c = (p - key * VCH) * 8; vgo[j] = key * LDV + c; vlo[j] = v_st<NCG>(key, c); }
  const int vb0 = (int)(uintptr_t)V_lds + v_rd_base(lane);
  bf16x8 sk[SDEPTH][KPT], sv[SDEPTH][VPT];
#define ATT_SLOAD(i, k0) do { _Pragma("unroll") for (int j_ = 0; j_ < VPT; ++j_) sv[i][j_] = *reinterpret_cast<const bf16x8*>(Vh + (long)(k0) * LDV + vgo[j_]); \
    _Pragma("unroll") for (int j_ = 0; j_ < KPT; ++j_) if (kval[j_]) sk[i][j_] = *reinterpret_cast<const bf16x8*>(Kh + (long)(k0) * LDK + kgo[j_]); } while (0)
#define ATT_SWRITE(b, i) do { _Pragma("unroll") for (int j_ = 0; j_ < VPT; ++j_) *reinterpret_cast<bf16x8*>(V_lds + (b) * SHM_V + vlo[j_]) = sv[i][j_]; \
    _Pragma("unroll") for (int j_ = 0; j_ < KPT; ++j_) if (kval[j_]) *reinterpret_cast<bf16x8*>(K_lds + (b) * SHM_K + klo[j_]) = sk[i][j_]; } while (0)
#define ATT_SWAIT() asm volatile("s_waitcnt vmcnt(%0)" :: "n"(KPT + VPT) : "memory")
#define ATT_RESC(a) do { if (__any((a) < 1.f)) { if (hi == 0) al_l[r32] = (a); asm volatile("s_waitcnt lgkmcnt(0)" ::: "memory"); \
    _Pragma("unroll") for (int d_ = 0; d_ < NDB; ++d_) _Pragma("unroll") for (int r_ = 0; r_ < 16; ++r_) o[d_][r_] *= al_l[crow(r_, hi)]; } } while (0)
  f32x16 pA0, pA1, pB0, pB1; float mnA, mnB, alA, alB; bf16x8 pa0, pa1, pa2, pa3; const int NT = seq / 64;
  constexpr int SE = 0, SO = SDEPTH - 1;
  ATT_SLOAD(SE, 0); asm volatile("s_waitcnt vmcnt(0)" ::: "memory"); ATT_SWRITE(0, SE); __syncthreads();
  qkt<DQK>(pA0, pA1, K_lds, qr, r32, hi); partialSM(pA0, pA1, m_reg, mnA, alA, C, thr_raw);
  ATT_SLOAD(SO, 64); if (2 < NT) ATT_SLOAD(SE, 2 * 64);
  ATT_SWAIT(); ATT_SWRITE(1, SO); __syncthreads();
  for (int j = 1; j + 1 < NT; j += 2) {
    ASBAR(); qkt<DQK>(pB0, pB1, K_lds + SHM_K, qr, r32, hi);
    finishSM(pA0, pA1, alA, l_reg, pa0, pa1, pa2, pa3); ASBAR();
    ATT_SLOAD(SO, (j + SDEPTH) * 64); ASBAR();
    pv_all<NCG>(o, vb0, pa0, pa1, pa2, pa3); partialSM(pB0, pB1, m_reg, mnB, alB, C, thr_raw);
    __syncthreads(); ATT_SWAIT(); ATT_SWRITE(0, SE);
    ATT_RESC(alB); __syncthreads();
    ASBAR(); qkt<DQK>(pA0, pA1, K_lds, qr, r32, hi);
    finishSM(pB0, pB1, alB, l_reg, pa0, pa1, pa2, pa3); ASBAR();
    if (j + 3 < NT) ATT_SLOAD(SE, (j + 1 + SDEPTH) * 64); ASBAR();
    pv_all<NCG>(o, vb0 + SHM_V, pa0, pa1, pa2, pa3); partialSM(pA0, pA1, m_reg, mnA, alA, C, thr_raw);
    __syncthreads(); ATT_SWAIT(); ATT_SWRITE(1, SO);
    ATT_RESC(alA); __syncthreads();
  }
  ASBAR(); qkt<DQK>(pB0, pB1, K_lds + SHM_K, qr, r32, hi);
  finishSM(pA0, pA1, alA, l_reg, pa0, pa1, pa2, pa3); ASBAR();
  pv_all<NCG>(o, vb0, pa0, pa1, pa2, pa3); partialSM(pB0, pB1, m_reg, mnB, alB, C, thr_raw);
  __syncthreads(); ATT_RESC(alB);
  finishSM(pB0, pB1, alB, l_reg, pa0, pa1, pa2, pa3); ASBAR();
  pv_all<NCG>(o, vb0 + SHM_V, pa0, pa1, pa2, pa3);
  if (hi == 0) li_l[r32] = l_reg; asm volatile("s_waitcnt lgkmcnt(0)" ::: "memory");
  float rli[16];
#pragma unroll
  for (int r = 0; r < 16; ++r) rli[r] = __builtin_amdgcn_rcpf(li_l[crow(r, hi)]);
  bf16_t* Ow = Ob + (long)(wid * 32) * LDO;
#pragma unroll
  for (int r = 0; r < 16; ++r) { const int orow = crow(r, hi);
#pragma unroll
    for (int d0 = 0; d0 < NDB; ++d0) { const unsigned w = cvtpk(o[d0][r] * rli[r], 0.f); Ow[(long)orow * LDO + d0 * 32 + r32] = (bf16_t)(w & 0xffffu); } }
  __syncthreads();
#undef ATT_SLOAD
#undef ATT_SWRITE
#undef ATT_SWAIT
#undef ATT_RESC
}

template <int DQK, int DV, int LDQ, int LDK, int LDV, int LDO>
__device__ __forceinline__ void attn_body2(const bf16_t* Qb, const bf16_t* __restrict__ Kh, const bf16_t* __restrict__ Vh, bf16_t* Ob, int seq, float C, float thr_raw, char* lds, const int wave_id) {
  using CF = Cfg<DQK, DV>;
  constexpr int KROW = CF::KROW, SHM_K = CF::SHM_K, SHM_V = CF::SHM_V, NCG = CF::NCG, KCH = CF::KCH, VCH = CF::VCH, KPT = CF::KPT, VPT = CF::VPT, ND0 = DQK / 16, NDB = DV / 32;
  int lane_ = pg8::lane_now(); asm volatile("" : "+v"(lane_));
  const int lane = lane_, wid = wave_id, tid = wave_id * 64 + lane, r32 = lane & 31, hi = lane >> 5, g = wid >> 2;
  char* V_lds = lds; char* K_lds = lds + 2 * SHM_V;
  float* ws = (float*)(lds + 2 * SHM_V + 2 * SHM_K) + wid * 64; float* li_l = ws; float* al_l = ws + 32;
  bf16_t* stg = (bf16_t*)(lds + 2 * SHM_V + 2 * SHM_K + 8 * 64 * 4) + wid * (32 * 64);
  float m_reg = -1e30f, l_reg = 0; f32x16 o[NDB]; bf16x8 qr[ND0];
#pragma unroll
  for (int d = 0; d < NDB; ++d) o[d] = f32x16{};
  const bf16_t* Qw = Qb + (long)(wid * 32 + r32) * LDQ + hi * 8;
#pragma unroll
  for (int d0 = 0; d0 < ND0; ++d0) qr[d0] = *reinterpret_cast<const bf16x8*>(Qw + d0 * 16);
  int kgo[KPT], klo[KPT], vgo[VPT], vlo[VPT];
#pragma unroll
  for (int j = 0; j < KPT; ++j) { int p = tid + 512 * j; if (p >= 64 * KCH) p = tid; const int row = p / KCH, ch = p - row * KCH; kgo[j] = row * LDK + ch * 8; klo[j] = row * KROW + ch * 16; }
#pragma unroll
  for (int j = 0; j < VPT; ++j) { const int p = tid + 512 * j, key = p / VCH, c = (p - key * VCH) * 8; vgo[j] = key * LDV + c; vlo[j] = v_st<NCG>(key, c); }
  const int vb0 = (int)(uintptr_t)V_lds + v_rd_base(lane);
  bf16x8 sk0[KPT], sv0[VPT], sk1[KPT], sv1[VPT], sk2[KPT], sv2[VPT], sk3[KPT], sv3[VPT];
  const int NT = seq / 64, TL = NT - 1;
#define A2_LOAD(S, kx, vx) do { const int kx_ = (kx) < TL ? (kx) : TL, vx_ = (vx) < TL ? (vx) : TL; \
    _Pragma("unroll") for (int j_ = 0; j_ < KPT; ++j_) sk##S[j_] = *reinterpret_cast<const bf16x8*>(Kh + (long)kx_ * 64 * LDK + kgo[j_]); \
    _Pragma("unroll") for (int j_ = 0; j_ < VPT; ++j_) sv##S[j_] = *reinterpret_cast<const bf16x8*>(Vh + (long)vx_ * 64 * LDV + vgo[j_]); } while (0)
#define A2_WRITE(S, kx, vx) do { _Pragma("unroll") for (int j_ = 0; j_ < KPT; ++j_) *reinterpret_cast<bf16x8*>(K_lds + ((kx) & 1) * SHM_K + klo[j_]) = sk##S[j_]; \
    _Pragma("unroll") for (int j_ = 0; j_ < VPT; ++j_) *reinterpret_cast<bf16x8*>(V_lds + ((vx) & 1) * SHM_V + vlo[j_]) = sv##S[j_]; } while (0)
#define A2_STAGE(S, t_) do { A2_WRITE(S, (t_) + 1 + g, (t_) + g); A2_LOAD(S, (t_) + 5 + g, (t_) + 4 + g); } while (0)
#define A2_PIN_O() do { _Pragma("unroll") for (int d_ = 0; d_ < NDB; ++d_) asm volatile("" : "+v"(o[d_])); } while (0)
#define A2_MSEG(t_) do { if ((t_) > 0) m_segment<DQK, NCG, true>(p0, p1, o, K_lds + ((t_) & 1) * SHM_K, vb0 + (((t_) - 1) & 1) * SHM_V, qr, pa0, pa1, pa2, pa3, r32, hi); \
    else m_segment<DQK, NCG, false>(p0, p1, o, K_lds + ((t_) & 1) * SHM_K, vb0, qr, pa0, pa1, pa2, pa3, r32, hi); \
    ASBAR(); __syncthreads(); ASBAR(); asm volatile("" : "+v"(p0), "+v"(p1)); A2_PIN_O(); } while (0)
#define A2_VSEG(S, t_) do { { float mn_; partialSM(p0, p1, m_reg, mn_, alpha, C, thr_raw); (void)mn_; } \
    finishSM(p0, p1, alpha, l_reg, pa0, pa1, pa2, pa3); \
    if (__any(alpha < 1.f)) { if (hi == 0) al_l[r32] = alpha; asm volatile("s_waitcnt lgkmcnt(0)" ::: "memory"); \
      _Pragma("unroll") for (int d_ = 0; d_ < NDB; ++d_) _Pragma("unroll") for (int r_ = 0; r_ < 16; ++r_) o[d_][r_] *= al_l[crow(r_, hi)]; } \
    A2_STAGE(S, t_); asm volatile("" : "+v"(pa0), "+v"(pa1), "+v"(pa2), "+v"(pa3), "+v"(l_reg), "+v"(m_reg)); A2_PIN_O(); ASBAR(); __syncthreads(); ASBAR(); } while (0)
  { A2_LOAD(0, 0, 0); _Pragma("unroll") for (int j_ = 0; j_ < KPT; ++j_) *reinterpret_cast<bf16x8*>(K_lds + klo[j_]) = sk0[j_]; }
  if (g) { A2_LOAD(3, 1, 0); A2_LOAD(0, 2, 1); A2_LOAD(1, 3, 2); A2_LOAD(2, 4, 3); }
  else   { A2_LOAD(0, 1, 0); A2_LOAD(1, 2, 1); A2_LOAD(2, 3, 2); A2_LOAD(3, 4, 3); }
  __syncthreads();
  if (g) { A2_STAGE(3, -1); __syncthreads(); }
  f32x16 p0, p1; bf16x8 pa0, pa1, pa2, pa3; float alpha = 1.f;
  for (int t = 0; t < NT; t += 4) {
    A2_MSEG(t);     A2_VSEG(0, t);
    A2_MSEG(t + 1); A2_VSEG(1, t + 1);
    A2_MSEG(t + 2); A2_VSEG(2, t + 2);
    A2_MSEG(t + 3); A2_VSEG(3, t + 3);
  }
  pv_all<NCG>(o, vb0 + ((NT - 1) & 1) * SHM_V, pa0, pa1, pa2, pa3);
  if (!g) __syncthreads();
  if (hi == 0) li_l[r32] = l_reg; asm volatile("s_waitcnt lgkmcnt(0)" ::: "memory");
  float rli[16];
#pragma unroll
  for (int r = 0; r < 16; ++r) rli[r] = __builtin_amdgcn_rcpf(li_l[crow(r, hi)]);
  bf16_t* Ow = Ob + (long)(wid * 32) * LDO;
#pragma unroll
  for (int hb = 0; hb < NDB / 2; ++hb) {
#pragma unroll
    for (int r = 0; r < 16; ++r) { const int orow = crow(r, hi);
#pragma unroll
      for (int d0 = 0; d0 < 2; ++d0) stg[orow * 64 + d0 * 32 + r32] = (bf16_t)(cvtpk(o[2 * hb + d0][r] * rli[r], 0.f) & 0xffffu); }
    asm volatile("s_waitcnt lgkmcnt(0)" ::: "memory");
#pragma unroll
    for (int i = 0; i < 4; ++i) { const int idx = i * 64 + lane, row = idx >> 3, ch = idx & 7;
      *reinterpret_cast<u32x4*>(Ow + (long)row * LDO + hb * 64 + ch * 8) = *reinterpret_cast<const u32x4*>(stg + row * 64 + ch * 8); }
    asm volatile("s_waitcnt lgkmcnt(0)" ::: "memory");
  }
  __syncthreads();
#undef A2_LOAD
#undef A2_WRITE
#undef A2_STAGE
#undef A2_MSEG
#undef A2_PIN_O
#undef A2_VSEG
}

template <int DQK, int DV, int LDQ, int LDK, int LDV, int LDO>
__device__ __forceinline__ void attn_body3(const bf16_t* Qb, const bf16_t* __restrict__ Kh, const bf16_t* __restrict__ Vh, bf16_t* Ob, int seq, float C, float thr_raw, char* lds, const int wave_id) {
  using CF = Cfg<DQK, DV>;
  constexpr int KROW = CF::KROW, SHM_K = CF::SHM_K, SHM_V = CF::SHM_V, NCG = CF::NCG, KCH = CF::KCH, VCH = CF::VCH, KPT = CF::KPT, VPT = CF::VPT, ND0 = DQK / 16, NDB = DV / 32;
  static_assert(NCG == 2, "attn_body3: DV = 64");
  int lane_ = pg8::lane_now(); asm volatile("" : "+v"(lane_));
  const int lane = lane_, wid = wave_id, tid = wave_id * 64 + lane, r32 = lane & 31, hi = lane >> 5;
  char* V_lds = lds; char* K_lds = lds + 2 * SHM_V;
  float* ws = (float*)(lds + 2 * SHM_V + 2 * SHM_K) + wid * 64; float* li_l = ws; float* al_l = ws + 32;
  bf16_t* stg = (bf16_t*)(lds + 2 * SHM_V + 2 * SHM_K + 8 * 64 * 4) + wid * (32 * 64);
  float m_reg = -1e30f, l_reg = 0; f32x16 o[NDB]; bf16x8 qr[ND0];
#pragma unroll
  for (int d = 0; d < NDB; ++d) o[d] = f32x16{};
  const bf16_t* Qw = Qb + (long)(wid * 32 + r32) * LDQ + hi * 8;
#pragma unroll
  for (int d0 = 0; d0 < ND0; ++d0) qr[d0] = *reinterpret_cast<const bf16x8*>(Qw + d0 * 16);
  int kgo[KPT], klo[KPT], vgo[VPT], vlo[VPT];
#pragma unroll
  for (int j = 0; j < KPT; ++j) { int p = tid + 512 * j; if (p >= 64 * KCH) p = tid; const int row = p / KCH, ch = p - row * KCH; kgo[j] = row * LDK + ch * 8; klo[j] = row * KROW + ch * 16; }
#pragma unroll
  for (int j = 0; j < VPT; ++j) { const int p = tid + 512 * j, key = p / VCH, c = (p - key * VCH) * 8; vgo[j] = key * LDV + c; vlo[j] = v_st<NCG>(key, c); }
  const int vb0 = (int)(uintptr_t)V_lds + v_rd_base(lane);
  const int ka0 = (int)(uintptr_t)K_lds + r32 * KROW + hi * 16;
  bf16x8 sk0[KPT], sv0[VPT], sk1[KPT], sv1[VPT];
  const int NT = seq / 64, TL = NT - 1;
#define A3_KLOAD(S, kx) do { const int kx_ = (kx) < TL ? (kx) : TL; _Pragma("unroll") for (int j_ = 0; j_ < KPT; ++j_) sk##S[j_] = *reinterpret_cast<const bf16x8*>(Kh + (long)kx_ * 64 * LDK + kgo[j_]); } while (0)
#define A3_VLOAD(S, vx) do { const int vx_ = (vx) < TL ? (vx) : TL; _Pragma("unroll") for (int j_ = 0; j_ < VPT; ++j_) sv##S[j_] = *reinterpret_cast<const bf16x8*>(Vh + (long)vx_ * 64 * LDV + vgo[j_]); } while (0)
#define A3_KWRITE(S, kx) do { _Pragma("unroll") for (int j_ = 0; j_ < KPT; ++j_) *reinterpret_cast<bf16x8*>(K_lds + ((kx) & 1) * SHM_K + klo[j_]) = sk##S[j_]; } while (0)
#define A3_VWRITE(S, vx) do { _Pragma("unroll") for (int j_ = 0; j_ < VPT; ++j_) *reinterpret_cast<bf16x8*>(V_lds + ((vx) & 1) * SHM_V + vlo[j_]) = sv##S[j_]; } while (0)
#define A3_KREADS(kf, x) do { const int ka_ = ka0 + ((x) & 1) * SHM_K; \
    kf[0] = lds_read128<0>(ka_); kf[1] = lds_read128<32 * KROW>(ka_); kf[2] = lds_read128<32>(ka_); kf[3] = lds_read128<32 + 32 * KROW>(ka_); \
    kf[4] = lds_read128<64>(ka_); kf[5] = lds_read128<64 + 32 * KROW>(ka_); kf[6] = lds_read128<96>(ka_); kf[7] = lds_read128<96 + 32 * KROW>(ka_); \
    if constexpr (ND0 > 4) { kf[8] = lds_read128<128>(ka_); kf[9] = lds_read128<128 + 32 * KROW>(ka_); kf[10] = lds_read128<160>(ka_); kf[11] = lds_read128<160 + 32 * KROW>(ka_); } } while (0)
#define A3_SGB_MFMA_VALU(nm, nv) do { _Pragma("unroll") for (int i_ = 0; i_ < (nm); ++i_) { __builtin_amdgcn_sched_group_barrier(0x008, 1, 0); __builtin_amdgcn_sched_group_barrier(0x002, (nv), 0); } } while (0)
#define A3_ITER(t_, S, PC0, PC1, PN0, PN1, PV_) do { \
    __syncthreads(); \
    bf16x8 kf_[2 * ND0]; s16x4 vlA_[4], vhA_[4], vlB_[4], vhB_[4]; const int vp_ = vb0 + (((t_) - 1) & 1) * SHM_V; \
    v_reads<0, NCG>(vlA_, vhA_, vp_); v_reads<1, NCG>(vlB_, vhB_, vp_); A3_KREADS(kf_, (t_) + 1); \
    A3_KWRITE(S, (t_) + 2); A3_VWRITE(S, (t_)); A3_KLOAD(S, (t_) + 4); A3_VLOAD(S, (t_) + 2); \
    lgkm_wait<0>(); \
    if (PV_) { pv_mma(o[0], vlA_, vhA_, pa0, pa1, pa2, pa3); pv_mma(o[1], vlB_, vhB_, pa0, pa1, pa2, pa3); } \
    { float mn_; partialSM(PC0, PC1, m_reg, mn_, alpha, C, thr_raw); (void)mn_; } \
    A3_SGB_MFMA_VALU(8, 10); ASBAR(); \
    PN0 = f32x16{}; PN1 = f32x16{}; \
    _Pragma("unroll") for (int d0 = 0; d0 < ND0; ++d0) { PN0 = __builtin_amdgcn_mfma_f32_32x32x16_bf16(kf_[2 * d0], qr[d0], PN0, 0, 0, 0); PN1 = __builtin_amdgcn_mfma_f32_32x32x16_bf16(kf_[2 * d0 + 1], qr[d0], PN1, 0, 0, 0); } \
    finishSM(PC0, PC1, alpha, l_reg, pa0, pa1, pa2, pa3); \
    A3_SGB_MFMA_VALU(2 * ND0, 6); ASBAR(); \
    if (__any(alpha < 1.f)) { if (hi == 0) al_l[r32] = alpha; asm volatile("s_waitcnt lgkmcnt(0)" ::: "memory"); \
      _Pragma("unroll") for (int d_ = 0; d_ < NDB; ++d_) _Pragma("unroll") for (int r_ = 0; r_ < 16; ++r_) o[d_][r_] *= al_l[crow(r_, hi)]; } \
  } while (0)
  A3_KLOAD(0, 0); A3_KLOAD(1, 1); A3_KWRITE(0, 0); A3_KWRITE(1, 1);
  A3_KLOAD(0, 2); A3_VLOAD(0, 0); A3_KLOAD(1, 3); A3_VLOAD(1, 1);
  __syncthreads();
  f32x16 pA0, pA1, pB0, pB1; bf16x8 pa0, pa1, pa2, pa3; float alpha = 1.f;
  pa0 = bf16x8{}; pa1 = bf16x8{}; pa2 = bf16x8{}; pa3 = bf16x8{};
  qkt<DQK>(pA0, pA1, K_lds, qr, r32, hi);
  A3_ITER(0, 0, pA0, pA1, pB0, pB1, 0);
  for (int t = 1; t + 1 < NT; t += 2) {
    A3_ITER(t, 1, pB0, pB1, pA0, pA1, 1);
    A3_ITER(t + 1, 0, pA0, pA1, pB0, pB1, 1);
  }
  A3_ITER(NT - 1, 1, pB0, pB1, pA0, pA1, 1);
  __syncthreads();
  { s16x4 vlA_[4], vhA_[4], vlB_[4], vhB_[4]; const int vp_ = vb0 + ((NT - 1) & 1) * SHM_V;
    v_reads<0, NCG>(vlA_, vhA_, vp_); v_reads<1, NCG>(vlB_, vhB_, vp_); lgkm_wait<0>();
    pv_mma(o[0], vlA_, vhA_, pa0, pa1, pa2, pa3); pv_mma(o[1], vlB_, vhB_, pa0, pa1, pa2, pa3); }
  if (hi == 0) li_l[r32] = l_reg; asm volatile("s_waitcnt lgkmcnt(0)" ::: "memory");
  float rli[16];
#pragma unroll
  for (int r = 0; r < 16; ++r) rli[r] = __builtin_amdgcn_rcpf(li_l[crow(r, hi)]);
  bf16_t* Ow = Ob + (long)(wid * 32) * LDO;
#pragma unroll
  for (int r = 0; r < 16; ++r) { const int orow = crow(r, hi);
#pragma unroll
    for (int d0 = 0; d0 < 2; ++d0) stg[orow * 64 + d0 * 32 + r32] = (bf16_t)(cvtpk(o[d0][r] * rli[r], 0.f) & 0xffffu); }
  asm volatile("s_waitcnt lgkmcnt(0)" ::: "memory");
#pragma unroll
  for (int i = 0; i < 4; ++i) { const int idx = i * 64 + lane, row = idx >> 3, ch = idx & 7;
    *reinterpret_cast<u32x4*>(Ow + (long)row * LDO + ch * 8) = *reinterpret_cast<const u32x4*>(stg + row * 64 + ch * 8); }
  __syncthreads();
#undef A3_KLOAD
#undef A3_VLOAD
#undef A3_KWRITE
#undef A3_VWRITE
#undef A3_KREADS
#undef A3_SGB_MFMA_VALU
#undef A3_ITER
}

constexpr float THR2 = 11.541560327111707f;
template <int DQK, int DV, int LDQ, int LDK, int LDV, int LDO, bool NOMAX, int NS, bool MSUM, bool KHOIST>
__device__ __forceinline__ void attn_body4(const bf16_t* Qb, const bf16_t* __restrict__ Kh, const bf16_t* __restrict__ Vh, bf16_t* Ob, int seq, float offs, char* lds, const int wave_id) {
  using CF = Cfg<DQK, DV>;
  constexpr int KROW = CF::KROW, SHM_K = CF::SHM_K, SHM_V = CF::SHM_V, NCG = CF::NCG, KCH = CF::KCH, VCH = CF::VCH, KPT = CF::KPT, VPT = CF::VPT, ND0 = DQK / 16, NDB = DV / 32;
  static_assert(NCG == 2, "attn_body4: DV = 64");
  int lane_ = pg8::lane_now(); asm volatile("" : "+v"(lane_));
  const int lane = lane_, wid = wave_id, tid = wave_id * 64 + lane, r32 = lane & 31, hi = lane >> 5;
  char* V_lds = lds; char* K_lds = lds + 2 * SHM_V;
  float* ws = (float*)(lds + 2 * SHM_V + 2 * SHM_K) + wid * 64; float* li_l = ws; float* al_l = ws + 32;
  bf16_t* stg = (bf16_t*)(lds + 2 * SHM_V + 2 * SHM_K + 8 * 64 * 4) + wid * (32 * 64);
  float m_run = 0.f, l_reg = 0.f; f32x16 o[NDB], osum, negt; bf16x8 qr[ND0];
#pragma unroll
  for (int d = 0; d < NDB; ++d) o[d] = f32x16{};
  osum = f32x16{};
#pragma unroll
  for (int r = 0; r < 16; ++r) negt[r] = NOMAX ? -offs : 0.f;
  const short one_ = (r32 == 0) ? (short)0x3F80 : (short)0;
  const bf16x8 ones = {one_, one_, one_, one_, one_, one_, one_, one_};
  const bf16_t* Qw = Qb + (long)(wid * 32 + r32) * LDQ + hi * 8;
#pragma unroll
  for (int d0 = 0; d0 < ND0; ++d0) qr[d0] = *reinterpret_cast<const bf16x8*>(Qw + d0 * 16);
  int kgo[KPT], klo[KPT], vgo[VPT], vlo[VPT];
#pragma unroll
  for (int j = 0; j < KPT; ++j) { int p = tid + 512 * j; if (p >= 64 * KCH) p = tid; const int row = p / KCH, ch = p - row * KCH; kgo[j] = row * LDK + ch * 8; klo[j] = row * KROW + ch * 16; }
#pragma unroll
  for (int j = 0; j < VPT; ++j) { const int p = tid + 512 * j, key = p / VCH, c = (p - key * VCH) * 8; vgo[j] = key * LDV + c; vlo[j] = v_st<NCG>(key, c); }
  const int vb0 = (int)(uintptr_t)V_lds + v_rd_base(lane);
  const int ka0 = (int)(uintptr_t)K_lds + r32 * KROW + hi * 16;
  bf16x8 sk0[KPT], sv0[VPT], sk1[KPT], sv1[VPT], sk2[KPT], sv2[VPT], sk3[KPT], sv3[VPT];
  const int NT = seq / 64, TL = NT - 1;
#define A4_KLOAD(S, kx) do { const int kx_ = (kx) < TL ? (kx) : TL; _Pragma("unroll") for (int j_ = 0; j_ < KPT; ++j_) sk##S[j_] = *reinterpret_cast<const bf16x8*>(Kh + (long)kx_ * 64 * LDK + kgo[j_]); } while (0)
#define A4_VLOAD(S, vx) do { const int vx_ = (vx) < TL ? (vx) : TL; _Pragma("unroll") for (int j_ = 0; j_ < VPT; ++j_) sv##S[j_] = *reinterpret_cast<const bf16x8*>(Vh + (long)vx_ * 64 * LDV + vgo[j_]); } while (0)
#define A4_KWRITE(S, kx) do { _Pragma("unroll") for (int j_ = 0; j_ < KPT; ++j_) *reinterpret_cast<bf16x8*>(K_lds + ((kx) & 1) * SHM_K + klo[j_]) = sk##S[j_]; } while (0)
#define A4_VWRITE(S, vx) do { _Pragma("unroll") for (int j_ = 0; j_ < VPT; ++j_) *reinterpret_cast<bf16x8*>(V_lds + ((vx) & 1) * SHM_V + vlo[j_]) = sv##S[j_]; } while (0)
#define A4_KREADS(kf, x) do { const int ka_ = ka0 + ((x) & 1) * SHM_K; \
    kf[0] = lds_read128<0>(ka_); kf[1] = lds_read128<32 * KROW>(ka_); kf[2] = lds_read128<32>(ka_); kf[3] = lds_read128<32 + 32 * KROW>(ka_); \
    kf[4] = lds_read128<64>(ka_); kf[5] = lds_read128<64 + 32 * KROW>(ka_); kf[6] = lds_read128<96>(ka_); kf[7] = lds_read128<96 + 32 * KROW>(ka_); \
    if constexpr (ND0 > 4) { kf[8] = lds_read128<128>(ka_); kf[9] = lds_read128<128 + 32 * KROW>(ka_); kf[10] = lds_read128<160>(ka_); kf[11] = lds_read128<160 + 32 * KROW>(ka_); } } while (0)
#define A4_SGB(nm, nv) do { _Pragma("unroll") for (int i_ = 0; i_ < (nm); ++i_) { __builtin_amdgcn_sched_group_barrier(0x008, 1, 0); __builtin_amdgcn_sched_group_barrier(0x002, (nv), 0); } } while (0)
#define A4_PK4(P, BASE, OUT) do { unsigned a0_ = cvtpk(P[BASE + 0], P[BASE + 1]), a1_ = cvtpk(P[BASE + 2], P[BASE + 3]), b0_ = cvtpk(P[BASE + 4], P[BASE + 5]), b1_ = cvtpk(P[BASE + 6], P[BASE + 7]); \
    auto r0_ = __builtin_amdgcn_permlane32_swap(a0_, b0_, false, false); auto r1_ = __builtin_amdgcn_permlane32_swap(a1_, b1_, false, false); \
    u32x4 w_ = {r0_[0], r1_[0], r0_[1], r1_[1]}; OUT = *reinterpret_cast<bf16x8*>(&w_); } while (0)
#define A4_PV(vlA, vhA, vlB, vhB) do { pv_mma(o[0], vlA, vhA, pa0, pa1, pa2, pa3); pv_mma(o[1], vlB, vhB, pa0, pa1, pa2, pa3); \
    if constexpr (MSUM) { osum = __builtin_amdgcn_mfma_f32_32x32x16_bf16(pa0, ones, osum, 0, 0, 0); osum = __builtin_amdgcn_mfma_f32_32x32x16_bf16(pa1, ones, osum, 0, 0, 0); \
                           osum = __builtin_amdgcn_mfma_f32_32x32x16_bf16(pa2, ones, osum, 0, 0, 0); osum = __builtin_amdgcn_mfma_f32_32x32x16_bf16(pa3, ones, osum, 0, 0, 0); } } while (0)
#define A4_QK(PN0, PN1, x) do { const char* kb_ = K_lds + ((x) & 1) * SHM_K + r32 * KROW + hi * 16; \
    PN0 = __builtin_amdgcn_mfma_f32_32x32x16_bf16(*reinterpret_cast<const bf16x8*>(kb_), qr[0], negt, 0, 0, 0); \
    PN1 = __builtin_amdgcn_mfma_f32_32x32x16_bf16(*reinterpret_cast<const bf16x8*>(kb_ + 32 * KROW), qr[0], negt, 0, 0, 0); \
    _Pragma("unroll") for (int d0 = 1; d0 < ND0; ++d0) { \
      PN0 = __builtin_amdgcn_mfma_f32_32x32x16_bf16(*reinterpret_cast<const bf16x8*>(kb_ + d0 * 32), qr[d0], PN0, 0, 0, 0); \
      PN1 = __builtin_amdgcn_mfma_f32_32x32x16_bf16(*reinterpret_cast<const bf16x8*>(kb_ + d0 * 32 + 32 * KROW), qr[d0], PN1, 0, 0, 0); } } while (0)
#define A4_OSUM() do { if constexpr (MSUM) { osum = __builtin_amdgcn_mfma_f32_32x32x16_bf16(pa0, ones, osum, 0, 0, 0); osum = __builtin_amdgcn_mfma_f32_32x32x16_bf16(pa1, ones, osum, 0, 0, 0); \
    osum = __builtin_amdgcn_mfma_f32_32x32x16_bf16(pa2, ones, osum, 0, 0, 0); osum = __builtin_amdgcn_mfma_f32_32x32x16_bf16(pa3, ones, osum, 0, 0, 0); } } while (0)
#define A4_ITER(t_, S, PC0, PC1, PN0, PN1, PV_) do { \
    __syncthreads(); \
    s16x4 vlA_[4], vhA_[4]; const int vp_ = vb0 + (((t_) - 1) & 1) * SHM_V; \
    if (PV_) v_reads<0, NCG>(vlA_, vhA_, vp_); \
    bf16x8 kf_[2 * ND0]; if constexpr (KHOIST) A4_KREADS(kf_, (t_) + 1); \
    A4_KWRITE(S, (t_) + 2); A4_VWRITE(S, (t_)); A4_KLOAD(S, (t_) + 2 + NS); A4_VLOAD(S, (t_) + NS); \
    if (PV_) A4_OSUM(); \
    if constexpr (!NOMAX) { \
      float pmax_ = PC0[0]; \
      _Pragma("unroll") for (int r_ = 1; r_ < 16; ++r_) pmax_ = fmaxf(pmax_, PC0[r_]); \
      _Pragma("unroll") for (int r_ = 0; r_ < 16; ++r_) pmax_ = fmaxf(pmax_, PC1[r_]); \
      { auto rr_ = __builtin_amdgcn_permlane32_swap(__float_as_uint(pmax_), __float_as_uint(pmax_), false, false); pmax_ = fmaxf(__uint_as_float(rr_[0]), __uint_as_float(rr_[1])); } \
      if (__builtin_expect(__all(pmax_ <= THR2), 1)) alpha = 1.f; \
      else { const float dl_ = fmaxf(pmax_, 0.f); m_run += dl_; alpha = __builtin_amdgcn_exp2f(-dl_); \
        _Pragma("unroll") for (int r_ = 0; r_ < 16; ++r_) { PC0[r_] -= dl_; PC1[r_] -= dl_; negt[r_] = -m_run; } } \
    } \
    if constexpr (KHOIST) lgkm_wait<2 * ND0 + KPT + VPT>(); else lgkm_wait<0>(); \
    if (PV_) pv_mma(o[0], vlA_, vhA_, pa0, pa1, pa2, pa3); \
    _Pragma("unroll") for (int r_ = 0; r_ < 8; ++r_) PC0[r_] = __builtin_amdgcn_exp2f(PC0[r_]); \
    A4_SGB((PV_) ? 4 : 0, 2); ASBAR(); \
    s16x4 vlB_[4], vhB_[4]; \
    if (PV_) v_reads<1, NCG>(vlB_, vhB_, vp_); \
    _Pragma("unroll") for (int r_ = 8; r_ < 16; ++r_) PC0[r_] = __builtin_amdgcn_exp2f(PC0[r_]); \
    lgkm_wait<0>(); \
    if (PV_) pv_mma(o[1], vlB_, vhB_, pa0, pa1, pa2, pa3); \
    _Pragma("unroll") for (int r_ = 0; r_ < 8; ++r_) PC1[r_] = __builtin_amdgcn_exp2f(PC1[r_]); \
    A4_SGB((PV_) ? 4 : 0, 2); ASBAR(); \
    if constexpr (KHOIST) { PN0 = __builtin_amdgcn_mfma_f32_32x32x16_bf16(kf_[0], qr[0], negt, 0, 0, 0); PN1 = __builtin_amdgcn_mfma_f32_32x32x16_bf16(kf_[1], qr[0], negt, 0, 0, 0); \
      _Pragma("unroll") for (int d0 = 1; d0 < ND0; ++d0) { PN0 = __builtin_amdgcn_mfma_f32_32x32x16_bf16(kf_[2 * d0], qr[d0], PN0, 0, 0, 0); PN1 = __builtin_amdgcn_mfma_f32_32x32x16_bf16(kf_[2 * d0 + 1], qr[d0], PN1, 0, 0, 0); } } \
    else A4_QK(PN0, PN1, (t_) + 1); \
    _Pragma("unroll") for (int r_ = 8; r_ < 16; ++r_) PC1[r_] = __builtin_amdgcn_exp2f(PC1[r_]); \
    if constexpr (!MSUM) { float ps_ = 0.f; \
      _Pragma("unroll") for (int r_ = 0; r_ < 16; ++r_) ps_ += PC0[r_]; \
      _Pragma("unroll") for (int r_ = 0; r_ < 16; ++r_) ps_ += PC1[r_]; \
      { auto rr_ = __builtin_amdgcn_permlane32_swap(__float_as_uint(ps_), __float_as_uint(ps_), false, false); ps_ = __uint_as_float(rr_[0]) + __uint_as_float(rr_[1]); } \
      l_reg = l_reg * alpha + ps_; } \
    A4_PK4(PC0, 0, pa0); A4_PK4(PC0, 8, pa1); A4_PK4(PC1, 0, pa2); A4_PK4(PC1, 8, pa3); \
    if constexpr (!KHOIST) { __builtin_amdgcn_sched_group_barrier(0x100, 2 * ND0, 0); __builtin_amdgcn_sched_group_barrier(0x002, 10, 0); } A4_SGB(2 * ND0, MSUM ? 3 : 5); ASBAR(); \
    if constexpr (!NOMAX) { if (__any(alpha < 1.f)) { if (hi == 0) al_l[r32] = alpha; asm volatile("s_waitcnt lgkmcnt(0)" ::: "memory"); \
      _Pragma("unroll") for (int r_ = 0; r_ < 16; ++r_) { const float f_ = al_l[crow(r_, hi)]; o[0][r_] *= f_; o[1][r_] *= f_; if constexpr (MSUM) osum[r_] *= f_; } } } \
  } while (0)
  A4_KLOAD(0, 0); A4_KLOAD(1, 1); A4_KWRITE(0, 0); A4_KWRITE(1, 1);
  A4_KLOAD(0, 2); A4_VLOAD(0, 0); A4_KLOAD(1, 3); A4_VLOAD(1, 1);
  if constexpr (NS == 4) { A4_KLOAD(2, 4); A4_VLOAD(2, 2); A4_KLOAD(3, 5); A4_VLOAD(3, 3); }
  __syncthreads();
  f32x16 pA0, pA1, pB0, pB1; bf16x8 pa0, pa1, pa2, pa3; float alpha = 1.f;
  pa0 = bf16x8{}; pa1 = bf16x8{}; pa2 = bf16x8{}; pa3 = bf16x8{};
  A4_QK(pA0, pA1, 0);
  A4_ITER(0, 0, pA0, pA1, pB0, pB1, 0);
  if constexpr (NS == 2) {
    for (int t = 1; t + 1 < NT; t += 2) {
      A4_ITER(t, 1, pB0, pB1, pA0, pA1, 1);
      A4_ITER(t + 1, 0, pA0, pA1, pB0, pB1, 1);
    }
    A4_ITER(NT - 1, 1, pB0, pB1, pA0, pA1, 1);
  } else {
    for (int t = 1; t + 3 < NT; t += 4) {
      A4_ITER(t, 1, pB0, pB1, pA0, pA1, 1);
      A4_ITER(t + 1, 2, pA0, pA1, pB0, pB1, 1);
      A4_ITER(t + 2, 3, pB0, pB1, pA0, pA1, 1);
      A4_ITER(t + 3, 0, pA0, pA1, pB0, pB1, 1);
    }
    A4_ITER(NT - 3, 1, pB0, pB1, pA0, pA1, 1);
    A4_ITER(NT - 2, 2, pA0, pA1, pB0, pB1, 1);
    A4_ITER(NT - 1, 3, pB0, pB1, pA0, pA1, 1);
  }
  __syncthreads();
  { s16x4 vlA_[4], vhA_[4], vlB_[4], vhB_[4]; const int vp_ = vb0 + ((NT - 1) & 1) * SHM_V;
    v_reads<0, NCG>(vlA_, vhA_, vp_); v_reads<1, NCG>(vlB_, vhB_, vp_); lgkm_wait<0>();
    A4_OSUM(); pv_mma(o[0], vlA_, vhA_, pa0, pa1, pa2, pa3); pv_mma(o[1], vlB_, vhB_, pa0, pa1, pa2, pa3); }
  if constexpr (MSUM) { if (r32 == 0) {
#pragma unroll
      for (int r = 0; r < 16; ++r) li_l[crow(r, hi)] = osum[r]; } }
  else { if (hi == 0) li_l[r32] = l_reg; }
  asm volatile("s_waitcnt lgkmcnt(0)" ::: "memory");
  float rli[16];
#pragma unroll
  for (int r = 0; r < 16; ++r) rli[r] = __builtin_amdgcn_rcpf(li_l[crow(r, hi)]);
  bf16_t* Ow = Ob + (long)(wid * 32) * LDO;
#pragma unroll
  for (int r = 0; r < 16; ++r) { const int orow = crow(r, hi);
#pragma unroll
    for (int d0 = 0; d0 < 2; ++d0) stg[orow * 64 + d0 * 32 + r32] = (bf16_t)(cvtpk(o[d0][r] * rli[r], 0.f) & 0xffffu); }
  asm volatile("s_waitcnt lgkmcnt(0)" ::: "memory");
#pragma unroll
  for (int i = 0; i < 4; ++i) { const int idx = i * 64 + lane, row = idx >> 3, ch = idx & 7;
    *reinterpret_cast<u32x4*>(Ow + (long)row * LDO + ch * 8) = *reinterpret_cast<const u32x4*>(stg + row * 64 + ch * 8); }
  __syncthreads();
#undef A4_KLOAD
#undef A4_VLOAD
#undef A4_KWRITE
#undef A4_VWRITE
#undef A4_QK
#undef A4_KREADS
#undef A4_SGB
#undef A4_PK4
#undef A4_PV
#undef A4_OSUM
#undef A4_ITER
}
template <int DQK, int DV, int LDQ, int LDK, int LDV, int LDO, bool NOMAX, int NS, bool MSUM, bool KHOIST, bool ZC = false>
__device__ __forceinline__ void attn_body5(const bf16_t* Qb, const bf16_t* __restrict__ Kh, const bf16_t* __restrict__ Vh, bf16_t* Ob, int seq, float offs, char* lds, const int wave_id) {
  using CF = Cfg<DQK, DV>;
  constexpr int KROW = CF::KROW, SHM_K = CF::SHM_K, SHM_V = CF::SHM_V, NCG = CF::NCG, KCH = CF::KCH, VCH = CF::VCH, KPT = CF::KPT, VPT = CF::VPT, ND0 = DQK / 16, NDB = DV / 32;
  static_assert(NCG == 2 && !KHOIST, "attn_body5: DV = 64");
  float lac0 = 0.f, lac1 = 0.f;
  constexpr int KAH = ND0 > 4 ? 8 : 8;
  int lane_ = pg8::lane_now(); asm volatile("" : "+v"(lane_));
  const int lane = lane_, wid = wave_id, tid = wave_id * 64 + lane, r32 = lane & 31, hi = lane >> 5;
  char* V_lds = lds; char* K_lds = lds + 2 * SHM_V;
  float* ws = (float*)(lds + 2 * SHM_V + 2 * SHM_K) + wid * 64; float* li_l = ws; float* al_l = ws + 32;
  bf16_t* stg = (bf16_t*)(lds + 2 * SHM_V + 2 * SHM_K + 8 * 64 * 4) + wid * (32 * 64);
  float m_run = 0.f, l_reg = 0.f; f32x16 o[NDB], osum, negt; bf16x8 qr[ND0];
#pragma unroll
  for (int d = 0; d < NDB; ++d) o[d] = f32x16{};
  osum = f32x16{};
#pragma unroll
  for (int r = 0; r < 16; ++r) negt[r] = -offs;
  bool anym = false;
  const short one_ = (r32 == 0) ? (short)0x3F80 : (short)0;
  const bf16x8 ones = {one_, one_, one_, one_, one_, one_, one_, one_};
  const bf16_t* Qw = Qb + (long)(wid * 32 + r32) * LDQ + hi * 8;
#pragma unroll
  for (int d0 = 0; d0 < ND0; ++d0) qr[d0] = *reinterpret_cast<const bf16x8*>(Qw + d0 * 16);
  int kgo[KPT], klo[KPT], vgo[VPT], vlo[VPT];
#pragma unroll
  for (int j = 0; j < KPT; ++j) { int p = tid + 512 * j; if (p >= 64 * KCH) p = tid; const int row = p / KCH, ch = p - row * KCH; kgo[j] = row * LDK + ch * 8; klo[j] = row * KROW + ch * 16; }
#pragma unroll
  for (int j = 0; j < VPT; ++j) { const int p = tid + 512 * j, key = p / VCH, c = (p - key * VCH) * 8; vgo[j] = key * LDV + c; vlo[j] = v_st<NCG>(key, c); }
  const int vb0 = (int)(uintptr_t)V_lds + v_rd_base(lane);
  const int ka0 = (int)(uintptr_t)K_lds + r32 * KROW + hi * 16;
  bf16x8 sk0[KPT], sv0[VPT], sk1[KPT], sv1[VPT], sk2[KPT], sv2[VPT], sk3[KPT], sv3[VPT];
  const int NT = seq / 64, TL = NT - 1;
#define A5_KLOAD(S, kx) do { const int kx_ = (kx) < TL ? (kx) : TL; _Pragma("unroll") for (int j_ = 0; j_ < KPT; ++j_) sk##S[j_] = *reinterpret_cast<const bf16x8*>(Kh + (long)kx_ * 64 * LDK + kgo[j_]); } while (0)
#define A5_VLOAD(S, vx) do { const int vx_ = (vx) < TL ? (vx) : TL; _Pragma("unroll") for (int j_ = 0; j_ < VPT; ++j_) sv##S[j_] = *reinterpret_cast<const bf16x8*>(Vh + (long)vx_ * 64 * LDV + vgo[j_]); } while (0)
#define A5_KWRITE(S, kx) do { _Pragma("unroll") for (int j_ = 0; j_ < KPT; ++j_) *reinterpret_cast<bf16x8*>(K_lds + ((kx) & 1) * SHM_K + klo[j_]) = sk##S[j_]; } while (0)
#define A5_VWRITE(S, vx) do { _Pragma("unroll") for (int j_ = 0; j_ < VPT; ++j_) *reinterpret_cast<bf16x8*>(V_lds + ((vx) & 1) * SHM_V + vlo[j_]) = sv##S[j_]; } while (0)
#define A5_KREADS(kf, x) do { const int ka_ = ka0 + ((x) & 1) * SHM_K; \
    kf[0] = lds_read128<0>(ka_); kf[1] = lds_read128<32 * KROW>(ka_); kf[2] = lds_read128<32>(ka_); kf[3] = lds_read128<32 + 32 * KROW>(ka_); \
    kf[4] = lds_read128<64>(ka_); kf[5] = lds_read128<64 + 32 * KROW>(ka_); kf[6] = lds_read128<96>(ka_); kf[7] = lds_read128<96 + 32 * KROW>(ka_); \
    if constexpr (ND0 > 4) { kf[8] = lds_read128<128>(ka_); kf[9] = lds_read128<128 + 32 * KROW>(ka_); kf[10] = lds_read128<160>(ka_); kf[11] = lds_read128<160 + 32 * KROW>(ka_); } } while (0)
#define A5_SGB(nm, nv) do { _Pragma("unroll") for (int i_ = 0; i_ < (nm); ++i_) { __builtin_amdgcn_sched_group_barrier(0x008, 1, 0); __builtin_amdgcn_sched_group_barrier(0x002, (nv), 0); } } while (0)
#define A5_PK4(P, BASE, OUT) do { unsigned a0_ = cvtpk(P[BASE + 0], P[BASE + 1]), a1_ = cvtpk(P[BASE + 2], P[BASE + 3]), b0_ = cvtpk(P[BASE + 4], P[BASE + 5]), b1_ = cvtpk(P[BASE + 6], P[BASE + 7]); \
    auto r0_ = __builtin_amdgcn_permlane32_swap(a0_, b0_, false, false); auto r1_ = __builtin_amdgcn_permlane32_swap(a1_, b1_, false, false); \
    u32x4 w_ = {r0_[0], r1_[0], r0_[1], r1_[1]}; OUT = *reinterpret_cast<bf16x8*>(&w_); } while (0)
#define A5_PV(vlA, vhA, vlB, vhB) do { pv_mma(o[0], vlA, vhA, pa0, pa1, pa2, pa3); pv_mma(o[1], vlB, vhB, pa0, pa1, pa2, pa3); \
    if constexpr (MSUM) { osum = __builtin_amdgcn_mfma_f32_32x32x16_bf16(pa0, ones, osum, 0, 0, 0); osum = __builtin_amdgcn_mfma_f32_32x32x16_bf16(pa1, ones, osum, 0, 0, 0); \
                           osum = __builtin_amdgcn_mfma_f32_32x32x16_bf16(pa2, ones, osum, 0, 0, 0); osum = __builtin_amdgcn_mfma_f32_32x32x16_bf16(pa3, ones, osum, 0, 0, 0); } } while (0)
#define A5_QK(PN0, PN1, x) do { const char* kb_ = K_lds + ((x) & 1) * SHM_K + r32 * KROW + hi * 16; \
    if constexpr (NOMAX && !ZC) { PN0 = __builtin_amdgcn_mfma_f32_32x32x16_bf16(*reinterpret_cast<const bf16x8*>(kb_), qr[0], negt, 0, 0, 0); \
    PN1 = __builtin_amdgcn_mfma_f32_32x32x16_bf16(*reinterpret_cast<const bf16x8*>(kb_ + 32 * KROW), qr[0], negt, 0, 0, 0); } \
    else { PN0 = __builtin_amdgcn_mfma_f32_32x32x16_bf16(*reinterpret_cast<const bf16x8*>(kb_), qr[0], f32x16{}, 0, 0, 0); \
    PN1 = __builtin_amdgcn_mfma_f32_32x32x16_bf16(*reinterpret_cast<const bf16x8*>(kb_ + 32 * KROW), qr[0], f32x16{}, 0, 0, 0); } \
    _Pragma("unroll") for (int d0 = 1; d0 < ND0; ++d0) { \
      PN0 = __builtin_amdgcn_mfma_f32_32x32x16_bf16(*reinterpret_cast<const bf16x8*>(kb_ + d0 * 32), qr[d0], PN0, 0, 0, 0); \
      PN1 = __builtin_amdgcn_mfma_f32_32x32x16_bf16(*reinterpret_cast<const bf16x8*>(kb_ + d0 * 32 + 32 * KROW), qr[d0], PN1, 0, 0, 0); } } while (0)
#define A5_OSUM() do { if constexpr (MSUM) { osum = __builtin_amdgcn_mfma_f32_32x32x16_bf16(pa0, ones, osum, 0, 0, 0); osum = __builtin_amdgcn_mfma_f32_32x32x16_bf16(pa1, ones, osum, 0, 0, 0); \
    osum = __builtin_amdgcn_mfma_f32_32x32x16_bf16(pa2, ones, osum, 0, 0, 0); osum = __builtin_amdgcn_mfma_f32_32x32x16_bf16(pa3, ones, osum, 0, 0, 0); } } while (0)
#define A5_MF(a, b, c) __builtin_amdgcn_mfma_f32_32x32x16_bf16(a, b, c, 0, 0, 0)
#define A5_VPK(L, H) (bf16x8){L[0], L[1], L[2], L[3], H[0], H[1], H[2], H[3]}
#define A5_EX2(P, i) do { P[i] = __builtin_amdgcn_exp2f(P[i]); P[(i) + 1] = __builtin_amdgcn_exp2f(P[(i) + 1]); if constexpr (!MSUM) { lac0 += P[i]; lac1 += P[(i) + 1]; } } while (0)
#define A5_V(g, PC0, PC1) do { constexpr int k_ = (g) - ((NOMAX && ND0 <= 4) ? 1 : 5); \
    if constexpr (k_ >= 0 && k_ < 8) A5_EX2(PC0, 2 * k_); else if constexpr (k_ >= 8 && k_ < 16) A5_EX2(PC1, 2 * (k_ - 8)); \
    else if constexpr (k_ == 16) A5_PK4(PC0, 0, pa0); else if constexpr (k_ == 17) A5_PK4(PC0, 8, pa1); else if constexpr (k_ == 18) A5_PK4(PC1, 0, pa2); else if constexpr (k_ == 19) A5_PK4(PC1, 8, pa3); } while (0)
#define A5_MAX8(P, b) fmaxf(fmaxf(fmaxf(P[b], P[b + 1]), fmaxf(P[b + 2], P[b + 3])), fmaxf(fmaxf(P[b + 4], P[b + 5]), fmaxf(P[b + 6], P[b + 7])))
#define A5_VB(i) do { constexpr int KS_ = 2 * NCG * 512; vlB_[i] = tr_read<512 + (i) * KS_>(vp_); vhB_[i] = tr_read<512 + (i) * KS_ + NCG * 512>(vp_); } while (0)
#define A5_VA(i) do { constexpr int KS_ = 2 * NCG * 512; vlA_[i] = tr_read<(i) * KS_>(vp_); vhA_[i] = tr_read<(i) * KS_ + NCG * 512>(vp_); } while (0)
#define A5_KG(g, QK_) do { constexpr int j_ = (g) - (13 - KAH); if constexpr (j_ >= 0 && j_ < 2 * ND0) { if (QK_) kf_[j_] = lds_read128<(j_ >> 1) * 32 + (j_ & 1) * 32 * KROW>(ka_); } } while (0)
#define A5_QKM(j, PN0, PN1) do { constexpr int w_ = (KAH - 1) < (2 * ND0 - 1 - (j)) ? (KAH - 1) : (2 * ND0 - 1 - (j)); lgkm_wait<w_>(); \
    if constexpr ((j) == 0) { if constexpr (NOMAX && !ZC) PN0 = A5_MF(kf_[0], qr[0], negt); else PN0 = A5_MF(kf_[0], qr[0], f32x16{}); } else if constexpr ((j) == 1) { if constexpr (NOMAX && !ZC) PN1 = A5_MF(kf_[1], qr[0], negt); else PN1 = A5_MF(kf_[1], qr[0], f32x16{}); } \
    else if constexpr (((j) & 1) == 0) PN0 = A5_MF(kf_[j], qr[(j) >> 1], PN0); else PN1 = A5_MF(kf_[j], qr[(j) >> 1], PN1); } while (0)
#define A5_QG(g, PC0, PC1, PN0, PN1, QK_) do { if (QK_) A5_QKM((g) - 13, PN0, PN1); A5_KG(g, QK_); A5_V(g, PC0, PC1); ASBAR(); } while (0)
#define A5_CHECK(P0, P1) do { float pmax_ = fmaxf(fmaxf(A5_MAX8(P0, 0), A5_MAX8(P0, 8)), fmaxf(A5_MAX8(P1, 0), A5_MAX8(P1, 8))); \
      { auto rr_ = __builtin_amdgcn_permlane32_swap(__float_as_uint(pmax_), __float_as_uint(pmax_), false, false); pmax_ = fmaxf(__uint_as_float(rr_[0]), __uint_as_float(rr_[1])); } \
      if (__builtin_expect(__all(pmax_ <= THR2), 1)) alpha = 1.f; \
      else { const float dl_ = fmaxf(pmax_, 0.f); m_run += dl_; alpha = __builtin_amdgcn_exp2f(-dl_); \
        _Pragma("unroll") for (int r_ = 0; r_ < 16; ++r_) { P0[r_] -= dl_; P1[r_] -= dl_; negt[r_] = -m_run; } } } while (0)
#define A5_ITER(t_, S, PC0, PC1, PN0, PN1, PV_, QK_) do { \
    __syncthreads(); \
    s16x4 vlA_[4], vhA_[4], vlB_[4], vhB_[4]; bf16x8 kf_[2 * ND0]; float pm0_ = 0.f, pm1_ = 0.f, pm2_ = 0.f, pm3_ = 0.f; \
    const int vp_ = vb0 + (((t_) - 1) & 1) * SHM_V, ka_ = ka0 + (((t_) + 1) & 1) * SHM_K; \
    if (PV_) { A5_VA(0); A5_VA(1); A5_VA(2); A5_VA(3); } \
    if constexpr (!NOMAX) { if (anym) { _Pragma("unroll") for (int r_ = 0; r_ < 16; ++r_) { PC0[r_] -= m_run; PC1[r_] -= m_run; } } } \
    A5_KWRITE(S, (t_) + 2); A5_VWRITE(S, (t_)); A5_KLOAD(S, (t_) + 2 + NS); A5_VLOAD(S, (t_) + NS); ASBAR(); \
    if (PV_) { if constexpr (MSUM) osum = A5_MF(pa0, ones, osum); A5_VB(0); } if constexpr (NOMAX) A5_V(1, PC0, PC1); else pm0_ = A5_MAX8(PC0, 0); ASBAR(); \
    if (PV_) { if constexpr (MSUM) osum = A5_MF(pa1, ones, osum); A5_VB(1); } if constexpr (NOMAX) A5_V(2, PC0, PC1); else pm1_ = A5_MAX8(PC0, 8); ASBAR(); \
    if (PV_) { if constexpr (MSUM) osum = A5_MF(pa2, ones, osum); A5_VB(2); } if constexpr (NOMAX) A5_V(3, PC0, PC1); else pm2_ = A5_MAX8(PC1, 0); ASBAR(); \
    if (PV_) { if constexpr (MSUM) osum = A5_MF(pa3, ones, osum); A5_VB(3); } if constexpr (NOMAX) A5_V(4, PC0, PC1); else pm3_ = A5_MAX8(PC1, 8); ASBAR(); \
    if constexpr (!NOMAX) { float pmax_ = fmaxf(fmaxf(pm0_, pm1_), fmaxf(pm2_, pm3_)); \
      { auto rr_ = __builtin_amdgcn_permlane32_swap(__float_as_uint(pmax_), __float_as_uint(pmax_), false, false); pmax_ = fmaxf(__uint_as_float(rr_[0]), __uint_as_float(rr_[1])); } \
      if (__builtin_expect(__all(pmax_ <= THR2), 1)) alpha = 1.f; \
      else { const float dl_ = fmaxf(pmax_, 0.f); m_run += dl_; alpha = __builtin_amdgcn_exp2f(-dl_); \
        anym = true; _Pragma("unroll") for (int r_ = 0; r_ < 16; ++r_) { PC0[r_] -= dl_; PC1[r_] -= dl_; } } ASBAR(); } \
    lgkm_wait<8>(); \
    if (PV_) o[0] = A5_MF(pa0, A5_VPK(vlA_[0], vhA_[0]), o[0]); A5_KG(5, QK_); A5_V(5, PC0, PC1); ASBAR(); \
    if (PV_) o[0] = A5_MF(pa1, A5_VPK(vlA_[1], vhA_[1]), o[0]); A5_KG(6, QK_); A5_V(6, PC0, PC1); ASBAR(); \
    if (PV_) o[0] = A5_MF(pa2, A5_VPK(vlA_[2], vhA_[2]), o[0]); A5_KG(7, QK_); A5_V(7, PC0, PC1); ASBAR(); \
    if (PV_) o[0] = A5_MF(pa3, A5_VPK(vlA_[3], vhA_[3]), o[0]); A5_KG(8, QK_); A5_V(8, PC0, PC1); ASBAR(); \
    if (QK_) lgkm_wait<(KAH > 4 ? KAH - 4 : 0)>(); else lgkm_wait<0>(); \
    if (PV_) o[1] = A5_MF(pa0, A5_VPK(vlB_[0], vhB_[0]), o[1]); A5_KG(9, QK_); A5_V(9, PC0, PC1); ASBAR(); \
    if (PV_) o[1] = A5_MF(pa1, A5_VPK(vlB_[1], vhB_[1]), o[1]); A5_KG(10, QK_); A5_V(10, PC0, PC1); ASBAR(); \
    if (PV_) o[1] = A5_MF(pa2, A5_VPK(vlB_[2], vhB_[2]), o[1]); A5_KG(11, QK_); A5_V(11, PC0, PC1); ASBAR(); \
    if (PV_) o[1] = A5_MF(pa3, A5_VPK(vlB_[3], vhB_[3]), o[1]); A5_KG(12, QK_); A5_V(12, PC0, PC1); ASBAR(); \
    A5_QG(13, PC0, PC1, PN0, PN1, QK_); A5_QG(14, PC0, PC1, PN0, PN1, QK_); A5_QG(15, PC0, PC1, PN0, PN1, QK_); A5_QG(16, PC0, PC1, PN0, PN1, QK_); \
    A5_QG(17, PC0, PC1, PN0, PN1, QK_); A5_QG(18, PC0, PC1, PN0, PN1, QK_); A5_QG(19, PC0, PC1, PN0, PN1, QK_); A5_QG(20, PC0, PC1, PN0, PN1, QK_); \
    if constexpr (ND0 > 4) { A5_QG(21, PC0, PC1, PN0, PN1, QK_); A5_QG(22, PC0, PC1, PN0, PN1, QK_); A5_QG(23, PC0, PC1, PN0, PN1, QK_); A5_QG(24, PC0, PC1, PN0, PN1, QK_); } \
    if constexpr (!NOMAX) { if (__any(alpha < 1.f)) { if (hi == 0) al_l[r32] = alpha; asm volatile("s_waitcnt lgkmcnt(0)" ::: "memory"); \
      _Pragma("unroll") for (int r_ = 0; r_ < 16; ++r_) { const float f_ = al_l[crow(r_, hi)]; o[0][r_] *= f_; o[1][r_] *= f_; if constexpr (MSUM) osum[r_] *= f_; } if constexpr (!MSUM) { lac0 *= alpha; lac1 *= alpha; } } \
      } \
  } while (0)
  A5_KLOAD(0, 0); A5_KLOAD(1, 1); A5_KWRITE(0, 0); A5_KWRITE(1, 1);
  A5_KLOAD(0, 2); A5_VLOAD(0, 0); A5_KLOAD(1, 3); A5_VLOAD(1, 1);
  if constexpr (NS == 4) { A5_KLOAD(2, 4); A5_VLOAD(2, 2); A5_KLOAD(3, 5); A5_VLOAD(3, 3); }
  __syncthreads();
  f32x16 pA0, pA1, pB0, pB1; bf16x8 pa0, pa1, pa2, pa3; float alpha = 1.f;
  pa0 = bf16x8{}; pa1 = bf16x8{}; pa2 = bf16x8{}; pa3 = bf16x8{};
  A5_QK(pA0, pA1, 0);
  A5_ITER(0, 0, pA0, pA1, pB0, pB1, 0, 1);
  if constexpr (NS == 2) {
    for (int t = 1; t + 1 < NT; t += 2) {
      A5_ITER(t, 1, pB0, pB1, pA0, pA1,  1, 1);
      A5_ITER(t + 1, 0, pA0, pA1, pB0, pB1,  1, 1);
    }
    A5_ITER(NT - 1, 1, pB0, pB1, pA0, pA1,  1, 0);
  } else {
    for (int t = 1; t + 3 < NT; t += 4) {
      A5_ITER(t, 1, pB0, pB1, pA0, pA1,  1, 1);
      A5_ITER(t + 1, 2, pA0, pA1, pB0, pB1,  1, 1);
      A5_ITER(t + 2, 3, pB0, pB1, pA0, pA1,  1, 1);
      A5_ITER(t + 3, 0, pA0, pA1, pB0, pB1,  1, 1);
    }
    A5_ITER(NT - 3, 1, pB0, pB1, pA0, pA1,  1, 1);
    A5_ITER(NT - 2, 2, pA0, pA1, pB0, pB1,  1, 1);
    A5_ITER(NT - 1, 3, pB0, pB1, pA0, pA1,  1, 0);
  }
  __syncthreads();
  { s16x4 vlA_[4], vhA_[4], vlB_[4], vhB_[4]; const int vp_ = vb0 + ((NT - 1) & 1) * SHM_V;
    A5_VA(0); A5_VA(1); A5_VA(2); A5_VA(3); A5_VB(0); A5_VB(1); A5_VB(2); A5_VB(3); lgkm_wait<0>();
    A5_OSUM(); pv_mma(o[0], vlA_, vhA_, pa0, pa1, pa2, pa3); pv_mma(o[1], vlB_, vhB_, pa0, pa1, pa2, pa3); }
  if constexpr (MSUM) { if (r32 == 0) {
#pragma unroll
      for (int r = 0; r < 16; ++r) li_l[crow(r, hi)] = osum[r]; } }
  else { l_reg = pg8::half_sum(lac0 + lac1); if (hi == 0) li_l[r32] = l_reg; }
  asm volatile("s_waitcnt lgkmcnt(0)" ::: "memory");
  float rli[16];
#pragma unroll
  for (int r = 0; r < 16; ++r) rli[r] = __builtin_amdgcn_rcpf(li_l[crow(r, hi)]);
  bf16_t* Ow = Ob + (long)(wid * 32) * LDO;
#pragma unroll
  for (int r = 0; r < 16; ++r) { const int orow = crow(r, hi);
#pragma unroll
    for (int d0 = 0; d0 < 2; ++d0) stg[orow * 64 + d0 * 32 + r32] = (bf16_t)(cvtpk(o[d0][r] * rli[r], 0.f) & 0xffffu); }
  asm volatile("s_waitcnt lgkmcnt(0)" ::: "memory");
#pragma unroll
  for (int i = 0; i < 4; ++i) { const int idx = i * 64 + lane, row = idx >> 3, ch = idx & 7;
    *reinterpret_cast<u32x4*>(Ow + (long)row * LDO + ch * 8) = *reinterpret_cast<const u32x4*>(stg + row * 64 + ch * 8); }
  __syncthreads();
#undef A5_KLOAD
#undef A5_VLOAD
#undef A5_KWRITE
#undef A5_VWRITE
#undef A5_QK
#undef A5_KREADS
#undef A5_SGB
#undef A5_PK4
#undef A5_PV
#undef A5_OSUM
#undef A5_ITER
#undef A5_MF
#undef A5_VPK
#undef A5_EX2
#undef A5_V
#undef A5_MAX8
#undef A5_CHECK
#undef A5_VB
#undef A5_VA
#undef A5_KR
#undef A5_QKM
#undef A5_KG
#undef A5_QG
}
#undef ASBAR
}

constexpr int NWAVES = 8;
constexpr int NPHASE = 11;
#ifndef MK_BARMASK
#define MK_BARMASK 0x3ff
#endif
#ifndef MK_LAUNCHES
#define MK_LAUNCHES {{0, 11, 7}}
#endif
struct LaunchSpec { int lo, hi, amask; };
constexpr LaunchSpec LAUNCHES[] = MK_LAUNCHES;
constexpr int N_LAUNCHES = (int)(sizeof(LAUNCHES) / sizeof(LaunchSpec));

constexpr size_t MiB = 1u << 20;
constexpr size_t WS_CTL = 0, CTL_ZERO_BYTES = 1 * MiB;
constexpr size_t WS_STATS0 = 1 * MiB, WS_STATS1 = WS_STATS0 + 256 * 1024, WS_ROPEA = WS_STATS1 + 256 * 1024, WS_ROPEB = WS_ROPEA + 8192;
constexpr size_t WS_SSQ = 2 * MiB, WS_TOKER = 4 * MiB, WS_RTOK = 5 * MiB, WS_RW = 10 * MiB;
constexpr size_t WS_WIN = 16 * MiB, WS_WQB = 26 * MiB, WS_WKVB = 27 * MiB, WS_WMEM = 28 * MiB, WS_WBR = 30 * MiB, WS_WOUT = 33 * MiB;
constexpr size_t WS_MEMB = 36 * MiB, WS_MKV = 40 * MiB, WS_W1 = 44 * MiB, WS_W2 = 172 * MiB;
constexpr size_t WS_H0 = 236 * MiB, WS_H1 = WS_H0;
constexpr size_t WS_QA = 300 * MiB, WS_OB = 332 * MiB, WS_QM = 364 * MiB, WS_KA = 396 * MiB, WS_VA = 404 * MiB, WS_QLAT = 412 * MiB, WS_KVLAT = 436 * MiB, WS_GATES = 452 * MiB;
constexpr size_t WS_QB = 644 * MiB, WS_KB = 692 * MiB, WS_VB = 740 * MiB, WS_MERGED = 772 * MiB;
constexpr size_t WS_XS = 300 * MiB, WS_ACT = 572 * MiB, WS_YS = WS_XS, WS_H1B = 444 * MiB, WS_MIX = 940 * MiB,     WS_END = 1004 * MiB;
#ifdef MK_INPLACE_O
constexpr size_t WS_OA = WS_QA, WS_OB2 = WS_OB, WS_OC = WS_QM;
#else
constexpr size_t WS_OA = 844 * MiB, WS_OB2 = 876 * MiB, WS_OC = 908 * MiB;
#endif
static_assert(WS_RTOK + (size_t)(NEXP * NTOK + 256) * 4 <= WS_RW && WS_RW + (size_t)(NEXP * NTOK + 256) * 4 <= WS_WIN, "routing arrays");
static_assert(WS_XS + (size_t)MAXTILES * 256 * 2048 <= WS_ACT && WS_ACT + (size_t)MAXTILES * 256 * 2048 <= WS_END, "moe slabs");
constexpr int CW_QMX = 80000, CW_KMX = 80512, CW_KRX = 81024;
constexpr int CW_TMO = 0, CW_BAR = 4096, CW_CNT = 65536;
constexpr int RING_OFF = 0, RING_BYTES = 131072;
constexpr int LDSCTL_OFF = RING_BYTES, MISC_OFF = LDSCTL_OFF + 320;
constexpr int L_TS = LDSCTL_OFF + 512, L_CNT = LDSCTL_OFF + 704, L_TE = LDSCTL_OFF + 1024, L_HIST = LDSCTL_OFF + 4096, L_BASE = LDSCTL_OFF + 4224, L_ASGE = LDSCTL_OFF + 4608, L_ASGW = LDSCTL_OFF + 6656;
constexpr int LDS_BYTES = 147456;
static_assert(att::Cfg<128, 128>::LDS2 <= RING_BYTES && att::Cfg<96, 64>::LDS2 <= RING_BYTES, "attention LDS");

static_assert((long)WS_CTL - (long)WS_SSQ == SSQ_TO_CTL && CW_QMX == CW_QMX_ && CW_KMX == CW_KMX_ && CW_KRX == CW_KRX_ && (CW_KRX + 16) * 4 <= (int)CTL_ZERO_BYTES, "score-bound slots: workspace distances used by the epilogues");
typedef GAS unsigned gu32;
#define RLX_AGENT __ATOMIC_RELAXED, __HIP_MEMORY_SCOPE_AGENT
#define LDS_WAIT() asm volatile("s_waitcnt lgkmcnt(0)" ::: "memory")
#define VM_WAIT() asm volatile("s_waitcnt vmcnt(0)" ::: "memory")

#define XB_TMO      128
#define XB_XCNT(j)  (256  + 64 * (j))
#define XB_XSUB(j)  (1280 + 64 * (j))
#define XB_XGEN(j)  (2304 + 64 * (j))
#define XB_TOP      3328
#define XB_TOPGEN   3392
#define XCD_BAR_WORDS 3456
#define XB_SPIN_CAP (1u << 18)
__device__ __forceinline__ unsigned xb_ld(unsigned* p)              { return __hip_atomic_load(p, __ATOMIC_RELAXED, __HIP_MEMORY_SCOPE_AGENT); }
__device__ __forceinline__ unsigned xb_add(unsigned* p, unsigned v) { return __hip_atomic_fetch_add(p, v, __ATOMIC_RELAXED, __HIP_MEMORY_SCOPE_AGENT); }
__device__ __forceinline__ unsigned xb_xcc_id() { return (unsigned)__builtin_amdgcn_s_getreg((3 << 11) | 20) & 0xFu; }
#define XB_SPIN(cond, bar) do { unsigned _sp = 0; while (cond) { __builtin_amdgcn_s_sleep(1); \
    if ((++_sp & 255u) == 0u) { if (xb_ld(&(bar)[XB_TMO])) break; if (_sp > XB_SPIN_CAP) { atomicAdd(&(bar)[XB_TMO], 1u); break; } } } } while (0)
struct XcdBarrier { unsigned* bar; unsigned x; volatile LAS unsigned* st; };
__device__ __forceinline__ XcdBarrier xcd_barrier_post(unsigned* bar, volatile LAS unsigned* st, const int wave_id) {
    XcdBarrier b; b.bar = bar; b.x = xb_xcc_id(); b.st = st;
    if (wave_id == 0 && pg8::lane_now() == 0) (void)xb_add(&bar[XB_XCNT(b.x)], 1u);
    return b;
}
__device__ __forceinline__ void xcd_barrier_complete(unsigned* bar, unsigned x, unsigned& nloc, unsigned& nx) {
    const unsigned G = gridDim.x * gridDim.y * gridDim.z;
    unsigned sum, cnt, mine, sp = 0u;
    for (;;) {
        sum = 0u; cnt = 0u; mine = 0u;
#pragma unroll
        for (unsigned j = 0; j < 16; ++j) { const unsigned c = xb_ld(&bar[XB_XCNT(j)]); sum += c; cnt += (c > 0u) ? 1u : 0u; mine = (j == x) ? c : mine; }
        if (sum == G) break;
        __builtin_amdgcn_s_sleep(1);
        if ((++sp & 255u) == 0u) { if (xb_ld(&bar[XB_TMO])) break; if (sp > XB_SPIN_CAP) { atomicAdd(&bar[XB_TMO], 1u); break; } }
    }
    nloc = mine > 0u ? mine : 1u; nx = cnt > 0u ? cnt : 1u;
}
__device__ __forceinline__ void xcd_barrier(const XcdBarrier& b, const int wave_id) {
    asm volatile("s_waitcnt vmcnt(0)" ::: "memory");
    __syncthreads();
    if (wave_id == 0 && pg8::lane_now() == 0) {
        unsigned* bar = b.bar;
        __builtin_amdgcn_s_waitcnt(0);
#if defined(XB_EXP_RELALL)
        __builtin_amdgcn_fence(__ATOMIC_RELEASE, "agent"); asm volatile("s_waitcnt vmcnt(0)" ::: "memory");
#endif
        unsigned nloc = b.st[0], nx = b.st[1];
        if (nloc == 0u) { xcd_barrier_complete(bar, b.x, nloc, nx); b.st[0] = nloc; b.st[1] = nx; }
        const unsigned old = xb_add(&bar[XB_XSUB(b.x)], 1u);
        const unsigned gen = old / nloc;
        if (old + 1u == (gen + 1u) * nloc) {
            __builtin_amdgcn_fence(__ATOMIC_RELEASE, "agent");
            asm volatile("s_waitcnt vmcnt(0)" ::: "memory");
            const unsigned og = xb_add(&bar[XB_TOP], 1u);
            const unsigned tg = og / nx;
            if (og + 1u == (tg + 1u) * nx) xb_add(&bar[XB_TOPGEN], 1u);
            else XB_SPIN(xb_ld(&bar[XB_TOPGEN]) == tg, bar);
            __builtin_amdgcn_fence(__ATOMIC_ACQUIRE, "agent");
            xb_add(&bar[XB_XGEN(b.x)], 1u);
            asm volatile("s_waitcnt vmcnt(0)" ::: "memory");
        } else {
            XB_SPIN(xb_ld(&bar[XB_XGEN(b.x)]) == gen, bar);
            __builtin_amdgcn_fence(__ATOMIC_ACQUIRE, "agent");
            asm volatile("s_waitcnt vmcnt(0)" ::: "memory");
        }
    }
    __syncthreads();
#if defined(XB_EXP_DELAY)
    { const unsigned long long t0 = __builtin_amdgcn_s_memrealtime(); while (__builtin_amdgcn_s_memrealtime() - t0 < 3000ull) __builtin_amdgcn_s_sleep(8); }
#endif
#if defined(XB_EXP_ACQALL)
    __builtin_amdgcn_fence(__ATOMIC_ACQUIRE, "agent"); asm volatile("s_waitcnt vmcnt(0)" ::: "memory"); __syncthreads();
#endif
}

struct Frame {
    LAS unsigned char* lds;
    volatile LAS unsigned* MISC;
    int wave, G;
};
__device__ __forceinline__ int tid_now(const Frame& F) { int l = pg8::lane_now(); asm volatile("" : "+v"(l)); return F.wave * 64 + l; }
struct Args { const float* in[27]; float* out; unsigned char* ws; int ph_lo, ph_hi, li, amask; };
#define CAS __attribute__((address_space(4)))
struct KA { const CAS char* p;
    __device__ __forceinline__ const float* in(int i) const { return *(const float* const CAS*)(p + 8 * i); }
    __device__ __forceinline__ float* out() const { return *(float* const CAS*)(p + 216); }
    __device__ __forceinline__ unsigned char* ws() const { return *(unsigned char* const CAS*)(p + 224); }
    __device__ __forceinline__ gu32* ctl() const { return (gu32*)(ws() + WS_CTL); }
};
static_assert(offsetof(Args, out) == 216 && offsetof(Args, ws) == 224 && offsetof(Args, ph_lo) == 232, "Args layout");
__device__ __forceinline__ KA kargs() { KA k; k.p = (const CAS char*)__builtin_amdgcn_kernarg_segment_ptr(); asm volatile("" : "+s"(k.p)); return k; }
template <class T> __device__ __forceinline__ T* wsp(const KA& ka, size_t off) { return (T*)(ka.ws() + off); }
template <int CTRL> __device__ __forceinline__ float dpp_f(float v) { return __uint_as_float((unsigned)__builtin_amdgcn_update_dpp(0, (int)__float_as_uint(v), CTRL, 0xf, 0xf, true)); }
__device__ __forceinline__ float wave_sum(float v) { v += dpp_f<0xB1>(v); v += dpp_f<0x4E>(v); v += dpp_f<0x141>(v); v += dpp_f<0x140>(v);
    { const auto r = __builtin_amdgcn_permlane16_swap(__float_as_uint(v), __float_as_uint(v), false, false); v = __uint_as_float(r[0]) + __uint_as_float(r[1]); } return pg8::half_sum(v); }
__device__ __forceinline__ float wave_max(float v) { v = fmaxf(v, dpp_f<0xB1>(v)); v = fmaxf(v, dpp_f<0x4E>(v)); v = fmaxf(v, dpp_f<0x141>(v)); v = fmaxf(v, dpp_f<0x140>(v));
    { const auto r = __builtin_amdgcn_permlane16_swap(__float_as_uint(v), __float_as_uint(v), false, false); v = fmaxf(__uint_as_float(r[0]), __uint_as_float(r[1])); } return pg8::half_max(v); }
__device__ __forceinline__ f32x4 bf4_to_f32(u32x2 w) { f32x4 g; g[0] = __uint_as_float(w.x << 16); g[1] = __uint_as_float(w.x & 0xffff0000u); g[2] = __uint_as_float(w.y << 16); g[3] = __uint_as_float(w.y & 0xffff0000u); return g; }

struct MapId { __device__ __forceinline__ int operator()(int n) const { return n; } };
__device__ __forceinline__ int rot16(int d32) { const int np = (d32 >> 4) & 1, i = d32 & 15; return 8 * (i >> 2) + 4 * np + (i & 3); }
__device__ __forceinline__ int rot8(int d32) { const int a = d32 >> 4, np = (d32 >> 3) & 1, i = d32 & 7; return 16 * a + 8 * (i >> 2) + 4 * np + (i & 3); }
struct MapInProj { __device__ __forceinline__ int operator()(int n) const {
    if (n < 512) { const int h = n >> 6, d = n & 63; return 256 * (h >> 2) + 128 * (d >> 5) + 32 * (h & 3) + rot16(d & 31); }
    if (n < 768) { const int g = (n - 512) >> 6, d = n & 63; return 512 + 128 * (d >> 5) + 32 * g + rot16(d & 31); }
    if (n < 1152) { const int i = n - 768; return i < 256 ? 768 + i : 1024 + (i - 256); }
    if (n < 1408) return 1280 + (n - 1152);
    if (n < 1440) return 1024 + 128 + rot8(n - 1408);
    if (n < 1952) return 1536 + (n - 1440);
    return 2048 + (n - 1952); } };
struct MapQb { __device__ __forceinline__ int operator()(int c) const { const int h = c / 96, r = c - 96 * h;
    if (r < 64) return 256 * (h >> 2) + 64 * (h & 3) + r;
    return 512 + 128 * (h >> 2) + 32 * (h & 3) + rot8(r - 64); } };
struct MapW2 { __device__ __forceinline__ int operator()(int n) const { const int c = n & 255; return (n & ~255) + 128 * ((c >> 3) & 1) + 32 * (c >> 6) + 8 * ((c >> 4) & 3) + (c & 7); } };
struct MapGlu { __device__ __forceinline__ int operator()(int n) const { return n < 1024 ? 256 * (n >> 7) + (n & 127) : 256 * ((n - 1024) >> 7) + 128 + (n & 127); } };

template <class Map> __device__ __forceinline__ void transpose_item(const float* W, int K, int N, bf16_t* WT, const float* kscale, LAS float* scr, int item, int lane, Map map) {
    const int nblk = N / 32, kb = item / nblk, nb = item - kb * nblk, k0 = 64 * kb, n0 = 32 * nb;
#pragma unroll
    for (int i = 0; i < 8; ++i) { const int kk = 8 * i + (lane >> 3), nq = 4 * (lane & 7); f32x4 v = *(const f32x4*)(W + (size_t)(k0 + kk) * N + n0 + nq); if (kscale) v = v * kscale[k0 + kk];
        LAS float* d = scr + kk * 33 + nq; d[0] = v[0]; d[1] = v[1]; d[2] = v[2]; d[3] = v[3]; }
    LDS_WAIT(); asm volatile("" ::: "memory");
    const int c = lane & 7;
#pragma unroll
    for (int j = 0; j < 4; ++j) { const int n = (lane >> 3) + 8 * j; const LAS float* s = scr + (8 * c) * 33 + n;
        u32x4 o; o.x = pg8::cvt_pk_bf16(s[0 * 33], s[1 * 33]); o.y = pg8::cvt_pk_bf16(s[2 * 33], s[3 * 33]); o.z = pg8::cvt_pk_bf16(s[4 * 33], s[5 * 33]); o.w = pg8::cvt_pk_bf16(s[6 * 33], s[7 * 33]);
        *(u32x4*)(WT + (size_t)map(n0 + n) * K + k0 + 8 * c) = o; }
    LDS_WAIT(); asm volatile("" ::: "memory");
}

template <class Map> __device__ __forceinline__ void transpose_item_f8(const float* W, int K, int N, unsigned char* WT, float scale, LAS float* scr, int item, int lane, Map map) {
    const int nblk = N / 32, kb = item / nblk, nb = item - kb * nblk, k0 = 64 * kb, n0 = 32 * nb;
#pragma unroll
    for (int i = 0; i < 8; ++i) { const int kk = 8 * i + (lane >> 3), nq = 4 * (lane & 7); const f32x4 v = *(const f32x4*)(W + (size_t)(k0 + kk) * N + n0 + nq) * scale;
        LAS float* d = scr + kk * 33 + nq; d[0] = v[0]; d[1] = v[1]; d[2] = v[2]; d[3] = v[3]; }
    LDS_WAIT(); asm volatile("" ::: "memory");
#pragma unroll
    for (int h = 0; h < 2; ++h) { const int idx = lane + 64 * h, n = idx >> 2, c = idx & 3; const LAS float* s = scr + (16 * c) * 33 + n;
        u32x4 o; o.x = pk4_f8(s[0 * 33], s[1 * 33], s[2 * 33], s[3 * 33]); o.y = pk4_f8(s[4 * 33], s[5 * 33], s[6 * 33], s[7 * 33]);
        o.z = pk4_f8(s[8 * 33], s[9 * 33], s[10 * 33], s[11 * 33]); o.w = pk4_f8(s[12 * 33], s[13 * 33], s[14 * 33], s[15 * 33]);
        *(u32x4*)(WT + (size_t)map(n0 + n) * K + k0 + 16 * c) = o; }
    LDS_WAIT(); asm volatile("" ::: "memory");
}
__device__ __forceinline__ void p0_prologue(Frame& F, const KA& ka) {
    LAS float* scr = (LAS float*)(F.lds + RING_OFF + F.wave * 16384);
    const int tid = tid_now(F), lane = tid & 63;
    const int gw = blockIdx.x * NWAVES + F.wave, NGW = F.G * NWAVES;
    constexpr int I_IN = 16 * 157, I_QB = 6 * 24, I_KVB = 4 * 32, I_MEM = 16 * 32, I_BR = 8 * 32, I_OUT = 16 * 32, I_W1 = 16 * 64, I_W2 = 16 * 32;
    constexpr int NITEMS = I_IN + I_QB + I_KVB + I_MEM + 3 * I_BR + I_OUT + NEXP * I_W1 + NEXP * I_W2;
#ifdef MK_P0PROBE
    const unsigned long long p0t0_ = __builtin_amdgcn_s_memrealtime();
#endif
    for (int it = gw; it < NITEMS; it += NGW) {
        int r = it;
        if (r < NEXP * I_W1) { const int e = r / I_W1; transpose_item_f8(ka.in(21) + (size_t)e * 1024 * 2048, 1024, 2048, wsp<unsigned char>(ka, WS_W1) + (size_t)e * 2048 * 1024, F8_WSCALE, scr, r - e * I_W1, lane, MapGlu()); continue; } r -= NEXP * I_W1;
        if (r < NEXP * I_W2) { const int e = r / I_W2; transpose_item_f8(ka.in(23) + (size_t)e * 1024 * 1024, 1024, 1024, wsp<unsigned char>(ka, WS_W2) + (size_t)e * 1024 * 1024, F8_WSCALE, scr, r - e * I_W2, lane, MapW2()); continue; } r -= NEXP * I_W2;
        if (r < I_IN) { transpose_item(ka.in(4), 1024, IN_PROJ_W, wsp<bf16_t>(ka, WS_WIN), nullptr, scr, r, lane, MapInProj()); continue; } r -= I_IN;
        if (r < I_QB) { transpose_item(ka.in(10), QLAT, 768, wsp<bf16_t>(ka, WS_WQB), ka.in(8), scr, r, lane, MapQb()); continue; } r -= I_QB;
        if (r < I_KVB) { transpose_item(ka.in(11), KVLAT, 1024, wsp<bf16_t>(ka, WS_WKVB), ka.in(9), scr, r, lane, MapId()); continue; } r -= I_KVB;
        if (r < I_MEM) { transpose_item(ka.in(12), 1024, 1024, wsp<bf16_t>(ka, WS_WMEM), nullptr, scr, r, lane, MapId()); continue; } r -= I_MEM;
        if (r < I_BR) { transpose_item(ka.in(13), 512, 1024, wsp<bf16_t>(ka, WS_WBR), nullptr, scr, r, lane, MapId()); continue; } r -= I_BR;
        if (r < I_BR) { transpose_item(ka.in(14), 512, 1024, wsp<bf16_t>(ka, WS_WBR) + (size_t)1024 * 512, nullptr, scr, r, lane, MapId()); continue; } r -= I_BR;
        if (r < I_BR) { transpose_item(ka.in(15), 512, 1024, wsp<bf16_t>(ka, WS_WBR) + (size_t)2 * 1024 * 512, nullptr, scr, r, lane, MapId()); continue; } r -= I_BR;
        transpose_item(ka.in(16), 1024, 1024, wsp<bf16_t>(ka, WS_WOUT), nullptr, scr, r, lane, MapId());
    }
#ifdef MK_P0PROBE
    if (MK_P0PROBE == 1 && tid == 0) F.MISC[40] = (unsigned)(__builtin_amdgcn_s_memrealtime() - p0t0_);
#endif
    { bf16_t* wp = wsp<bf16_t>(ka, WS_WIN) + (size_t)1184 * 1024; const int gt = blockIdx.x * 512 + tid, NGT = F.G * 512;
      for (int i = gt; i < 96 * 1024 / 8; i += NGT) *(u32x4*)(wp + (size_t)i * 8) = (u32x4){0u, 0u, 0u, 0u}; }
    { const int gt = blockIdx.x * 512 + tid; float* ra = wsp<float>(ka, WS_ROPEA); float* rb = wsp<float>(ka, WS_ROPEB);
      if (gt < 1024) { const int pos = gt >> 4, i = gt & 15; const float inv = __builtin_amdgcn_exp2f(-(float)i * (13.287712379549449f / 16.0f)); float rev = (float)pos * inv * 0.15915494309189535f; rev -= floorf(rev);
          ra[gt] = __builtin_amdgcn_cosf(rev); ra[1024 + gt] = __builtin_amdgcn_sinf(rev); }
      else if (gt < 1536) { const int q = gt - 1024, pos = q >> 3, i = q & 7; const float inv = __builtin_amdgcn_exp2f(-(float)i * (13.287712379549449f / 8.0f)); float rev = (float)pos * inv * 0.15915494309189535f; rev -= floorf(rev);
          rb[q] = __builtin_amdgcn_cosf(rev); rb[512 + q] = __builtin_amdgcn_sinf(rev); } }
#ifdef MK_P0PROBE
    const unsigned long long p0t1_ = __builtin_amdgcn_s_memrealtime();
#endif
    { const float* x = ka.in(0); const f32x4* gp = (const f32x4*)ka.in(2) + lane; const f32x4* bp = (const f32x4*)ka.in(3) + lane; f32x4 gv[4], bv[4];
#pragma unroll
      for (int j = 0; j < 4; ++j) { gv[j] = gp[64 * j]; bv[j] = bp[64 * j]; }
      bf16_t* H0 = wsp<bf16_t>(ka, WS_H0); float* st0 = wsp<float>(ka, WS_STATS0);
      for (int m = gw; m < NTOK; m += 8 * NGW) {
          f32x4 v[8][4];
#pragma unroll
          for (int q = 0; q < 8; ++q) { const f32x4* xr = (const f32x4*)(x + (size_t)(m + q * NGW) * DM) + lane;
#pragma unroll
              for (int j = 0; j < 4; ++j) v[q][j] = xr[64 * j]; }
#pragma unroll
          for (int q = 0; q < 8; ++q) { const int mm = m + q * NGW; float s = 0.f;
#pragma unroll
              for (int j = 0; j < 4; ++j) s += (v[q][j][0] + v[q][j][1]) + (v[q][j][2] + v[q][j][3]);
              const float mean = wave_sum(s) * (1.f / DM); float s2 = 0.f;
#pragma unroll
              for (int j = 0; j < 4; ++j) { const f32x4 d = v[q][j] - mean; s2 += ssq4(d); }
              const float rstd = 1.f / sqrtf(wave_sum(s2) * (1.f / DM) + LN_EPS);
              if (lane == 0) *(f32x2*)(st0 + (size_t)mm * 2) = (f32x2){mean, rstd};
#pragma unroll
              for (int j = 0; j < 4; ++j) *(u32x2*)(H0 + (size_t)mm * DM + 4 * lane + 256 * j) = pack4((v[q][j] - mean) * rstd * gv[j] + bv[j]); }
      } }
#ifdef MK_P0PROBE
    if (MK_P0PROBE == 2 && tid == 0) F.MISC[40] = (unsigned)(__builtin_amdgcn_s_memrealtime() - p0t1_);
#endif
    { const float* mem = ka.in(1); bf16_t* mb = wsp<bf16_t>(ka, WS_MEMB); const int gt = blockIdx.x * 512 + tid, NGT = F.G * 512;
      for (int i = gt; i < NMEM * DM / 4; i += NGT) *(u32x2*)(mb + (size_t)i * 4) = pack4(*(const f32x4*)(mem + (size_t)i * 4)); }
}

struct Pre1Raw { f32x4 xv[4]; u32x2 mw[4]; f32x2 st; };
__device__ __forceinline__ void pre1_load(const float* x, const float* st0, const bf16_t* mix, int m, int lane, Pre1Raw& r) {
    r.st = *(const f32x2*)(st0 + (size_t)m * 2);
#pragma unroll
    for (int j = 0; j < 4; ++j) { r.xv[j] = ((const f32x4*)(x + (size_t)m * DM))[lane + 64 * j]; r.mw[j] = *(const u32x2*)(mix + (size_t)m * DM + 4 * lane + 256 * j); }
}
__device__ __forceinline__ void pre1_calc(const Pre1Raw& r, const f32x4 (&g0)[4], const f32x4 (&b0)[4], f32x4 (&v)[4]) {
#pragma unroll
    for (int j = 0; j < 4; ++j) v[j] = ((r.xv[j] - r.st.x) * r.st.y * g0[j] + b0[j]) * DN_ALPHA + bf4_to_f32(r.mw[j]);
}
__device__ __forceinline__ void pre1_row(const float* x, const float* st0, const bf16_t* mix, const f32x4 (&g0)[4], const f32x4 (&b0)[4], int m, int lane, f32x4 (&v)[4]) {
    Pre1Raw r; pre1_load(x, st0, mix, m, lane, r); pre1_calc(r, g0, b0, v);
}
__device__ __forceinline__ void moe_tables(Frame& F, const KA& ka) {
    LAS int* TS = (LAS int*)(F.lds + L_TS); LAS int* CNT = (LAS int*)(F.lds + L_CNT); LAS int* TE = (LAS int*)(F.lds + L_TE);
    const int tid = tid_now(F);
    if (tid < NEXP) { int c = (int)__hip_atomic_load(ka.ctl() + CW_CNT + 32 * tid, RLX_AGENT); c = c < 0 ? 0 : (c > NTOK ? NTOK : c); CNT[tid] = c; }
    __syncthreads();
    if (tid == 0) { int s = 0; for (int e = 0; e < NEXP; ++e) { TS[e] = s; s += (CNT[e] + 255) >> 8; } TS[NEXP] = s; }
    __syncthreads();
    const int T = TS[NEXP];
    for (int t = tid; t < T; t += NWAVES * 64) { int e = 0; while (e < NEXP - 1 && TS[e + 1] <= t) ++e; TE[t] = e; }
    __syncthreads();
}

__device__ __forceinline__ float treduce32(const float (&v)[32], int lane) {
    float u[16], w[8], x[4], y[2];
#pragma unroll
    for (int i = 0; i < 16; ++i) { const auto r = __builtin_amdgcn_permlane32_swap(__float_as_uint(v[i]), __float_as_uint(v[16 + i]), false, false); u[i] = __uint_as_float(r[0]) + __uint_as_float(r[1]); }
#pragma unroll
    for (int i = 0; i < 8; ++i) { const auto r = __builtin_amdgcn_permlane16_swap(__float_as_uint(u[i]), __float_as_uint(u[8 + i]), false, false); w[i] = __uint_as_float(r[0]) + __uint_as_float(r[1]); }
    const bool b3 = (lane & 8) != 0, b2 = (lane & 4) != 0, b1 = (lane & 2) != 0;
#pragma unroll
    for (int i = 0; i < 4; ++i) { const float send = b3 ? w[i] : w[4 + i], keep = b3 ? w[4 + i] : w[i]; x[i] = keep + pg8::swz_xor<8>(send); }
#pragma unroll
    for (int i = 0; i < 2; ++i) { const float send = b2 ? x[i] : x[2 + i], keep = b2 ? x[2 + i] : x[i]; y[i] = keep + pg8::swz_xor<4>(send); }
    const float send = b1 ? y[0] : y[1], keep = b1 ? y[1] : y[0]; float z = keep + pg8::swz_xor<2>(send);
    return z + pg8::swz_xor<1>(z);
}
__device__ __forceinline__ void split_bf16x8(const float (&x)[8], pg8::bf16x8& hi, pg8::bf16x8& lo) { u32x4 h, l;
#pragma unroll
    for (int i = 0; i < 4; ++i) { const unsigned hp = pg8::cvt_pk_bf16(x[2 * i], x[2 * i + 1]); h[i] = hp;
        const float r0 = x[2 * i] - __uint_as_float(hp << 16), r1 = x[2 * i + 1] - __uint_as_float(hp & 0xffff0000u); l[i] = pg8::cvt_pk_bf16(r0, r1); }
    hi = __builtin_bit_cast(pg8::bf16x8, h); lo = __builtin_bit_cast(pg8::bf16x8, l); }
__device__ __forceinline__ void p6_route(Frame& F, const KA& ka) {
    constexpr int HS = 1028;
    LAS float* HT = (LAS float*)(F.lds + RING_OFF); LAS float* PART = (LAS float*)(F.lds + RING_OFF + 16 * HS * 4);
    LAS int* hist = (LAS int*)(F.lds + L_HIST); LAS int* base = (LAS int*)(F.lds + L_BASE); LAS int* asg_e = (LAS int*)(F.lds + L_ASGE); LAS float* asg_w = (LAS float*)(F.lds + L_ASGW);
    const int tid = tid_now(F), lane = tid & 63, wv = F.wave;
    const float* xin = ka.in(0); const float* st0 = wsp<float>(ka, WS_STATS0); const bf16_t* mixp = wsp<bf16_t>(ka, WS_MIX); unsigned char* H1 = wsp<unsigned char>(ka, WS_H1);   float* st1 = wsp<float>(ka, WS_STATS1);
    int* rtok = wsp<int>(ka, WS_RTOK); float* rw = wsp<float>(ka, WS_RW); int* toker = wsp<int>(ka, WS_TOKER); bf16_t* H1b = wsp<bf16_t>(ka, WS_H1B);
    const float brt = ka.in(20)[lane >> 1];
    pg8::bf16x8 wBh[4][2], wBl[4][2];
    { const float* wr = ka.in(19) + (size_t)(128 * wv + 8 * (lane >> 4)) * NEXP + (lane & 15);
#pragma unroll
      for (int s_ = 0; s_ < 4; ++s_)
#pragma unroll
          for (int hf = 0; hf < 2; ++hf) { float w[8];
#pragma unroll
              for (int i = 0; i < 8; ++i) w[i] = wr[(size_t)(32 * s_ + i) * NEXP + 16 * hf];
              split_bf16x8(w, wBh[s_][hf], wBl[s_][hf]); } }
    for (int chunk = blockIdx.x; chunk < NTOK / 128; chunk += F.G) {
        if (tid < NEXP) hist[tid] = 0;
        Pre1Raw ra, rb;
        pre1_load(xin, st0, mixp, chunk * 128 + 2 * wv, lane, ra); pre1_load(xin, st0, mixp, chunk * 128 + 2 * wv + 1, lane, rb);
        for (int grp = 0; grp < 8; ++grp) {
            const int lrow = grp * 16 + 2 * wv, m = chunk * 128 + lrow;
            f32x4 va[4], vb[4];
            { const float* g0p = ka.in(2); const float* b0p = ka.in(3); asm volatile("" : "+s"(g0p), "+s"(b0p));
              f32x4 g0[4], b0[4];
#pragma unroll
              for (int j = 0; j < 4; ++j) { g0[j] = ((const f32x4*)g0p)[lane + 64 * j]; b0[j] = ((const f32x4*)b0p)[lane + 64 * j]; }
              pre1_calc(ra, g0, b0, va); pre1_calc(rb, g0, b0, vb);
              { const int mn = grp < 7 ? m + 16 : m; pre1_load(xin, st0, mixp, mn, lane, ra); pre1_load(xin, st0, mixp, mn + 1, lane, rb); } }
            float sa = 0.f, sb = 0.f;
#pragma unroll
            for (int j = 0; j < 4; ++j) { sa += (va[j][0] + va[j][1]) + (va[j][2] + va[j][3]); sb += (vb[j][0] + vb[j][1]) + (vb[j][2] + vb[j][3]); }
            const float meana = wave_sum(sa) * (1.f / DM), meanb = wave_sum(sb) * (1.f / DM); float qa = 0.f, qb = 0.f;
#pragma unroll
            for (int j = 0; j < 4; ++j) { const f32x4 da = va[j] - meana, db = vb[j] - meanb; qa += ssq4(da); qb += ssq4(db); }
            const float rstda = 1.f / sqrtf(wave_sum(qa) * (1.f / DM) + LN_EPS), rstdb = 1.f / sqrtf(wave_sum(qb) * (1.f / DM) + LN_EPS);
            if (lane == 0) { *(f32x2*)(st1 + (size_t)m * 2) = (f32x2){meana, rstda}; *(f32x2*)(st1 + (size_t)(m + 1) * 2) = (f32x2){meanb, rstdb}; }
#pragma unroll
            for (int j = 0; j < 4; ++j) { const float* g1p = ka.in(17); const float* b1p = ka.in(18); asm volatile("" : "+s"(g1p), "+s"(b1p));
                const f32x4 gvj = ((const f32x4*)g1p)[lane + 64 * j], bvj = ((const f32x4*)b1p)[lane + 64 * j];
                va[j] = (va[j] - meana) * rstda * gvj + bvj; vb[j] = (vb[j] - meanb) * rstdb * gvj + bvj;
                *(LAS f32x4*)(HT + (2 * wv) * HS + 4 * lane + 256 * j) = va[j]; *(LAS f32x4*)(HT + (2 * wv + 1) * HS + 4 * lane + 256 * j) = vb[j]; }
            LDS_WAIT(); asm volatile("" ::: "memory");
#pragma unroll
            for (int rr = 0; rr < 2; ++rr) { const LAS float* hr = HT + (2 * wv + rr) * HS; const size_t mr = (size_t)(m + rr) * DM;
                { const f32x4 c0 = *(const LAS f32x4*)(hr + 16 * lane), c1 = *(const LAS f32x4*)(hr + 16 * lane + 4), c2 = *(const LAS f32x4*)(hr + 16 * lane + 8), c3 = *(const LAS f32x4*)(hr + 16 * lane + 12);
                  *(u32x4*)(H1 + mr + 16 * lane) = (u32x4){pk4_f8(c0[0], c0[1], c0[2], c0[3]), pk4_f8(c1[0], c1[1], c1[2], c1[3]), pk4_f8(c2[0], c2[1], c2[2], c2[3]), pk4_f8(c3[0], c3[1], c3[2], c3[3])}; }
#pragma unroll
                for (int hh = 0; hh < 2; ++hh) { const f32x4 c0 = *(const LAS f32x4*)(hr + 512 * hh + 8 * lane), c1 = *(const LAS f32x4*)(hr + 512 * hh + 8 * lane + 4);
                    *(u32x4*)(H1b + mr + 512 * hh + 8 * lane) = pack8(c0, c1); } }
            __syncthreads();
            { f32x4 c0 = {0.f, 0.f, 0.f, 0.f}, c1 = {0.f, 0.f, 0.f, 0.f}; const LAS float* ap = HT + (lane & 15) * HS + 128 * wv + 8 * (lane >> 4);
#pragma unroll
              for (int s_ = 0; s_ < 4; ++s_) { const f32x4 a0 = *(const LAS f32x4*)(ap + 32 * s_), a1 = *(const LAS f32x4*)(ap + 32 * s_ + 4);
                  const float a[8] = {a0[0], a0[1], a0[2], a0[3], a1[0], a1[1], a1[2], a1[3]}; pg8::bf16x8 ah, al; split_bf16x8(a, ah, al);
                  c0 = __builtin_amdgcn_mfma_f32_16x16x32_bf16(ah, wBh[s_][0], c0, 0, 0, 0); c1 = __builtin_amdgcn_mfma_f32_16x16x32_bf16(ah, wBh[s_][1], c1, 0, 0, 0);
                  c0 = __builtin_amdgcn_mfma_f32_16x16x32_bf16(ah, wBl[s_][0], c0, 0, 0, 0); c1 = __builtin_amdgcn_mfma_f32_16x16x32_bf16(ah, wBl[s_][1], c1, 0, 0, 0);
                  c0 = __builtin_amdgcn_mfma_f32_16x16x32_bf16(al, wBh[s_][0], c0, 0, 0, 0); c1 = __builtin_amdgcn_mfma_f32_16x16x32_bf16(al, wBh[s_][1], c1, 0, 0, 0); }
              LAS float* pp = PART + (wv * 16 + 4 * (lane >> 4)) * 32 + (lane & 15);
#pragma unroll
              for (int r_ = 0; r_ < 4; ++r_) { pp[r_ * 32] = c0[r_]; pp[r_ * 32 + 16] = c1[r_]; } }
            __syncthreads();
#pragma unroll
            for (int rr = 0; rr < 2; ++rr) { float mylogit = brt;
#pragma unroll
                for (int w_ = 0; w_ < 8; ++w_) mylogit += PART[(w_ * 16 + 2 * wv + rr) * 32 + (lane >> 1)];
                float val[4]; int id[4];
#pragma unroll
                for (int k = 0; k < 4; ++k) { const float mx = wave_max(mylogit); const unsigned long long ball = __ballot(mylogit == mx); const int idx = ball ? ((int)__builtin_ctzll(ball) >> 1) : k;
                    val[k] = mx; id[k] = idx; if ((lane >> 1) == idx) mylogit = -INFINITY; }
                const float e1 = __expf(val[1] - val[0]), e2 = __expf(val[2] - val[0]), e3 = __expf(val[3] - val[0]); const float inv = 1.f / (1.f + e1 + e2 + e3);
                if (lane < 4) { const int myid = lane == 0 ? id[0] : (lane == 1 ? id[1] : (lane == 2 ? id[2] : id[3])); const float myw = (lane == 0 ? 1.f : (lane == 1 ? e1 : (lane == 2 ? e2 : e3))) * inv;
                    asg_e[(lrow + rr) * 4 + lane] = myid; asg_w[(lrow + rr) * 4 + lane] = myw; } }
        }
        __syncthreads();
        const int e = asg_e[tid] & 31; const float w = asg_w[tid];
        const int lr = __hip_atomic_fetch_add(hist + e, 1, __ATOMIC_RELAXED, __HIP_MEMORY_SCOPE_WORKGROUP);
        __syncthreads();
        if (tid < NEXP) base[tid] = (int)__hip_atomic_fetch_add(ka.ctl() + CW_CNT + 32 * tid, (unsigned)hist[tid], RLX_AGENT);
        __syncthreads();
        const int rank = base[e] + lr, m = chunk * 128 + (tid >> 2);
        if (rank >= 0 && rank < NTOK) { rtok[(size_t)e * NTOK + rank] = m; rw[(size_t)e * NTOK + rank] = w; }
        toker[(size_t)m * 4 + (tid & 3)] = (e << 16) | (rank & 0xffff);
        __syncthreads();
    }
}

__device__ __forceinline__ void p10_final(Frame& F, const KA& ka, const bool have_tables) {
    if (!have_tables) moe_tables(F, ka);
    const LAS int* TS = (const LAS int*)(F.lds + L_TS);
    const int lane = tid_now(F) & 63;
    const int gw = blockIdx.x * NWAVES + F.wave, NGW = F.G * NWAVES;
    const int* toker = wsp<int>(ka, WS_TOKER); const unsigned char* YS = wsp<unsigned char>(ka, WS_YS); const bf16_t* H1b = wsp<bf16_t>(ka, WS_H1B);
    f32x4 g2[4], b2[4];
#pragma unroll
    for (int j = 0; j < 4; ++j) { g2[j] = ((const f32x4*)ka.in(25))[lane + 64 * j]; b2[j] = ((const f32x4*)ka.in(26))[lane + 64 * j]; }
    int ern[2][4];
#pragma unroll
    for (int q = 0; q < 2; ++q)
#pragma unroll
        for (int k = 0; k < 4; ++k) ern[q][k] = toker[(size_t)(gw + q * NGW) * 4 + k];
    for (int m0 = gw; m0 < NTOK; m0 += 2 * NGW) {
        int er[2][4];
#pragma unroll
        for (int q = 0; q < 2; ++q)
#pragma unroll
            for (int k = 0; k < 4; ++k) er[q][k] = ern[q][k];
        { const int mn = m0 + 2 * NGW < NTOK ? m0 + 2 * NGW : m0;
#pragma unroll
          for (int q = 0; q < 2; ++q)
#pragma unroll
              for (int k = 0; k < 4; ++k) ern[q][k] = toker[(size_t)(mn + q * NGW) * 4 + k]; }
        f32x4 y[2][4]; unsigned yw[2][4][4];
#pragma unroll
        for (int q = 0; q < 2; ++q) { const int m = m0 + q * NGW;
#pragma unroll
            for (int j = 0; j < 4; ++j) y[q][j] = bf4_to_f32(*(const u32x2*)(H1b + (size_t)m * DM + 4 * lane + 256 * j));
#pragma unroll
            for (int k = 0; k < 4; ++k) { const int e = (er[q][k] >> 16) & 31, rank = er[q][k] & 0xffff; const size_t slot = (size_t)TS[e] * 256 + rank; const unsigned char* yr = YS + slot * DM + 4 * lane;
#pragma unroll
                for (int j = 0; j < 4; ++j) yw[q][k][j] = *(const unsigned*)(yr + 256 * j); } }
#pragma unroll
        for (int q = 0; q < 2; ++q) { const int m = m0 + q * NGW; float* orow = ka.out() + (size_t)m * DM; float s = 0.f;
#pragma unroll
            for (int j = 0; j < 4; ++j) { f32x4 f = (un4_f8(yw[q][0][j]) + un4_f8(yw[q][1][j])) + (un4_f8(yw[q][2][j]) + un4_f8(yw[q][3][j]));
                y[q][j] = y[q][j] * DN_ALPHA + f * (1.0f / F8_YSCALE); s += (y[q][j][0] + y[q][j][1]) + (y[q][j][2] + y[q][j][3]); }
            const float mean = wave_sum(s) * (1.f / DM); float s2 = 0.f;
#pragma unroll
            for (int j = 0; j < 4; ++j) { const f32x4 d = y[q][j] - mean; s2 += ssq4(d); }
            const float rstd = 1.f / sqrtf(wave_sum(s2) * (1.f / DM) + LN_EPS);
#pragma unroll
            for (int j = 0; j < 4; ++j) ((f32x4*)orow)[lane + 64 * j] = (y[q][j] - mean) * rstd * g2[j] + b2[j]; }
    }
}

__global__ void __launch_bounds__(NWAVES * 64, 2) mk_fwd(Args args) {
    extern __shared__ __attribute__((aligned(16))) unsigned char lds[];
    Frame F;
    F.lds = (LAS unsigned char*)lds;
    F.MISC = (volatile LAS unsigned*)(F.lds + MISC_OFF);
    F.wave = __builtin_amdgcn_readfirstlane((int)threadIdx.x >> 6);
    F.G = gridDim.x;
    for (int u = tid_now(F); u < (LDS_BYTES - LDSCTL_OFF) / 4; u += NWAVES * 64) ((LAS unsigned*)(F.lds + LDSCTL_OFF))[u] = 0u;
    __syncthreads();
    XcdBarrier bar; bar.bar = (unsigned*)((gu32*)(args.ws + WS_CTL) + CW_BAR) + args.li * XCD_BAR_WORDS; bar.x = 0; bar.st = nullptr;
    if constexpr (MK_BARMASK != 0) { if (args.ph_hi - args.ph_lo > 1) bar = xcd_barrier_post(bar.bar, F.MISC + 8, F.wave); }
#ifdef MK_CLKPROBE
    unsigned long long cp_c0 = __builtin_amdgcn_s_memtime(), cp_c1 = 0, cp_r0 = __builtin_amdgcn_s_memrealtime(), cp_r1 = 1;
#define GRID_BAR_K(k) do { if constexpr ((MK_BARMASK >> (k)) & 1) xcd_barrier(bar, F.wave); if ((k) + 1 == MK_CLKPROBE || (MK_CLKPROBE == 8 && (k) == 6)) { cp_c0 = __builtin_amdgcn_s_memtime(); cp_r0 = __builtin_amdgcn_s_memrealtime(); } if ((k) == MK_CLKPROBE) { cp_c1 = __builtin_amdgcn_s_memtime(); cp_r1 = __builtin_amdgcn_s_memrealtime(); } } while (0)
#elif defined(MK_TIMEPHASE)
    unsigned long long tp_start = __builtin_amdgcn_s_memrealtime(), tp_end = tp_start;
#define GRID_BAR_K(k) do { if constexpr ((MK_BARMASK >> (k)) & 1) xcd_barrier(bar, F.wave); { const unsigned long long now_ = __builtin_amdgcn_s_memrealtime(); if ((k) + 1 == MK_TIMEPHASE || (MK_TIMEPHASE == 8 && (k) == 6)) tp_start = now_; if ((k) == MK_TIMEPHASE) tp_end = now_; } } while (0)
#else
#ifdef MK_BARTWICE
#define GRID_BAR_K(k) do { if constexpr ((MK_BARMASK >> (k)) & 1) { xcd_barrier(bar, F.wave); for (int r_ = 0; r_ < MK_BARTWICE; ++r_) xcd_barrier(bar, F.wave); } } while (0)
#else
#define GRID_BAR_K(k) do { if constexpr ((MK_BARMASK >> (k)) & 1) xcd_barrier(bar, F.wave); } while (0)
#endif
#endif
    const int lo = args.ph_lo, hi = args.ph_hi;
#define IN(k) (lo <= (k) && (k) < hi)
#define BOTH(k) (IN(k) && IN((k) + 1))
    const int bx = blockIdx.x;

    if (IN(0)) { const KA ka = kargs(); p0_prologue(F, ka); if (BOTH(0)) GRID_BAR_K(0); }

    if (IN(1)) { const KA ka = kargs();
        DenseOrder S; S.init(NTOK, NPROJ, DM, F.G, bx, wsp<bf16_t>(ka, WS_H0), wsp<bf16_t>(ka, WS_WIN));
        EpiInProj E{wsp<bf16_t>(ka, WS_QA), wsp<bf16_t>(ka, WS_KA), wsp<bf16_t>(ka, WS_VA), wsp<bf16_t>(ka, WS_QLAT), wsp<bf16_t>(ka, WS_KVLAT), wsp<bf16_t>(ka, WS_KB), wsp<bf16_t>(ka, WS_QM), wsp<u32x2>(ka, WS_GATES),
                    wsp<float>(ka, WS_SSQ), ka.in(6), ka.in(7), ka.in(5), wsp<float>(ka, WS_ROPEA), wsp<float>(ka, WS_ROPEB)};
#ifdef MK_GEMMPROBE
        if (args.li > 0) pg8::gemm_phase<EpiInProj, DenseOrder, true, true, false, MK_GEMMPROBE>(F.lds + RING_OFF, DM, S, E, F.wave, (args.amask & 8) != 0); else
#endif
        pg8::gemm_phase<EpiInProj, DenseOrder, true, true>(F.lds + RING_OFF, DM, S, E, F.wave, (args.amask & 8) != 0);
        if (BOTH(1)) GRID_BAR_K(1);
    }

    if (IN(2)) { const KA ka = kargs();
#ifdef MK_P2PROBE
        unsigned long long p2t_[4]; p2t_[0] = __builtin_amdgcn_s_memrealtime();
#endif
        { QbOrder S; S.init(NTOK, 768, QLAT, F.G, bx, wsp<bf16_t>(ka, WS_QLAT), wsp<bf16_t>(ka, WS_WQB)); S.lo = (F.G == 256) ? 128 : -1000;
          EpiQb E{wsp<bf16_t>(ka, WS_QB), wsp<float>(ka, WS_SSQ), wsp<float>(ka, WS_ROPEB)};
          pg8::gemm_phase<EpiQb, QbOrder, true, true>(F.lds + RING_OFF, QLAT, S, E, F.wave, (args.amask & 8) != 0); }
#ifdef MK_P2PROBE
        p2t_[1] = __builtin_amdgcn_s_memrealtime();
#endif
        __syncthreads();
        { KvbOrder S; S.nM = NTOK / 256; S.nN = 4; S.A = (const char*)wsp<bf16_t>(ka, WS_KVLAT); S.B = (const char*)wsp<bf16_t>(ka, WS_WKVB); S.tstep = (size_t)256 * KVLAT * 2;
          { const int G = F.G, nwg = (NTOK / 256) * 4, lo = (G == 256) ? 128 : -1000, d = bx - lo;
            int L0 = bx, L1 = G + bx, L2 = -1;
            if (d >= 0 && d < 32) { L0 = -1; L1 = -1; } else if (d >= 32 && d < 64) L2 = G + lo + (d - 32); else if (d >= 96 && d < 128) L2 = lo + (d - 96);
            S.L0 = L0 < nwg ? L0 : -1; S.L1 = (L0 >= 0 && L1 < nwg) ? L1 : -1; S.L2 = (S.L1 >= 0 && L2 < nwg) ? L2 : -1; }
          EpiKVb E{wsp<bf16_t>(ka, WS_KB), wsp<bf16_t>(ka, WS_VB), wsp<float>(ka, WS_SSQ)};
          pg8::gemm_phase<EpiKVb, KvbOrder, true, true>(F.lds + RING_OFF, KVLAT, S, E, F.wave, (args.amask & 8) != 0); }
#ifdef MK_P2PROBE
        p2t_[2] = __builtin_amdgcn_s_memrealtime();
#endif
        __syncthreads();
        { DenseOrder S; S.init(NMEM, 1024, DM, F.G, (bx + 128) % F.G, wsp<bf16_t>(ka, WS_MEMB), wsp<bf16_t>(ka, WS_WMEM));
          EpiPlain E{wsp<bf16_t>(ka, WS_MKV), 1024};
          pg8::gemm_phase<EpiPlain, DenseOrder, true, true>(F.lds + RING_OFF, DM, S, E, F.wave, (args.amask & 8) != 0); }
#ifdef MK_P2PROBE
        p2t_[3] = __builtin_amdgcn_s_memrealtime(); if (tid_now(F) == 0) F.MISC[40] = (unsigned)(p2t_[MK_P2PROBE] - p2t_[MK_P2PROBE - 1]);
#endif
        if (BOTH(2)) GRID_BAR_K(2);
    }

    if (IN(3)) { const KA ka = kargs();
        const int vcu = (F.G % 8 == 0) ? (bx % 8) * (F.G / 8) + bx / 8 : bx;
        char* al = (char*)lds + RING_OFF;
        const int NU = NB * 8 * 16;
        const int amask = args.amask;
        int mla_nomax; { float worst = 0.f;
            for (int ui = vcu; ui < NU; ui += F.G) { const int b = ui >> 7, h = (ui >> 4) & 7, sl = (b * 8 + h) * 4; const gu32* c = ka.ctl();
                const float qb2 = __uint_as_float(__hip_atomic_load(c + CW_QMX + sl, RLX_AGENT)) + __uint_as_float(__hip_atomic_load(c + CW_QMX + sl + 1, RLX_AGENT)) + __uint_as_float(__hip_atomic_load(c + CW_QMX + sl + 2, RLX_AGENT));
                const float kb2 = __uint_as_float(__hip_atomic_load(c + CW_KMX + sl, RLX_AGENT)) + __uint_as_float(__hip_atomic_load(c + CW_KMX + sl + 1, RLX_AGENT)) + __uint_as_float(__hip_atomic_load(c + CW_KRX + b, RLX_AGENT));
                worst = fmaxf(worst, sqrtf(qb2 * kb2) * 1.03f); }
            mla_nomax = __builtin_amdgcn_readfirstlane((worst > 0.f && worst <= 80.0f) ? 1 : 0); }
        float gqa_offs; { const int l_ = tid_now(F) & 63; const float mq_ = wave_max(fabsf(ka.in(6)[l_])), mk_ = wave_max(fabsf(ka.in(7)[l_])); gqa_offs = 64.0f * 0.125f * LOG2E * mq_ * mk_; gqa_offs = __builtin_amdgcn_readfirstlane(gqa_offs); }
        if (amask & 1) for (int ui = vcu; ui < NU; ui += F.G) {
            const int b = ui >> 7, h = (ui >> 4) & 7, qb = ui & 15; const size_t row0 = (size_t)b * SEQ + qb * 256;
            bf16_t* Q = wsp<bf16_t>(ka, WS_QA) + row0 * 512 + h * 64;
            const bf16_t* K = wsp<bf16_t>(ka, WS_KA) + (size_t)b * SEQ * 128 + (h >> 2) * 64; const bf16_t* V = wsp<bf16_t>(ka, WS_VA) + (size_t)b * SEQ * 128 + (h >> 2) * 64;
            att::attn_body5<64, 64, 512, 128, 128, 512, true, 4, true, false>(Q, K, V, wsp<bf16_t>(ka, WS_OA) + row0 * 512 + h * 64, SEQ, gqa_offs, al, F.wave);
        }
        if (amask & 2) {
            if (mla_nomax) { for (int ui = vcu; ui < NU; ui += F.G) {
                const int b = ui >> 7, h = (ui >> 4) & 7, qb = ui & 15; const size_t row0 = (size_t)b * SEQ + qb * 256;
                const bf16_t* Q = wsp<bf16_t>(ka, WS_QB) + row0 * 768 + h * 96;
                const bf16_t* K = wsp<bf16_t>(ka, WS_KB) + (size_t)b * SEQ * 768 + h * 96; const bf16_t* V = wsp<bf16_t>(ka, WS_VB) + (size_t)b * SEQ * 512 + h * 64;
                att::attn_body5<96, 64, 768, 768, 512, 512, true, 2, true, false, true>(Q, K, V, wsp<bf16_t>(ka, WS_OB2) + row0 * 512 + h * 64, SEQ, 0.f, al, F.wave); }
            } else { for (int ui = vcu; ui < NU; ui += F.G) {
                const int b = ui >> 7, h = (ui >> 4) & 7, qb = ui & 15; const size_t row0 = (size_t)b * SEQ + qb * 256;
                const bf16_t* Q = wsp<bf16_t>(ka, WS_QB) + row0 * 768 + h * 96;
                const bf16_t* K = wsp<bf16_t>(ka, WS_KB) + (size_t)b * SEQ * 768 + h * 96; const bf16_t* V = wsp<bf16_t>(ka, WS_VB) + (size_t)b * SEQ * 512 + h * 64;
                att::attn_body5<96, 64, 768, 768, 512, 512, false, 2, true, false>(Q, K, V, wsp<bf16_t>(ka, WS_OB2) + row0 * 512 + h * 64, SEQ, 0.f, al, F.wave); } }
        }
        if (amask & 4) for (int ui = vcu; ui < NB * 4 * 16; ui += F.G) {
            const int b = ui >> 6, h = (ui >> 4) & 3, qb = ui & 15; const size_t row0 = (size_t)b * SEQ + qb * 256;
            bf16_t* Q = wsp<bf16_t>(ka, WS_QM) + row0 * 512 + h * 128;
            const bf16_t* K = wsp<bf16_t>(ka, WS_MKV) + (size_t)b * MEMLEN * 1024 + h * 128; const bf16_t* V = K + 512;
            att::attn_body<128, 128, 512, 1024, 1024, 512>(Q, K, V, wsp<bf16_t>(ka, WS_OC) + row0 * 512 + h * 128, MEMLEN, 0.08838834764831845f * LOG2E, att::THR / 0.08838834764831845f, al, F.wave);
        }
        if (BOTH(3)) GRID_BAR_K(3);
    }

    if (IN(4)) { const KA ka = kargs();
        BranchOrder S; S.G = F.G; S.c = bx; S.tstep = (size_t)256 * 512 * 2; S.astride = WS_OB2 - WS_OA; S.bstride = (size_t)1024 * 512 * 2;
        static_assert(WS_OB2 - WS_OA == WS_OC - WS_OB2, "branch operands equally spaced");
        S.A = (const char*)wsp<bf16_t>(ka, WS_OA); S.B = (const char*)wsp<bf16_t>(ka, WS_WBR);
        EpiBranch E{wsp<u32x2>(ka, WS_GATES), wsp<bf16_t>(ka, WS_MERGED)};
        pg8::gemm_phase<EpiBranch, BranchOrder, true, true>(F.lds + RING_OFF, 512, S, E, F.wave, (args.amask & 8) != 0);
        if (BOTH(4)) GRID_BAR_K(4);
    }

    if (IN(5)) { const KA ka = kargs();
        DenseOrder S; S.init(NTOK, DM, DM, F.G, bx, wsp<bf16_t>(ka, WS_MERGED), wsp<bf16_t>(ka, WS_WOUT));
        EpiPlain E{wsp<bf16_t>(ka, WS_MIX), DM};
        pg8::gemm_phase<EpiPlain, DenseOrder, true, true>(F.lds + RING_OFF, DM, S, E, F.wave, (args.amask & 8) != 0);
        if (BOTH(5)) GRID_BAR_K(5);
    }

    if (IN(6)) { const KA ka = kargs(); p6_route(F, ka); if (BOTH(6)) GRID_BAR_K(6); }


    if (IN(8)) { const KA ka = kargs();
        moe_tables(F, ka);
        MoeGatherOrder S; S.G = F.G; S.c = bx; S.T = ((const LAS int*)(F.lds + L_TS))[NEXP]; S.NPN = 8; S.A = (const char*)wsp<unsigned char>(ka, WS_H1); S.B = (const char*)wsp<unsigned char>(ka, WS_W1); S.apitch = 1024u;
        S.tstep = (size_t)256 * 1024; S.tile_e = (const LAS int*)(F.lds + L_TE); S.ts = (const LAS int*)(F.lds + L_TS); S.cnt = (const LAS int*)(F.lds + L_CNT); S.rtok = wsp<int>(ka, WS_RTOK);
        EpiSwiglu E{ka.in(22), wsp<unsigned char>(ka, WS_ACT)};
        pg8::gemm_phase<EpiSwiglu, MoeGatherOrder, true, true, true>(F.lds + RING_OFF, DM / 2, S, E, F.wave, (args.amask & 8) != 0);
        if (BOTH(8)) GRID_BAR_K(8);
    }

    if (IN(9)) { const KA ka = kargs();
        if (!IN(8)) moe_tables(F, ka);
        MoeOrder S; S.G = F.G; S.c = bx; S.T = ((const LAS int*)(F.lds + L_TS))[NEXP]; S.NPN = 4; S.A = (const char*)wsp<unsigned char>(ka, WS_ACT); S.B = (const char*)wsp<unsigned char>(ka, WS_W2); S.apitch = 0u;
        S.tstep = (size_t)256 * 1024; S.tile_e = (const LAS int*)(F.lds + L_TE); S.ts = (const LAS int*)(F.lds + L_TS); S.cnt = (const LAS int*)(F.lds + L_CNT); S.rtok = nullptr;
        EpiExpOut E{ka.in(24), wsp<float>(ka, WS_RW), (const LAS int*)(F.lds + L_TS), wsp<unsigned char>(ka, WS_YS)};
        pg8::gemm_phase<EpiExpOut, MoeOrder, true, true, true>(F.lds + RING_OFF, DM / 2, S, E, F.wave, (args.amask & 8) != 0);
        if (BOTH(9)) GRID_BAR_K(9);
    }

    if (IN(10)) { const KA ka = kargs(); p10_final(F, ka, IN(9) || IN(8)); }
#if defined(MK_P0PROBE) || defined(MK_P2PROBE)
    { const unsigned long long want_ = 4ull * F.MISC[40], t0_ = __builtin_amdgcn_s_memrealtime();
      while (__builtin_amdgcn_s_memrealtime() - t0_ < want_) __builtin_amdgcn_s_sleep(16); }
#elif defined(MK_CLKPROBE)
    { const unsigned long long want_ = 2000ull * (cp_c1 - cp_c0) / (cp_r1 - cp_r0), t0_ = __builtin_amdgcn_s_memrealtime();
      while (__builtin_amdgcn_s_memrealtime() - t0_ < want_) __builtin_amdgcn_s_sleep(16); }
#elif defined(MK_TIMEPHASE)
    { if (MK_TIMEPHASE == 10) tp_end = __builtin_amdgcn_s_memrealtime();
      const unsigned long long want_ = 4ull * (tp_end - tp_start), t0_ = __builtin_amdgcn_s_memrealtime();
      while (__builtin_amdgcn_s_memrealtime() - t0_ < want_) __builtin_amdgcn_s_sleep(16); }
#endif
#undef IN
#undef BOTH
#undef GRID_BAR
}

extern "C" void kernel_launch(void* const* d_in, const int* in_sizes, int n_in, void* d_out, int out_size, void* d_ws, size_t ws_size, hipStream_t stream) {
    static int grid = 0;
    if (grid == 0) {
        if (n_in != 27 || in_sizes[0] != NTOK * DM || out_size != NTOK * DM || ws_size < WS_END) { fprintf(stderr, "kernel_launch: shape mismatch (n_in %d, in0 %d, out %d, ws %zu)\n", n_in, n_in > 0 ? in_sizes[0] : -1, out_size, ws_size); grid = -1; return; }
        int dev = 0, cus = 0, per_cu = 0;
        if (hipGetDevice(&dev) != hipSuccess || hipDeviceGetAttribute(&cus, hipDeviceAttributeMultiprocessorCount, dev) != hipSuccess) { fprintf(stderr, "kernel_launch: device query failed\n"); grid = -1; return; }
        if (hipFuncSetAttribute((const void*)mk_fwd, hipFuncAttributeMaxDynamicSharedMemorySize, LDS_BYTES) != hipSuccess) { fprintf(stderr, "kernel_launch: hipFuncSetAttribute failed\n"); grid = -1; return; }
        if (hipOccupancyMaxActiveBlocksPerMultiprocessor(&per_cu, (const void*)mk_fwd, NWAVES * 64, LDS_BYTES) != hipSuccess || per_cu < 1) fprintf(stderr, "kernel_launch: note: occupancy query reports %d\n", per_cu);
        (void)hipGetLastError();
        grid = cus - (cus % 8);
        if (grid < 8) { grid = -1; return; }
    }
    if (grid < 0) return;
    if (hipMemsetAsync((char*)d_ws + WS_CTL, 0, CTL_ZERO_BYTES, stream) != hipSuccess) { fprintf(stderr, "kernel_launch: memset failed\n"); return; }
    Args a{};
    for (int i = 0; i < 27; ++i) a.in[i] = (const float*)d_in[i];
    a.out = (float*)d_out; a.ws = (unsigned char*)d_ws;
    for (int li = 0; li < N_LAUNCHES; ++li) {
        a.ph_lo = LAUNCHES[li].lo; a.ph_hi = LAUNCHES[li].hi; a.li = li; a.amask = LAUNCHES[li].amask;
        hipLaunchKernelGGL(mk_fwd, dim3(grid), dim3(NWAVES * 64), LDS_BYTES, stream, a);
        const hipError_t le = hipPeekAtLastError();
        if (le != hipSuccess) { fprintf(stderr, "kernel_launch: launch %d failed: %s\n", li, hipGetErrorName(le)); break; }
    }
}
```
